# Optimizing an MI355X kernel written in HIP

```python
import jax
import jax.numpy as jnp
from jax import lax
import numpy as np

D_MODEL = 1024
BATCH = 32
SEQ = 256
DEPTH = 2
DEC_BATCH = 8
DEC_SEQ = 2048
PAST_LEN = 512

GRID_W = 64
N_EVEN = (DEPTH + 1) // 2
N_ODD = DEPTH // 2
D_FF = 2816
N_MOD = 9
CHUNK = 128
Q_BLOCK = 128
ROPE_BASE = 10000.0
H_A = 4
DK_A = 64
DV_A = 128
H_B = 8
HS_B = 64
LORA_W = 64
LORA_A = 64
LORA_G = 128
H_C = 4
DH_C = 128
HQ_D = 8
HKV_D = 2
HD_D = 64

WA = H_A * DV_A
WB = H_B * HS_B
WC = H_C * DH_C
WD = HQ_D * HD_D
P_A = 2 * H_A * DK_A + 2 * WA
P_B = 3 * WB + LORA_W + LORA_A + LORA_G
P_C = 3 * WC + 4 * H_C + WC
P_D = WD + 2 * HKV_D * HD_D

kernel_name = 'hybrid_bidir_diffusion_step'


def rms_norm(x, g, eps=1e-6):
    xf = x.astype(jnp.float32)
    y = xf * lax.rsqrt(jnp.mean(xf * xf, axis=-1, keepdims=True) + eps)
    return (y * g.astype(jnp.float32)).astype(x.dtype)


def head_layer_norm(y, eps):
    y = y.astype(jnp.float32)
    mu = jnp.mean(y, axis=-1, keepdims=True)
    var = jnp.mean(jnp.square(y - mu), axis=-1, keepdims=True)
    return (y - mu) * lax.rsqrt(var + eps)


def to_heads(p, h):
    b, l, w = p.shape
    return p.reshape(b, l, h, w // h).transpose(0, 2, 1, 3)


def from_heads(o):
    b, h, l, d = o.shape
    return o.transpose(0, 2, 1, 3).reshape(b, l, h * d)


def tflip(t):
    return jnp.flip(t, axis=2)


def center_shift(p):
    z = jnp.zeros_like(p[:, :1])
    prev = jnp.concatenate([z, p[:, :-1]], axis=1)
    nxt = jnp.concatenate([p[:, 1:], z], axis=1)
    return 0.5 * (prev + nxt)


def axial_rope(x):
    n, d = x.shape[-2], x.shape[-1]
    rows = n // GRID_W
    row = jnp.repeat(jnp.arange(rows), GRID_W).astype(jnp.float32)
    col = (jnp.arange(rows * GRID_W) % GRID_W).astype(jnp.float32)
    da = d // 2
    nf = da // 2
    inv = ROPE_BASE ** (-jnp.arange(nf, dtype=jnp.float32) / nf)

    def rot(xa, pos):
        ang = pos[:, None] * inv[None, :]
        cos = jnp.cos(ang).astype(x.dtype)
        sin = jnp.sin(ang).astype(x.dtype)
        x1, x2 = xa[..., :nf], xa[..., nf:]
        return jnp.concatenate([x1 * cos - x2 * sin, x1 * sin + x2 * cos], axis=-1)

    return jnp.concatenate([rot(x[..., :da], row), rot(x[..., da:], col)], axis=-1)


def to_chunks(x):
    b, h, l = x.shape[:3]
    x = x.reshape(b, h, l // CHUNK, CHUNK, *x.shape[3:])
    return jnp.moveaxis(x, 2, 0)


def from_chunks(x):
    x = jnp.moveaxis(x, 0, 2)
    b, h, nc, cl = x.shape[:4]
    return x.reshape(b, h, nc * cl, *x.shape[4:])


def retention_scan(q, k, v, log_g, s0):
    idx = jnp.arange(CHUNK, dtype=jnp.float32)
    diff = idx[:, None] - idx[None, :]
    causal = diff >= 0
    lg = log_g[:, None, None]
    d_intra = jnp.where(causal, jnp.exp(lg * jnp.where(causal, diff, 0.0)), 0.0)
    q_dec = jnp.exp(log_g[:, None] * (idx + 1.0))[:, :, None]
    k_dec = jnp.exp(log_g[:, None] * (CHUNK - 1.0 - idx))[:, :, None]
    c_dec = jnp.exp(log_g * CHUNK)[:, None, None]

    def step(s, inp):
        qc, kc, vc = inp
        att = jnp.einsum('bhid,bhjd->bhij', qc, kc) * d_intra
        o = jnp.einsum('bhij,bhje->bhie', att, vc) + jnp.einsum('bhid,bhde->bhie', qc * q_dec, s)
        s = s * c_dec + jnp.einsum('bhjd,bhje->bhde', kc * k_dec, vc)
        return s, o

    s_fin, o = lax.scan(step, s0, (to_chunks(q), to_chunks(k), to_chunks(v)))
    return from_chunks(o), s_fin


def mlstm_scan(q, k, v, ig, lf, c0, n0, m0):
    idx = jnp.arange(CHUNK)
    causal = idx[:, None] >= idx[None, :]

    def step(carry, inp):
        cm, nv, m = carry
        qc, kc, vc, igc, lfc = inp
        b = jnp.cumsum(lfc, axis=-1)
        a = b + m[..., None]
        dlog = jnp.where(causal, b[..., :, None] - b[..., None, :] + igc[..., None, :], -jnp.inf)
        mt = jnp.maximum(a, jnp.max(dlog, axis=-1))
        w = jnp.exp(dlog - mt[..., None])
        s = jnp.einsum('bhid,bhjd->bhij', qc, kc) * w
        inter = jnp.exp(a - mt)
        num = jnp.einsum('bhij,bhje->bhie', s, vc) + inter[..., None] * jnp.einsum('bhid,bhde->bhie', qc, cm)
        den = jnp.sum(s, axis=-1) + inter * jnp.einsum('bhid,bhd->bhi', qc, nv)
        h = num / jnp.maximum(jnp.abs(den), jnp.exp(-mt))[..., None]
        bl = b[..., -1]
        wl = bl[..., None] - b + igc
        m_new = jnp.maximum(bl + m, jnp.max(wl, axis=-1))
        wk = jnp.exp(wl - m_new[..., None])[..., None] * kc
        dec = jnp.exp(bl + m - m_new)
        cm = dec[..., None, None] * cm + jnp.einsum('bhjd,bhje->bhde', wk, vc)
        nv = dec[..., None] * nv + jnp.sum(wk, axis=2)
        return (cm, nv, m_new), h

    seqs = tuple(to_chunks(t) for t in (q, k, v, ig, lf))
    (c_f, n_f, m_f), h = lax.scan(step, (c0, n0, m0), seqs)
    return from_chunks(h), c_f, n_f, m_f


def rwkv_scan(r, w, k, v, a, b, s0):
    def step(s, inp):
        rt, wt, kt, vt, at, bt = inp
        sa = jnp.einsum('bhij,bhj->bhi', s, at)
        s = s * wt[..., None, :] + sa[..., :, None] * bt[..., None, :] + vt[..., :, None] * kt[..., None, :]
        return s, jnp.einsum('bhij,bhj->bhi', s, rt)

    seqs = tuple(jnp.moveaxis(t, 2, 0) for t in (r, w, k, v, a, b))
    s_fin, y = lax.scan(step, s0, seqs)
    return jnp.moveaxis(y, 0, 2), s_fin


def block_attention(q, k, v):
    b, hq, l, hd = q.shape
    hkv = k.shape[1]
    g = hq // hkv
    nb = l // Q_BLOCK
    qb = jnp.moveaxis(q.reshape(b, hkv, g, nb, Q_BLOCK, hd), 3, 0)
    scale = hd ** -0.5

    def one(qblk):
        s = jnp.einsum('bkgqd,bksd->bkgqs', qblk, k).astype(jnp.float32) * scale
        pr = jax.nn.softmax(s, axis=-1).astype(v.dtype)
        return jnp.einsum('bkgqs,bksd->bkgqd', pr, v)

    o = lax.map(one, qb)
    return jnp.moveaxis(o, 0, 3).reshape(b, hq, l, hd)


def retention_mixer(p, log_decay, gn_w, s0, latent):
    f32 = jnp.float32
    qk = H_A * DK_A
    q = to_heads(p[..., :qk], H_A)
    k = to_heads(p[..., qk:2 * qk], H_A)
    v = to_heads(p[..., 2 * qk:2 * qk + WA], H_A).astype(f32)
    g = p[..., 2 * qk + WA:]
    if latent:
        q = axial_rope(q)
        k = axial_rope(k)
    q = q.astype(f32)
    k = k.astype(f32) * DK_A ** -0.5
    s0 = s0.astype(f32)
    log_decay = log_decay.astype(f32)
    o_f, s_f = retention_scan(q, k, v, log_decay[0], s0[:, 0])
    o_b, s_b = retention_scan(tflip(q), tflip(k), tflip(v), log_decay[1], s0[:, 1])
    o = from_heads(head_layer_norm(o_f + tflip(o_b), 1e-5)) * gn_w
    out = jax.nn.silu(g) * o.astype(p.dtype)
    return out, jnp.stack([s_f, s_b], axis=1)


def rwkv_mixer(p, mu, w0, w2, a0, a2, g2, k_k, k_a, r_k, ln_w, ln_b, s0):
    f32 = jnp.float32
    p = p + mu * (center_shift(p) - p)
    r, k, v = p[..., :WB], p[..., WB:2 * WB], p[..., 2 * WB:3 * WB]
    o = 3 * WB
    wd = jnp.tanh(p[..., o:o + LORA_W])
    ad = p[..., o + LORA_W:o + LORA_W + LORA_A]
    gd = p[..., o + LORA_W + LORA_A:]
    g = jax.nn.sigmoid(gd) @ g2
    kk = to_heads(k * k_k, H_B).astype(f32)
    kk = kk / jnp.maximum(jnp.sqrt(jnp.sum(kk * kk, axis=-1, keepdims=True)), 1e-12)
    r_h = to_heads(r, H_B).astype(f32)
    k_h = to_heads(k, H_B).astype(f32)
    v_h = to_heads(v, H_B).astype(f32)
    ys, ss = [], []
    for d in range(2):
        w_log = -jax.nn.softplus(-(w0[d] + wd @ w2[d])) - 0.5
        decay = to_heads(jnp.exp(-jnp.exp(w_log.astype(f32))), H_B)
        a = jax.nn.sigmoid(a0[d] + ad @ a2[d])
        kd = to_heads(k * (1 + (a - 1) * k_a), H_B).astype(f32)
        a_h = to_heads(a, H_B).astype(f32)
        seqs = (r_h, decay, kd, v_h, -kk, kk * a_h)
        if d == 1:
            seqs = tuple(tflip(t) for t in seqs)
        y, s = rwkv_scan(*seqs, s0[:, d].astype(f32))
        ys.append(y if d == 0 else tflip(y))
        ss.append(s)
    y = from_heads(head_layer_norm(ys[0] + ys[1], 64e-5)) * ln_w + ln_b
    bonus = from_heads(jnp.sum(r_h * k_h * r_k[:, None, :].astype(f32), axis=-1, keepdims=True) * v_h)
    out = (y + bonus).astype(p.dtype) * g
    return out, jnp.stack(ss, axis=1)


def mlstm_mixer(p, i_bias, f_bias, norm_w, c0, n0, m0):
    f32 = jnp.float32
    bsz, seq = p.shape[0], p.shape[1]
    q = to_heads(p[..., :WC], H_C).astype(f32)
    k = to_heads(p[..., WC:2 * WC], H_C).astype(f32) * DH_C ** -0.5
    v = to_heads(p[..., 2 * WC:3 * WC], H_C).astype(f32)
    o = 3 * WC
    ig = p[..., o:o + 2 * H_C].reshape(bsz, seq, 2, H_C) + i_bias
    fg = p[..., o + 2 * H_C:o + 4 * H_C].reshape(bsz, seq, 2, H_C) + f_bias
    og = p[..., o + 4 * H_C:]
    ig = jnp.transpose(ig, (2, 0, 3, 1)).astype(f32)
    lf = jax.nn.log_sigmoid(jnp.transpose(fg, (2, 0, 3, 1)).astype(f32))
    c0 = c0.astype(f32)
    n0 = n0.astype(f32)
    m0 = m0.astype(f32)
    h_f, cf, nf, mf = mlstm_scan(q, k, v, ig[0], lf[0], c0[:, 0], n0[:, 0], m0[:, 0])
    h_b, cb, nb, mb = mlstm_scan(tflip(q), tflip(k), tflip(v), tflip(ig[1]), tflip(lf[1]),
                                 c0[:, 1], n0[:, 1], m0[:, 1])
    h = from_heads(head_layer_norm(h_f + tflip(h_b), 1e-5)) * norm_w
    out = jax.nn.sigmoid(og) * h.astype(p.dtype)
    return out, jnp.stack([cf, cb], axis=1), jnp.stack([nf, nb], axis=1), jnp.stack([mf, mb], axis=1)


def attention_mixer(p, qk_gain, ctx_k, ctx_v, latent):
    kvw = HKV_D * HD_D
    q = to_heads(p[..., :WD], HQ_D)
    k = to_heads(p[..., WD:WD + kvw], HKV_D)
    v = to_heads(p[..., WD + kvw:], HKV_D)
    q = rms_norm(q, qk_gain[0])
    k = rms_norm(k, qk_gain[1])
    if latent:
        q = axial_rope(q)
        k_lat = axial_rope(k)
        keys = jnp.concatenate([ctx_k.astype(k.dtype), k_lat], axis=2)
        vals = jnp.concatenate([ctx_v.astype(v.dtype), v], axis=2)
    else:
        keys, vals = k, v
    o = block_attention(q, keys, vals)
    return from_heads(o), k, v


def modulation(cond, ada_w, ada_b):
    m = jax.nn.silu(cond) @ ada_w + ada_b
    return jnp.split(m[:, None, :], N_MOD, axis=-1)


def swiglu(h, w1, w2):
    gate, up = jnp.split(h @ w1, 2, axis=-1)
    return (jax.nn.silu(gate) * up) @ w2


def setup_inputs(seed: int = 0) -> dict:
    key = jax.random.key(seed)
    ks = iter(jax.random.split(key, 48))
    f32 = jnp.float32

    def nrm(shape, scale=1.0):
        return jax.random.normal(next(ks), shape, f32) * scale

    d = D_MODEL
    ret_base = jnp.log1p(-(2.0 ** (-5.0 - jnp.arange(H_A, dtype=f32))))
    w0_base = jnp.repeat(jnp.linspace(-6.0, -0.5, HS_B)[None, :], H_B, axis=0).reshape(-1)
    return {
        'x_prompt': nrm((BATCH, SEQ, d)),
        'x_sample': nrm((DEC_BATCH, DEC_SEQ, d)),
        'state_ret': nrm((DEC_BATCH, N_EVEN, 2, H_A, DK_A, DV_A), 0.5),
        'state_rwkv': nrm((DEC_BATCH, N_EVEN, 2, H_B, HS_B, HS_B), 0.3),
        'state_mlstm_c': nrm((DEC_BATCH, N_ODD, 2, H_C, DH_C, DH_C), 0.3),
        'state_mlstm_n': nrm((DEC_BATCH, N_ODD, 2, H_C, DH_C), 0.3),
        'state_mlstm_m': nrm((DEC_BATCH, N_ODD, 2, H_C), 0.5),
        'cache_k': nrm((DEC_BATCH, N_ODD, HKV_D, PAST_LEN, HD_D)),
        'cache_v': nrm((DEC_BATCH, N_ODD, HKV_D, PAST_LEN, HD_D)),
        'c': nrm((DEC_BATCH, d)),
        'c_ctx': nrm((d,)),
        'ada_w': nrm((DEPTH, d, N_MOD * d), 0.5 * d ** -0.5),
        'ada_b': nrm((DEPTH, N_MOD * d), 0.02),
        'norm_g': 1.0 + nrm((DEPTH, 3, d), 0.02),
        'ffn_w1': nrm((DEPTH, 2, d, 2 * D_FF), d ** -0.5),
        'ffn_w2': nrm((DEPTH, 2, D_FF, d), D_FF ** -0.5),
        'w_in_even': nrm((N_EVEN, d, P_A + P_B), d ** -0.5),
        'w_out_even': nrm((N_EVEN, WA + WB, d), (WA + WB) ** -0.5),
        'ret_log_decay': ret_base[None, None, :] * (1.0 + nrm((N_EVEN, 2, H_A), 0.05)),
        'ret_gn_w': 1.0 + nrm((N_EVEN, WA), 0.02),
        'rwkv_mu': 0.5 + nrm((N_EVEN, P_B), 0.1),
        'rwkv_w0': w0_base[None, None, :] + nrm((N_EVEN, 2, WB), 0.1),
        'rwkv_w2': nrm((N_EVEN, 2, LORA_W, WB), 0.1 * LORA_W ** -0.5),
        'rwkv_a0': nrm((N_EVEN, 2, WB), 0.1),
        'rwkv_a2': nrm((N_EVEN, 2, LORA_A, WB), LORA_A ** -0.5),
        'rwkv_g2': nrm((N_EVEN, LORA_G, WB), LORA_G ** -0.5),
        'rwkv_k_k': 0.85 + nrm((N_EVEN, WB), 0.02),
        'rwkv_k_a': 1.0 + nrm((N_EVEN, WB), 0.02),
        'rwkv_r_k': nrm((N_EVEN, H_B, HS_B), 0.1),
        'rwkv_ln_w': 1.0 + nrm((N_EVEN, WB), 0.02),
        'rwkv_ln_b': nrm((N_EVEN, WB), 0.02),
        'w_in_odd': nrm((N_ODD, d, P_C + P_D), d ** -0.5),
        'w_out_odd': nrm((N_ODD, WC + WD, d), (WC + WD) ** -0.5),
        'mlstm_i_bias': nrm((N_ODD, 2, H_C), 0.1),
        'mlstm_f_bias': jnp.linspace(3.0, 6.0, H_C)[None, None, :] + nrm((N_ODD, 2, H_C), 0.1),
        'mlstm_norm_w': 1.0 + nrm((N_ODD, WC), 0.02),
        'attn_qk_norm': 1.0 + nrm((N_ODD, 2, HD_D), 0.02),
        'final_norm': 1.0 + nrm((d,), 0.02),
    }


def reference(x_prompt, x_sample, state_ret, state_rwkv, state_mlstm_c, state_mlstm_n, state_mlstm_m,
              cache_k, cache_v, c, c_ctx, ada_w, ada_b, norm_g, ffn_w1, ffn_w2, w_in_even, w_out_even,
              ret_log_decay, ret_gn_w, rwkv_mu, rwkv_w0, rwkv_w2, rwkv_a0, rwkv_a2, rwkv_g2, rwkv_k_k,
              rwkv_k_a, rwkv_r_k, rwkv_ln_w, rwkv_ln_b, w_in_odd, w_out_odd, mlstm_i_bias, mlstm_f_bias,
              mlstm_norm_w, attn_qk_norm, final_norm):
    f32 = jnp.float32

    def layer(x, cond, l, latent, st):
        sh1, sc1, gt1, sh2, sc2, gt2, sh3, sc3, gt3 = modulation(cond, ada_w[l], ada_b[l])
        h = rms_norm(x, norm_g[l, 0]) * (1 + sc1) + sh1
        x = x + 0.5 * gt1 * swiglu(h, ffn_w1[l, 0], ffn_w2[l, 0])
        h = rms_norm(x, norm_g[l, 1]) * (1 + sc2) + sh2
        if l % 2 == 0:
            e = l // 2
            p = h @ w_in_even[e]
            out_a, s_ret = retention_mixer(p[..., :P_A], ret_log_decay[e], ret_gn_w[e], st[0], latent)
            out_b, s_rwkv = rwkv_mixer(p[..., P_A:], rwkv_mu[e], rwkv_w0[e], rwkv_w2[e], rwkv_a0[e],
                                       rwkv_a2[e], rwkv_g2[e], rwkv_k_k[e], rwkv_k_a[e], rwkv_r_k[e],
                                       rwkv_ln_w[e], rwkv_ln_b[e], st[1])
            mix = jnp.concatenate([out_a, out_b], axis=-1) @ w_out_even[e]
            new = (s_ret, s_rwkv)
        else:
            o = l // 2
            p = h @ w_in_odd[o]
            out_c, s_c, s_n, s_m = mlstm_mixer(p[..., :P_C], mlstm_i_bias[o], mlstm_f_bias[o],
                                               mlstm_norm_w[o], st[0], st[1], st[2])
            out_d, k_ctx, v_ctx = attention_mixer(p[..., P_C:], attn_qk_norm[o], st[3], st[4], latent)
            mix = jnp.concatenate([out_c, out_d], axis=-1) @ w_out_odd[o]
            new = (s_c, s_n, s_m, k_ctx, v_ctx)
        x = x + gt2 * mix
        h = rms_norm(x, norm_g[l, 2]) * (1 + sc3) + sh3
        x = x + 0.5 * gt3 * swiglu(h, ffn_w1[l, 1], ffn_w2[l, 1])
        return x, new

    bp = x_prompt.shape[0]
    cond_ctx = c_ctx[None, :]
    xp, xs = x_prompt, x_sample
    ret_l, rwkv_l, mc_l, mn_l, mm_l, k_l, v_l = [], [], [], [], [], [], []
    for l in range(DEPTH):
        if l % 2 == 0:
            e = l // 2
            zeros = (jnp.zeros((bp, 2, H_A, DK_A, DV_A), f32), jnp.zeros((bp, 2, H_B, HS_B, HS_B), f32))
            xp, (s_ret, s_rwkv) = layer(xp, cond_ctx, l, False, zeros)
            ret_l.append(s_ret)
            rwkv_l.append(s_rwkv)
            xs, _ = layer(xs, c, l, True, (state_ret[:, e], state_rwkv[:, e]))
        else:
            o = l // 2
            zeros = (jnp.zeros((bp, 2, H_C, DH_C, DH_C), f32), jnp.zeros((bp, 2, H_C, DH_C), f32),
                     jnp.zeros((bp, 2, H_C), f32), None, None)
            xp, (s_c, s_n, s_m, k_ctx, v_ctx) = layer(xp, cond_ctx, l, False, zeros)
            mc_l.append(s_c)
            mn_l.append(s_n)
            mm_l.append(s_m)
            k_l.append(k_ctx)
            v_l.append(v_ctx)
            xs, _ = layer(xs, c, l, True, (state_mlstm_c[:, o], state_mlstm_n[:, o], state_mlstm_m[:, o],
                                           cache_k[:, o], cache_v[:, o]))
    y_prompt = rms_norm(xp, final_norm)
    y_sample = rms_norm(xs, final_norm)
    new_state_ret = jnp.stack(ret_l, axis=1)
    new_state_rwkv = jnp.stack(rwkv_l, axis=1)
    new_state_mlstm_c = jnp.stack(mc_l, axis=1)
    new_state_mlstm_n = jnp.stack(mn_l, axis=1)
    new_state_mlstm_m = jnp.stack(mm_l, axis=1)
    new_cache_k = jnp.stack(k_l, axis=1)
    new_cache_v = jnp.stack(v_l, axis=1)
    return (y_prompt, y_sample, new_state_ret, new_state_rwkv, new_state_mlstm_c, new_state_mlstm_n,
            new_state_mlstm_m, new_cache_k, new_cache_v)
```

```cpp
#include <hip/hip_runtime.h>
#include <hip/hip_cooperative_groups.h>
#include <cstdio>
namespace cg = cooperative_groups;

#define DI __device__ __forceinline__
#define LAS __attribute__((address_space(3)))
typedef unsigned short bf16_t;
typedef short s16x4 __attribute__((ext_vector_type(4)));
typedef float f32x2 __attribute__((ext_vector_type(2)));
typedef unsigned u32x2 __attribute__((ext_vector_type(2)));
typedef __bf16 bf2_t __attribute__((ext_vector_type(2)));

constexpr int M_ = 24576, MP_ = 8192, D_ = 1024, DFF_ = 2816;
constexpr int LDS_BYTES = 139264;
constexpr int MISC_OFF = 131072;

DI unsigned pk2(float a, float b) { f32x2 v = {a, b}; bf2_t r = __builtin_convertvector(v, bf2_t); return __builtin_bit_cast(unsigned, r); }
DI float bf_lo(unsigned u) { return __uint_as_float(u << 16); }
DI float bf_hi(unsigned u) { return __uint_as_float(u & 0xffff0000u); }
DI float bf2f(bf16_t h) { return __uint_as_float(((unsigned)h) << 16); }
DI float silu_f(float x) { return x * __builtin_amdgcn_rcpf(1.f + __expf(-x)); }
DI float sigmoid_f(float x) { return __builtin_amdgcn_rcpf(1.f + __expf(-x)); }
DI float softplus_f(float z) { return fmaxf(z, 0.f) + __logf(1.f + __expf(-fabsf(z))); }
DI float wave_sum(float v) { v += __shfl_xor(v, 32); v += __shfl_xor(v, 16); v += __shfl_xor(v, 8); v += __shfl_xor(v, 4); v += __shfl_xor(v, 2); v += __shfl_xor(v, 1); return v; }
DI float fq_sum(float v) { v += __shfl_xor(v, 16); v += __shfl_xor(v, 32); return v; }
DI float fq_max(float v) { v = fmaxf(v, __shfl_xor(v, 16)); v = fmaxf(v, __shfl_xor(v, 32)); return v; }
DI int cond_of_row(int row) { return row < MP_ ? 0 : 1 + ((row - MP_) >> 11); }
DI int seqpos_of_row(int row) { return row < MP_ ? (row & 255) : ((row - MP_) & 2047); }

DI int launder_v(int v) { asm volatile("" : "+v"(v)); return v; }
DI int launder_s(int v) { asm volatile("" : "+s"(v)); return v; }
struct Params { const float* in[38]; float* out; unsigned char* ws; };

typedef __attribute__((address_space(4))) const Params KParams;
DI KParams& kparams() { KParams* p = (KParams*)__builtin_amdgcn_kernarg_segment_ptr(); asm volatile("" : "+s"(p)); return *p; }
constexpr size_t WS_CTR = 0, WS_ROPE = 256, WS_MOD = 16384, WS_BAR = 786432, WS_W = 1048576;
constexpr size_t W_W1A = WS_W, W_W1B = W_W1A + 11534336, W_W2A = W_W1B + 11534336, W_W2B = W_W2A + 5767168, W_WIN = W_W2B + 5767168,
                 W_WOUT = W_WIN + 6815744, W_WL = W_WOUT + 2097152, WS_H = W_WL + 1310720, WS_AR = WS_H + 50331648;
constexpr size_t SZ512 = (size_t)M_ * 512 * 2;
constexpr size_t A_R = WS_AR, A_K = A_R + SZ512, A_V = A_K + SZ512, A_X = A_V + SZ512, A_Z = A_X + (size_t)M_ * 256 * 2;
constexpr size_t A_QA = A_Z, A_KA = A_QA + (size_t)M_ * 256 * 2, A_VA = A_KA + (size_t)M_ * 256 * 2, A_GA = A_VA + SZ512, A_PB = A_GA + SZ512;
constexpr size_t A_U0 = A_Z, A_U1 = A_U0 + SZ512, A_A0 = A_U1 + SZ512, A_A1 = A_A0 + SZ512, A_G = A_A1 + SZ512, A_Y = A_G + SZ512, A_END = A_Y + 2 * SZ512;
constexpr size_t O_QC = WS_AR, O_KC = O_QC + SZ512, O_VC = O_KC + SZ512, O_OC = O_VC + SZ512, O_QD = O_OC + SZ512,
                 O_KD = O_QD + SZ512, O_VD = O_KD + (size_t)M_ * 128 * 2, O_GT = O_VD + (size_t)M_ * 128 * 2;
constexpr size_t A_ACT = WS_AR;
constexpr size_t WS_CK = A_END, WS_CV = WS_CK + 1048576, WS_NEED = WS_CV + 1048576;
constexpr size_t OUT_RET = 25165824, OUT_RWKV = 27262976, OUT_MC = 29360128, OUT_MN = 33554432, OUT_MM = 33587200, OUT_CK = 33587456, OUT_CV = 34636032;
typedef short bf16x8 __attribute__((ext_vector_type(8)));
typedef float f32x4 __attribute__((ext_vector_type(4)));
typedef unsigned u32x4 __attribute__((ext_vector_type(4)));
namespace pg8 {
#define PG8_LAS __attribute__((address_space(3)))
typedef unsigned short bf16_t;
typedef short bf16x8 __attribute__((ext_vector_type(8)));
typedef float f32x4 __attribute__((ext_vector_type(4)));
typedef unsigned u32x4 __attribute__((ext_vector_type(4)));
constexpr int BM = 256, BK = 64, HALF = 128, HTB = HALF * BK * 2  , STAGE_BYTES = 8 * HTB, NXCD = 8, WGM = 8;

__host__ __device__ __forceinline__ int lds_byte(int r, int c) { const int st = (r >> 4) * 2 + (c >> 5), rr = r & 15, cc = c & 31, ob = rr * 64 + cc * 2; return st * 1024 + (ob ^ (((ob >> 9) & 1) << 5)); }
__host__ __device__ __forceinline__ void stage_rc(int b, int& R, int& C) { const int st = b / 1024, sb = b % 1024, swz = sb ^ (((sb >> 9) & 1) << 5); R = (st >> 1) * 16 + swz / 64; C = (st & 1) * 32 + (swz % 64) / 2; }
__host__ __device__ __forceinline__ int perm32(int rho) { const int n = rho >> 4, i = rho & 15; return 8 * (i >> 2) + 4 * n + (i & 3); }

struct Unit { int pm, pn; };
struct Gemm { const bf16_t* A; const bf16_t* Bt; int M, N, K; };

struct StaticOrder {
    int nM, nN, nwg, G, c;
    __host__ __device__ void init(int M, int N, int G_, int c_) { nM = M / BM; nN = N / BM; nwg = nM * nN; G = G_; c = c_; }
    __host__ __device__ bool next(int i, Unit& u) const {
        const long L = (long)i * G + c; if (L >= nwg) return false;
        int wgid = (int)L; { const int q = nwg / NXCD, r = nwg % NXCD, xcd = wgid % NXCD, off = wgid / NXCD; wgid = (xcd < r ? xcd * (q + 1) : r * (q + 1) + (xcd - r) * q) + off; }
        const int nig = WGM * nN, gid = wgid / nig, fm = gid * WGM, gsz = (nM - fm) < WGM ? (nM - fm) : WGM;
        u.pm = fm + ((wgid % nig) % gsz); u.pn = (wgid % nig) / gsz; return true;
    }
    __device__ __forceinline__ void a_ready(const Unit&) const {}
    __device__ __forceinline__ void done(const Unit&) const {}
};
template <class Epi, class Sched>
__device__ __forceinline__ void gemm_phase(PG8_LAS unsigned char* lds, const Gemm g, const Sched& S, const Epi& E) {
    const int tid = launder_v((int)threadIdx.x), wid = __builtin_amdgcn_readfirstlane(tid >> 6), lane = tid & 63, wr = wid >> 2, wc = wid & 3, fr = lane & 15, fq = lane >> 4;
    const int K = g.K, nt = K / BK;
    unsigned voffA[2], voffB[2];
#pragma unroll
    for (int i = 0; i < 2; ++i) { int R, C; stage_rc(tid * 16 + i * 8192, R, C); const int Rb = Epi::PERM ? ((R & ~31) + perm32(R & 31)) : R;
        voffA[i] = (unsigned)(R * K + C) * 2u; voffB[i] = (unsigned)(Rb * K + C) * 2u; }
    const size_t kstep = (size_t)(BK * 2);
    const size_t hstep = (size_t)HALF * K * 2;
    const size_t tstep = 2 * hstep;
    const unsigned ldsw = (unsigned)wid * 1024u;
    const int aoff = lds_byte(wr * 64 + fr, fq * 8), boff = lds_byte(wc * 32 + fr, fq * 8);
#define PG8_SA(b, h) (((b) * 2 + (h)) * HTB)
#define PG8_SB(b, h) ((4 + (b) * 2 + (h)) * HTB)
#define PG8_STAGE(bufoff, gbase, voff) do { _Pragma("unroll") for (int _i = 0; _i < 2; ++_i) \
        __builtin_amdgcn_global_load_lds((const unsigned*)((const char*)(gbase) + (voff)[_i]), (PG8_LAS unsigned*)(lds + (bufoff) + ldsw + _i * 8192), 16, 0, 0); } while (0)
#define PG8_LDA(dst, b, h) do { _Pragma("unroll") for (int m = 0; m < 4; ++m) _Pragma("unroll") for (int k = 0; k < 2; ++k) dst[m][k] = *(const PG8_LAS bf16x8*)(lds + PG8_SA(b, h) + aoff + m * 2048 + k * 1024); } while (0)
#define PG8_LDB(dst, b, h) do { _Pragma("unroll") for (int n = 0; n < 2; ++n) _Pragma("unroll") for (int k = 0; k < 2; ++k) dst[n][k] = *(const PG8_LAS bf16x8*)(lds + PG8_SB(b, h) + boff + n * 2048 + k * 1024); } while (0)
#define PG8_MMA(ai, bj, At, Bt) do { __builtin_amdgcn_s_setprio(1); _Pragma("unroll") for (int m = 0; m < 4; ++m) _Pragma("unroll") for (int n = 0; n < 2; ++n) _Pragma("unroll") for (int k = 0; k < 2; ++k) \
        acc[ai][bj][m][n] = __builtin_amdgcn_mfma_f32_16x16x32_bf16(Bt[n][k], At[m][k], acc[ai][bj][m][n], 0, 0, 0); __builtin_amdgcn_s_setprio(0); } while (0)
#define PG8_WAIT_V(n) asm volatile("s_waitcnt vmcnt(" #n ")" ::: "memory")
#define PG8_WAIT_L(n) asm volatile("s_waitcnt lgkmcnt(" #n ")" ::: "memory")
#define PG8_BAR __builtin_amdgcn_s_barrier()
#define PG8_SCHED __builtin_amdgcn_sched_barrier(0)
    Unit cur, nxt; int ui = 0;
    if (!S.next(0, cur)) return;
    f32x4 acc[2][2][4][2];
#pragma unroll
    for (int a = 0; a < 2; ++a)
#pragma unroll
        for (int b = 0; b < 2; ++b)
#pragma unroll
            for (int m = 0; m < 4; ++m)
#pragma unroll
                for (int n = 0; n < 2; ++n) acc[a][b][m][n] = (f32x4){0.f, 0.f, 0.f, 0.f};
    bf16x8 At[4][2], B0[2][2], B1[2][2];
    const char* cA = (const char*)g.A + (size_t)cur.pm * tstep; const char* cB = (const char*)g.Bt + (size_t)cur.pn * tstep;
    S.a_ready(cur);
    PG8_STAGE(PG8_SB(0, 0), cB, voffB); PG8_STAGE(PG8_SA(0, 0), cA, voffA); PG8_STAGE(PG8_SB(0, 1), cB + hstep, voffB); PG8_STAGE(PG8_SA(0, 1), cA + hstep, voffA);
    if (wr == 1) PG8_BAR;
    PG8_WAIT_V(4); PG8_BAR;
    PG8_STAGE(PG8_SB(1, 0), cB + kstep, voffB); PG8_STAGE(PG8_SA(1, 0), cA + kstep, voffA); PG8_STAGE(PG8_SB(1, 1), cB + hstep + kstep, voffB);
    PG8_WAIT_V(6); PG8_BAR;
    for (;;) {
        const bool has_next = S.next(ui + 1, nxt);
        const char* nA = has_next ? (const char*)g.A + (size_t)nxt.pm * tstep : cA; const char* nB = has_next ? (const char*)g.Bt + (size_t)nxt.pn * tstep : cB;
        for (int t = 0; t < nt; t += 2) {
            const bool last = (t == nt - 2);
            const char* a1 = cA + (size_t)(t + 1) * kstep;
            const char* a2 = last ? nA : cA + (size_t)(t + 2) * kstep; const char* b2 = last ? nB : cB + (size_t)(t + 2) * kstep;
            const char* a3 = a2 + kstep; const char* b3 = b2 + kstep;
            if (last && has_next) S.a_ready(nxt);
            PG8_LDB(B0, 0, 0); PG8_SCHED; PG8_LDA(At, 0, 0); PG8_STAGE(PG8_SA(1, 1), a1 + hstep, voffA);
            PG8_WAIT_L(8); PG8_BAR; PG8_WAIT_L(0); PG8_MMA(0, 0, At, B0); PG8_BAR; PG8_SCHED;
            PG8_LDB(B1, 0, 1); PG8_STAGE(PG8_SB(0, 0), b2, voffB);
            PG8_BAR; PG8_WAIT_L(0); PG8_MMA(0, 1, At, B1); PG8_BAR;
            PG8_LDA(At, 0, 1); PG8_STAGE(PG8_SA(0, 0), a2, voffA);
            PG8_BAR; PG8_WAIT_L(0); PG8_MMA(1, 0, At, B0); PG8_BAR; PG8_SCHED;
            PG8_STAGE(PG8_SB(0, 1), b2 + hstep, voffB);
            PG8_WAIT_V(6); PG8_BAR; PG8_MMA(1, 1, At, B1); PG8_BAR;
            PG8_LDB(B0, 1, 0); PG8_SCHED; PG8_LDA(At, 1, 0); PG8_STAGE(PG8_SA(0, 1), a2 + hstep, voffA);
            PG8_WAIT_L(8); PG8_BAR; PG8_WAIT_L(0); PG8_MMA(0, 0, At, B0); PG8_BAR; PG8_SCHED;
            PG8_LDB(B1, 1, 1); PG8_STAGE(PG8_SB(1, 0), b3, voffB);
            PG8_BAR; PG8_WAIT_L(0); PG8_MMA(0, 1, At, B1); PG8_BAR;
            PG8_LDA(At, 1, 1); PG8_STAGE(PG8_SA(1, 0), a3, voffA);
            PG8_BAR; PG8_WAIT_L(0); PG8_MMA(1, 0, At, B0); PG8_BAR; PG8_SCHED;
            PG8_STAGE(PG8_SB(1, 1), b3 + hstep, voffB);
            PG8_WAIT_V(6); PG8_BAR; PG8_MMA(1, 1, At, B1); PG8_BAR;
        }
        if constexpr (!Epi::AFTER_DRAIN) { E(acc, cur, wr, wc, fr, fq); S.done(cur); }
        if (!has_next) break;
#pragma unroll
        for (int a = 0; a < 2; ++a)
#pragma unroll
            for (int b = 0; b < 2; ++b)
#pragma unroll
                for (int m = 0; m < 4; ++m)
#pragma unroll
                    for (int n = 0; n < 2; ++n) acc[a][b][m][n] = (f32x4){0.f, 0.f, 0.f, 0.f};
        cur = nxt; cA = nA; cB = nB; ++ui;
    }
    PG8_WAIT_V(0);
    if (wr == 0) PG8_BAR;
    PG8_BAR;
    if constexpr (Epi::AFTER_DRAIN) { E.fused(acc, cur, wr, wc, fr, fq, lds, wid, lane); S.done(cur); }
#undef PG8_SA
#undef PG8_SB
#undef PG8_STAGE
#undef PG8_LDA
#undef PG8_LDB
#undef PG8_MMA
#undef PG8_WAIT_V
#undef PG8_WAIT_L
#undef PG8_BAR
#undef PG8_SCHED
}
}
using pg8::Unit;
typedef f32x4 Acc[2][2][4][2];

template <class F> DI void store_tile_bf16(const Acc& acc, bf16_t* dst, int ld, int coloff, const Unit& u, int wr, int wc, int fr, int fq, F f) {
    const int row0 = u.pm * 256 + wr * 64 + fr, col0 = coloff + wc * 32 + 4 * fq;
#pragma unroll
    for (int ai = 0; ai < 2; ++ai)
#pragma unroll
        for (int m = 0; m < 4; ++m) { bf16_t* rp = dst + (size_t)(row0 + ai * 128 + m * 16) * ld + col0;
#pragma unroll
            for (int bj = 0; bj < 2; ++bj)
#pragma unroll
                for (int n = 0; n < 2; ++n) { const f32x4 v = acc[ai][bj][m][n]; u32x2 w; w.x = pk2(f(v[0]), f(v[1])); w.y = pk2(f(v[2]), f(v[3])); *(u32x2*)(rp + bj * 128 + n * 16) = w; } }
}

struct EpiSwiglu {
    static constexpr bool PERM = false, AFTER_DRAIN = false;
    bf16_t* act;
    DI void operator()(const Acc& acc, const Unit& u, int wr, int wc, int fr, int fq) const {
        const int row0 = u.pm * 256 + wr * 64 + fr, col0 = u.pn * 128 + wc * 32 + 4 * fq;
#pragma unroll
        for (int ai = 0; ai < 2; ++ai)
#pragma unroll
            for (int m = 0; m < 4; ++m) { bf16_t* rp = act + (size_t)(row0 + ai * 128 + m * 16) * DFF_ + col0;
#pragma unroll
                for (int n = 0; n < 2; ++n) { const f32x4 g = acc[ai][0][m][n], up = acc[ai][1][m][n]; u32x2 w;
                    w.x = pk2(silu_f(g[0]) * up[0], silu_f(g[1]) * up[1]); w.y = pk2(silu_f(g[2]) * up[2], silu_f(g[3]) * up[3]); *(u32x2*)(rp + n * 16) = w; } }
    }
};

struct EpiResid {
    static constexpr bool PERM = false, AFTER_DRAIN = false;
    const float* xin_p; const float* xin_s; float* xout; const float* gate; float scale;
    DI void operator()(const Acc& acc, const Unit& u, int wr, int wc, int fr, int fq) const {
        const int row0 = u.pm * 256 + wr * 64 + fr, col0 = u.pn * 256 + wc * 32 + 4 * fq;
        const int ci = u.pm < 32 ? 0 : 1 + ((u.pm - 32) >> 3);
        const float* gt = gate + (size_t)ci * 9216 + col0;
        f32x4 gv[2][2];
#pragma unroll
        for (int bj = 0; bj < 2; ++bj)
#pragma unroll
            for (int n = 0; n < 2; ++n) gv[bj][n] = *(const f32x4*)(gt + bj * 128 + n * 16) * scale;
#pragma unroll
        for (int ai = 0; ai < 2; ++ai)
#pragma unroll
            for (int m = 0; m < 4; ++m) { const int row = row0 + ai * 128 + m * 16;
                const float* ip = (row < MP_ ? xin_p + (size_t)row * D_ : xin_s + (size_t)(row - MP_) * D_) + col0; float* op = xout + (size_t)row * D_ + col0;
#pragma unroll
                for (int bj = 0; bj < 2; ++bj)
#pragma unroll
                    for (int n = 0; n < 2; ++n) { const f32x4 xv = *(const f32x4*)(ip + bj * 128 + n * 16); *(f32x4*)(op + bj * 128 + n * 16) = xv + gv[bj][n] * acc[ai][bj][m][n]; } }
    }
};

DI void rope_pair(f32x4& x1, f32x4& x2, const float* tab, int pos, int fq) {
    const f32x4 t0 = *(const f32x4*)(tab + (pos * 16 + 4 * fq) * 2), t1 = *(const f32x4*)(tab + (pos * 16 + 4 * fq) * 2 + 4);
    const float c[4] = {t0[0], t0[2], t1[0], t1[2]}, s[4] = {t0[1], t0[3], t1[1], t1[3]};
#pragma unroll
    for (int j = 0; j < 4; ++j) { const float a = x1[j], b = x2[j]; x1[j] = a * c[j] - b * s[j]; x2[j] = a * s[j] + b * c[j]; }
}

struct EpiInEven {
    static constexpr bool PERM = false, AFTER_DRAIN = false;
    unsigned char* wsb; const float* rope;
    DI void operator()(const Acc& acc, const Unit& u, int wr, int wc, int fr, int fq) const {
        const int pn = u.pn;
        if (pn < 2) {
            bf16_t* dst = (bf16_t*)(wsb + (pn == 0 ? A_QA : A_KA)); const float sc = pn == 0 ? 1.f : 0.125f; const bool lat = u.pm >= 32;
            const int row0 = u.pm * 256 + wr * 64 + fr, col0 = wc * 32 + 4 * fq;
#pragma unroll
            for (int ai = 0; ai < 2; ++ai)
#pragma unroll
                for (int m = 0; m < 4; ++m) { const int row = row0 + ai * 128 + m * 16; const int t = (row - MP_) & 2047; const int pos = (wc & 1) ? (t & 63) : (t >> 6);
#pragma unroll
                    for (int bj = 0; bj < 2; ++bj) { f32x4 x1 = acc[ai][bj][m][0], x2 = acc[ai][bj][m][1];
                        if (lat) rope_pair(x1, x2, rope, pos, fq);
                        bf16_t* rp = dst + (size_t)row * 256 + bj * 128 + col0; u32x2 w;
                        w.x = pk2(x1[0] * sc, x1[1] * sc); w.y = pk2(x1[2] * sc, x1[3] * sc); *(u32x2*)rp = w;
                        w.x = pk2(x2[0] * sc, x2[1] * sc); w.y = pk2(x2[2] * sc, x2[3] * sc); *(u32x2*)(rp + 16) = w; } }
        } else if (pn < 4) { store_tile_bf16(acc, (bf16_t*)(wsb + A_VA), 512, (pn - 2) * 256, u, wr, wc, fr, fq, [](float x) { return x; });
        } else if (pn < 6) { store_tile_bf16(acc, (bf16_t*)(wsb + A_GA), 512, (pn - 4) * 256, u, wr, wc, fr, fq, [](float x) { return silu_f(x); });
        } else { store_tile_bf16(acc, (bf16_t*)(wsb + A_PB), 1792, (pn - 6) * 256, u, wr, wc, fr, fq, [](float x) { return x; }); }
    }
};

struct EpiInOdd {
    static constexpr bool PERM = false, AFTER_DRAIN = false;
    unsigned char* wsb; const float* rope; const float* qk_gain; const float* ibias; const float* fbias; float* outb;
    DI void operator()(const Acc& acc, const Unit& u, int wr, int wc, int fr, int fq) const {
        const int pn = u.pn;
        if (pn < 2) { store_tile_bf16(acc, (bf16_t*)(wsb + O_QC), 512, pn * 256, u, wr, wc, fr, fq, [](float x) { return x; });
        } else if (pn < 4) { store_tile_bf16(acc, (bf16_t*)(wsb + O_KC), 512, (pn - 2) * 256, u, wr, wc, fr, fq, [](float x) { return x * 0.08838834764831845f; });
        } else if (pn < 6) { store_tile_bf16(acc, (bf16_t*)(wsb + O_VC), 512, (pn - 4) * 256, u, wr, wc, fr, fq, [](float x) { return x; });
        } else if (pn < 8) { store_tile_bf16(acc, (bf16_t*)(wsb + O_OC), 512, (pn - 6) * 256, u, wr, wc, fr, fq, [](float x) { return sigmoid_f(x); });
        } else if (pn < 11) {
            const bool lat = u.pm >= 32; const bool isv = (pn == 10) && (wc >= 2); const bool isk = (pn == 10) && (wc < 2);
            const float* gain = qk_gain + (isk ? 64 : 0);
            const int row0 = u.pm * 256 + wr * 64 + fr;
#pragma unroll
            for (int ai = 0; ai < 2; ++ai)
#pragma unroll
                for (int m = 0; m < 4; ++m) { const int row = row0 + ai * 128 + m * 16;
                    f32x4 v[2][2];
#pragma unroll
                    for (int bj = 0; bj < 2; ++bj)
#pragma unroll
                        for (int n = 0; n < 2; ++n) v[bj][n] = acc[ai][bj][m][n];
                    if (!isv) {
                        float ss = 0.f;
#pragma unroll
                        for (int bj = 0; bj < 2; ++bj)
#pragma unroll
                            for (int n = 0; n < 2; ++n)
#pragma unroll
                                for (int j = 0; j < 4; ++j) ss += v[bj][n][j] * v[bj][n][j];
                        ss = fq_sum(ss);
                        const float rs = rsqrtf(ss * (1.f / 64.f) + 1e-6f);
#pragma unroll
                        for (int bj = 0; bj < 2; ++bj)
#pragma unroll
                            for (int n = 0; n < 2; ++n) v[bj][n] = v[bj][n] * rs * *(const f32x4*)(gain + 32 * bj + 16 * n + 4 * fq);
                    }
                    if (!lat && pn == 10) {
                        const int b = row >> 8, t = row & 255, hh = wc & 1; float* op = outb + (isk ? OUT_CK : OUT_CV) + ((size_t)(b * 2 + hh) * 256 + t) * 64 + 4 * fq;
#pragma unroll
                        for (int bj = 0; bj < 2; ++bj)
#pragma unroll
                            for (int n = 0; n < 2; ++n) *(f32x4*)(op + 32 * bj + 16 * n) = v[bj][n];
                    }
                    if (lat && !isv) { const int t = (row - MP_) & 2047; rope_pair(v[0][0], v[0][1], rope, t >> 6, fq); rope_pair(v[1][0], v[1][1], rope, t & 63, fq); }
                    bf16_t* rp;
                    if (pn < 10) rp = (bf16_t*)(wsb + O_QD) + (size_t)row * 512 + (4 * (pn - 8) + wc) * 64 + 4 * fq;
                    else rp = (bf16_t*)(wsb + (isk ? O_KD : O_VD)) + (size_t)row * 128 + (wc & 1) * 64 + 4 * fq;
#pragma unroll
                    for (int bj = 0; bj < 2; ++bj)
#pragma unroll
                        for (int n = 0; n < 2; ++n) { u32x2 w; w.x = pk2(v[bj][n][0], v[bj][n][1]); w.y = pk2(v[bj][n][2], v[bj][n][3]); *(u32x2*)(rp + 32 * bj + 16 * n) = w; }
                }
        } else {
            if (wc == 0) {
                const int row0 = u.pm * 256 + wr * 64 + fr; const int c0 = 4 * fq;
                const f32x4 bias = c0 < 8 ? *(const f32x4*)(ibias + c0) : *(const f32x4*)(fbias + c0 - 8);
#pragma unroll
                for (int ai = 0; ai < 2; ++ai)
#pragma unroll
                    for (int m = 0; m < 4; ++m) { const int row = row0 + ai * 128 + m * 16; f32x4 v = acc[ai][0][m][0] + bias;
                        if (c0 >= 8) { v[0] = -softplus_f(-v[0]); v[1] = -softplus_f(-v[1]); v[2] = -softplus_f(-v[2]); v[3] = -softplus_f(-v[3]); }
                        *(f32x4*)((float*)(wsb + O_GT) + (size_t)row * 16 + c0) = v; }
            }
        }
    }
};

struct EpiLora {
    static constexpr bool PERM = false, AFTER_DRAIN = false;
    unsigned char* wsb; const float* w0; const float* a0b;
    DI void operator()(const Acc& acc, const Unit& u, int wr, int wc, int fr, int fq) const {
        const int pn = u.pn;
        if (pn >= 8) { store_tile_bf16(acc, (bf16_t*)(wsb + A_G), 512, (pn - 8) * 256, u, wr, wc, fr, fq, [](float x) { return x; }); return; }
        const int d = (pn >> 1) & 1, cb = (pn & 1) * 256; const bool isw = pn < 4;
        bf16_t* dst = (bf16_t*)(wsb + (isw ? (d ? A_U1 : A_U0) : (d ? A_A1 : A_A0))); const int boff = d * 512 + cb;
        const int row0 = u.pm * 256 + wr * 64 + fr, col0 = wc * 32 + 4 * fq;
#pragma unroll
        for (int ai = 0; ai < 2; ++ai)
#pragma unroll
            for (int m = 0; m < 4; ++m) { bf16_t* rp = dst + (size_t)(row0 + ai * 128 + m * 16) * 512 + cb + col0;
#pragma unroll
                for (int bj = 0; bj < 2; ++bj)
#pragma unroll
                    for (int n = 0; n < 2; ++n) { const float* bp = (isw ? w0 : a0b) + boff + col0 + bj * 128 + n * 16; f32x4 v = acc[ai][bj][m][n] + *(const f32x4*)bp;
#pragma unroll
                        for (int j = 0; j < 4; ++j) { const float ez = __expf(-v[j]); const float sg = __builtin_amdgcn_rcpf(1.f + ez); v[j] = isw ? sg * 0.6065306597f : sg; }
                        u32x2 w; w.x = pk2(v[0], v[1]); w.y = pk2(v[2], v[3]); *(u32x2*)(rp + bj * 128 + n * 16) = w; } }
    }
};
DI int map_col(int kind, int n) {
    if (kind == 0) return n;
    if (kind == 1) { const int pn = n >> 8, bj = (n >> 7) & 1, q = n & 127; return bj * DFF_ + pn * 128 + q; }
    const int pn = n >> 8, tc = n & 255;
    if (pn < 6) return n;
    if (pn < 8) return 1552 + (n - 1536);
    const int hh = (tc & 127) >> 5, bj = tc >> 7, d = 32 * bj + (tc & 31);
    if (pn < 10) return 2064 + (4 * (pn - 8) + hh) * 64 + d;
    if (pn == 10) return hh < 2 ? 2576 + hh * 64 + d : 2704 + (hh - 2) * 64 + d;
    return tc < 16 ? 1536 + tc : -1;
}
DI void conv_load(float (&r)[8], const float* src, int ld, int K, int kind, int tile, int tid) {
    const int tk = K >> 6, n0 = (tile / tk) << 6, k0 = (tile % tk) << 6;
#pragma unroll
    for (int q = 0; q < 8; ++q) { const int e = tid + 512 * q; const int kk = e >> 6, nn = e & 63; const int col = map_col(kind, n0 + nn); r[q] = col >= 0 ? __builtin_nontemporal_load(src + (size_t)(k0 + kk) * ld + col) : 0.f; }
}
DI void conv_finish(const float (&r)[8], bf16_t* dst, int K, int tile, LAS float* T, int tid) {
    const int tk = K >> 6, n0 = (tile / tk) << 6, k0 = (tile % tk) << 6;
    __syncthreads();
#pragma unroll
    for (int q = 0; q < 8; ++q) { const int e = tid + 512 * q; T[(e >> 6) * 65 + (e & 63)] = r[q]; }
    __syncthreads();
    for (int e = tid; e < 2048; e += 512) { const int nn = e >> 5, kp = e & 31; *(unsigned*)(dst + (size_t)(n0 + nn) * K + k0 + 2 * kp) = pk2(T[(2 * kp) * 65 + nn], T[(2 * kp + 1) * 65 + nn]); }
}
DI void conv_tile(const float* src, int ld, bf16_t* dst, int K, int kind, int tile, LAS float* T, int tid) {
    float r[8]; conv_load(r, src, ld, K, kind, tile, tid); conv_finish(r, dst, K, tile, T, tid);
}
struct ConvJob { const float* src; int ld; bf16_t* dst; int K, N, kind; };
DI void convert_layer(KParams& P, int l, LAS unsigned char* lds, int tid, int mask) {
    unsigned char* ws = P.ws;
    ConvJob jobs[6];
    jobs[0] = {P.in[14] + (size_t)(l * 2 + 0) * D_ * 2 * DFF_, 2 * DFF_, (bf16_t*)(ws + W_W1A), D_, 2 * DFF_, 1};
    jobs[1] = {P.in[14] + (size_t)(l * 2 + 1) * D_ * 2 * DFF_, 2 * DFF_, (bf16_t*)(ws + W_W1B), D_, 2 * DFF_, 1};
    jobs[2] = {P.in[15] + (size_t)(l * 2 + 0) * DFF_ * D_, D_, (bf16_t*)(ws + W_W2A), DFF_, D_, 0};
    jobs[3] = {P.in[15] + (size_t)(l * 2 + 1) * DFF_ * D_, D_, (bf16_t*)(ws + W_W2B), DFF_, D_, 0};
    if (l == 0) { jobs[4] = {P.in[16], 3328, (bf16_t*)(ws + W_WIN), D_, 3328, 0}; jobs[5] = {P.in[17], D_, (bf16_t*)(ws + W_WOUT), D_, D_, 0}; }
    else        { jobs[4] = {P.in[31], 2832, (bf16_t*)(ws + W_WIN), D_, 3072, 3}; jobs[5] = {P.in[32], D_, (bf16_t*)(ws + W_WOUT), D_, D_, 0}; }
    LAS float* T = (LAS float*)lds;
#pragma unroll
    for (int j = 0; j < 6; ++j) { if (!((mask >> j) & 1)) continue; const ConvJob J = jobs[j]; const int nt = (J.N >> 6) * (J.K >> 6);
        int t = blockIdx.x; float r0[8], r1[8];
        if (t < nt) conv_load(r0, J.src, J.ld, J.K, J.kind, t, tid);
        for (; t < nt; t += 2 * (int)gridDim.x) {
            const int t1 = t + (int)gridDim.x, t2 = t1 + (int)gridDim.x;
            if (t1 < nt) conv_load(r1, J.src, J.ld, J.K, J.kind, t1, tid);
            conv_finish(r0, J.dst, J.K, t, T, tid);
            if (t2 < nt) conv_load(r0, J.src, J.ld, J.K, J.kind, t2, tid);
            if (t1 < nt) conv_finish(r1, J.dst, J.K, t1, T, tid);
        } }
    if (l == 0) {
        bf16_t* wl = (bf16_t*)(ws + W_WL); const float* w2 = P.in[22]; const float* a2 = P.in[24]; const float* g2 = P.in[25];
        for (int e = blockIdx.x * 512 + tid; e < 2560 * 128; e += gridDim.x * 512) { const int n = e >> 7, k = (e & 127) * 2; const int sel = n >> 9, c = n & 511; float v0 = 0.f, v1 = 0.f;
            if (sel < 2) { if (k < 64) { v0 = w2[(size_t)(sel * 64 + k) * 512 + c]; v1 = w2[(size_t)(sel * 64 + k + 1) * 512 + c]; } }
            else if (sel < 4) { if (k >= 64 && k < 128) { v0 = a2[(size_t)((sel - 2) * 64 + k - 64) * 512 + c]; v1 = a2[(size_t)((sel - 2) * 64 + k - 63) * 512 + c]; } }
            else { if (k >= 128) { v0 = g2[(size_t)(k - 128) * 512 + c]; v1 = g2[(size_t)(k - 127) * 512 + c]; } }
            *(unsigned*)(wl + (size_t)n * 256 + k) = pk2(v0, v1); }
    }
}


DI void conv_l1_early_item(KParams& P, int idx, LAS unsigned char* lds, int tid) {
    LAS float* T = (LAS float*)lds;
    if (idx < 1408) conv_tile(P.in[14] + (size_t)(1 * 2 + 0) * D_ * 2 * DFF_, 2 * DFF_, (bf16_t*)(P.ws + W_W1A), D_, 1, idx, T, tid);
    else if (idx < 2112) conv_tile(P.in[15] + (size_t)(1 * 2 + 0) * DFF_ * D_, D_, (bf16_t*)(P.ws + W_W2A), DFF_, 0, idx - 1408, T, tid);
    else conv_tile(P.in[31], 2832, (bf16_t*)(P.ws + W_WIN), D_, 3, idx - 2112, T, tid);
}
DI void mod_phase(KParams& P, LAS unsigned char* lds, int tid) {
    LAS float* sc = (LAS float*)lds;
    LAS float* red = sc + 9 * 1024;
    const float* c = P.in[9]; const float* cctx = P.in[10];
    for (int e = tid; e < 9 * 1024; e += 512) { const int ci = e >> 10, k = e & 1023; const float v = ci == 0 ? cctx[k] : c[(ci - 1) * 1024 + k]; sc[e] = silu_f(v); }
    __syncthreads();
    float* mod = (float*)(P.ws + WS_MOD);
    const int wid = tid >> 6, lane = tid & 63;
    for (int it = blockIdx.x; it < 288; it += gridDim.x) { const int l = it / 144, n0 = (it % 144) * 64;
        const float* w = P.in[11] + (size_t)l * D_ * 9216 + n0 + lane;
        float acc[9];
#pragma unroll
        for (int i = 0; i < 9; ++i) acc[i] = 0.f;
        for (int k = wid * 128; k < wid * 128 + 128; k += 16) {
            float wv[16];
#pragma unroll
            for (int q = 0; q < 16; ++q) wv[q] = __builtin_nontemporal_load(w + (size_t)(k + q) * 9216);
#pragma unroll
            for (int q = 0; q < 16; ++q)
#pragma unroll
                for (int i = 0; i < 9; ++i) acc[i] += sc[i * 1024 + k + q] * wv[q];
        }
#pragma unroll
        for (int i = 0; i < 9; ++i) red[(wid * 9 + i) * 64 + lane] = acc[i];
        __syncthreads();
        for (int o = tid; o < 576; o += 512) { const int i = o >> 6, ln = o & 63; float s = 0.f;
#pragma unroll
            for (int w8 = 0; w8 < 8; ++w8) s += red[(w8 * 9 + i) * 64 + ln];
            mod[(size_t)(l * 9 + i) * 9216 + n0 + ln] = s + P.in[12][(size_t)l * 9216 + n0 + ln]; }
        __syncthreads();
    }
}

DI void norm_phase(const float* xp, const float* xs, bf16_t* h, const float* g, const float* modl, int qsh, int tid) {
    const int wid = tid >> 6, lane = tid & 63; const int stride = gridDim.x * 8;
    int row = blockIdx.x * 8 + wid;
    f32x4 v[4], nv[4];
    if (row < M_) { const float* xr = row < MP_ ? xp + (size_t)row * D_ : xs + (size_t)(row - MP_) * D_;
#pragma unroll
        for (int i = 0; i < 4; ++i) v[i] = *(const f32x4*)(xr + 4 * lane + 256 * i); }
    for (; row < M_; row += stride) {
        const int nrow = row + stride;
        if (nrow < M_) { const float* xr = nrow < MP_ ? xp + (size_t)nrow * D_ : xs + (size_t)(nrow - MP_) * D_;
#pragma unroll
            for (int i = 0; i < 4; ++i) nv[i] = *(const f32x4*)(xr + 4 * lane + 256 * i); }
        const float* sh = modl + (size_t)cond_of_row(row) * 9216 + qsh * 1024; const float* sc = sh + 1024;
        float ss = 0.f;
#pragma unroll
        for (int i = 0; i < 4; ++i) ss += v[i][0] * v[i][0] + v[i][1] * v[i][1] + v[i][2] * v[i][2] + v[i][3] * v[i][3];
        ss = wave_sum(ss); const float rs = rsqrtf(ss * (1.f / 1024.f) + 1e-6f);
#pragma unroll
        for (int i = 0; i < 4; ++i) { const int c = 4 * lane + 256 * i; const f32x4 gg = *(const f32x4*)(g + c), s1 = *(const f32x4*)(sc + c), s0 = *(const f32x4*)(sh + c);
            const f32x4 y = v[i] * rs * gg * (s1 + 1.f) + s0; u32x2 w; w.x = pk2(y[0], y[1]); w.y = pk2(y[2], y[3]); *(u32x2*)(h + (size_t)row * D_ + c) = w; }
#pragma unroll
        for (int i = 0; i < 4; ++i) v[i] = nv[i];
    }
}
DI void final_norm_phase(float* x, const float* g, int tid) {
    const int wid = tid >> 6, lane = tid & 63; const int stride = gridDim.x * 8;
    int row = blockIdx.x * 8 + wid;
    f32x4 v[4], nv[4];
    if (row < M_) {
#pragma unroll
        for (int i = 0; i < 4; ++i) v[i] = *(const f32x4*)(x + (size_t)row * D_ + 4 * lane + 256 * i); }
    for (; row < M_; row += stride) {
        const int nrow = row + stride;
        if (nrow < M_) {
#pragma unroll
            for (int i = 0; i < 4; ++i) nv[i] = *(const f32x4*)(x + (size_t)nrow * D_ + 4 * lane + 256 * i); }
        float* xr = x + (size_t)row * D_; float ss = 0.f;
#pragma unroll
        for (int i = 0; i < 4; ++i) ss += v[i][0] * v[i][0] + v[i][1] * v[i][1] + v[i][2] * v[i][2] + v[i][3] * v[i][3];
        ss = wave_sum(ss); const float rs = rsqrtf(ss * (1.f / 1024.f) + 1e-6f);
#pragma unroll
        for (int i = 0; i < 4; ++i) { const int c = 4 * lane + 256 * i; *(f32x4*)(xr + c) = v[i] * rs * *(const f32x4*)(g + c); }
#pragma unroll
        for (int i = 0; i < 4; ++i) v[i] = nv[i];
    }
}
#define MFMA16(a, b, c) __builtin_amdgcn_mfma_f32_16x16x32_bf16((a), (b), (c), 0, 0, 0)
template <int COLS> DI void stage_bf16(LAS bf16_t* dst, const bf16_t* src, size_t ldg, int rows, int pitch, int tid) {
    constexpr int PR = COLS / 8;
    for (int p = tid; p < rows * PR; p += 512) { const int r = p / PR, c8 = p % PR; const u32x4 v = *(const u32x4*)(src + (size_t)r * ldg + c8 * 8); *(LAS u32x4*)(dst + r * pitch + c8 * 8) = v; }
}
template <int COLS> DI void stage_f32(LAS bf16_t* dst, const float* src, size_t ldg, int rows, int pitch, int tid) {
    constexpr int PR = COLS / 4;
    for (int p = tid; p < rows * PR; p += 512) { const int r = p / PR, c4 = p % PR; const f32x4 v = *(const f32x4*)(src + (size_t)r * ldg + c4 * 4); u32x2 w; w.x = pk2(v[0], v[1]); w.y = pk2(v[2], v[3]); *(LAS u32x2*)(dst + r * pitch + c4 * 4) = w; }
}

template <int COLS> DI void tile_load(u32x4 (&r)[COLS / 32], const bf16_t* src, size_t ldg, int tid) {
    constexpr int PR = COLS / 8;
#pragma unroll
    for (int i = 0; i < COLS / 32; ++i) { const int p = tid + 512 * i; r[i] = *(const u32x4*)(src + (size_t)(p / PR) * ldg + (p % PR) * 8); }
}
template <int COLS> DI void tile_store(LAS bf16_t* dst, const u32x4 (&r)[COLS / 32], int pitch, int tid) {
    constexpr int PR = COLS / 8;
#pragma unroll
    for (int i = 0; i < COLS / 32; ++i) { const int p = tid + 512 * i; *(LAS u32x4*)(dst + (p / PR) * pitch + (p % PR) * 8) = r[i]; }
}
DI void tile_load_f32x64(f32x4 (&r)[4], const float* src, int tid) {
#pragma unroll
    for (int i = 0; i < 4; ++i) r[i] = *(const f32x4*)(src + (size_t)(tid + 512 * i) * 4);
}
DI void tile_store_f32x64(LAS bf16_t* dst, const f32x4 (&r)[4], int pitch, int tid) {
#pragma unroll
    for (int i = 0; i < 4; ++i) { const int p = tid + 512 * i; u32x2 w; w.x = pk2(r[i][0], r[i][1]); w.y = pk2(r[i][2], r[i][3]); *(LAS u32x2*)(dst + (p >> 4) * pitch + (p & 15) * 4) = w; }
}
template <int DK> DI void qk_tile(const LAS bf16_t* sK, const bf16x8 (&qf)[DK / 32], f32x4 (&sacc)[8], int fr, int fq) {
#pragma unroll
    for (int jt = 0; jt < 8; ++jt) { f32x4 a = {0.f, 0.f, 0.f, 0.f};
#pragma unroll
        for (int s = 0; s < DK / 32; ++s) { const bf16x8 kf = *(const LAS bf16x8*)(sK + (16 * jt + fr) * (DK + 8) + 32 * s + 8 * fq); a = MFMA16(kf, qf[s], a); }
        sacc[jt] = a; }
}
template <int DV, int PITCH = DV + 8> DI void pv_tile(const LAS bf16_t* sV, const bf16x8 (&pf)[4], f32x4 (&oacc)[DV / 16], int fr, int fq) {
#pragma unroll
    for (int et = 0; et < DV / 16; ++et)
#pragma unroll
        for (int s = 0; s < 4; ++s) {
            const LAS bf16_t* p0 = sV + (32 * s + 4 * fq + (fr >> 2)) * PITCH + 16 * et + 4 * (fr & 3);
            const s16x4 lo = __builtin_amdgcn_ds_read_tr16_b64_v4i16((LAS s16x4*)p0), hi = __builtin_amdgcn_ds_read_tr16_b64_v4i16((LAS s16x4*)(p0 + 16 * PITCH));
            const bf16x8 vf = __builtin_shufflevector(lo, hi, 0, 1, 2, 3, 4, 5, 6, 7);
            oacc[et] = MFMA16(vf, pf[s], oacc[et]); }
}
DI void pack_p(const f32x4 (&p)[8], bf16x8 (&pf)[4]) {
#pragma unroll
    for (int s = 0; s < 4; ++s) { u32x4 w; w.x = pk2(p[2 * s][0], p[2 * s][1]); w.y = pk2(p[2 * s][2], p[2 * s][3]); w.z = pk2(p[2 * s + 1][0], p[2 * s + 1][1]); w.w = pk2(p[2 * s + 1][2], p[2 * s + 1][3]); pf[s] = __builtin_bit_cast(bf16x8, w); }
}
template <int DKQ> DI void pack_q_state(const bf16_t* qrow, float f0, float f1, bf16x8 (&pf)[4], f32x4 (&pv)[8], int fq) {
#pragma unroll
    for (int s = 0; s < 4; ++s)
#pragma unroll
        for (int hh = 0; hh < 2; ++hh) { const int key = 32 * s + 16 * hh + 4 * fq; const int d = DKQ == 64 ? (key & 63) : key; const float fac = (DKQ == 64 && key >= 64) ? f1 : f0;
            const u32x2 w = *(const u32x2*)(qrow + d); f32x4 v; v[0] = bf_lo(w.x) * fac; v[1] = bf_hi(w.x) * fac; v[2] = bf_lo(w.y) * fac; v[3] = bf_hi(w.y) * fac; pv[2 * s + hh] = v; }
    pack_p(pv, pf);
}
DI void ln_gate_store(f32x4 (&o)[8], float eps, const float* wgt, const bf16_t* gate, bf16_t* dst, int fq) {
    float s = 0.f;
#pragma unroll
    for (int et = 0; et < 8; ++et) s += o[et][0] + o[et][1] + o[et][2] + o[et][3];
    s = fq_sum(s); const float mu = s * (1.f / 128.f); float vs = 0.f;
#pragma unroll
    for (int et = 0; et < 8; ++et)
#pragma unroll
        for (int j = 0; j < 4; ++j) { const float d = o[et][j] - mu; vs += d * d; }
    vs = fq_sum(vs); const float rs = rsqrtf(vs * (1.f / 128.f) + eps);
#pragma unroll
    for (int et = 0; et < 8; ++et) { const int e = 16 * et + 4 * fq; const f32x4 wv = *(const f32x4*)(wgt + e); const u32x2 gw = *(const u32x2*)(gate + e);
        u32x2 w; w.x = pk2((o[et][0] - mu) * rs * wv[0] * bf_lo(gw.x), (o[et][1] - mu) * rs * wv[1] * bf_hi(gw.x));
        w.y = pk2((o[et][2] - mu) * rs * wv[2] * bf_lo(gw.y), (o[et][3] - mu) * rs * wv[3] * bf_hi(gw.y)); *(u32x2*)(dst + e) = w; }
}


template <int DK> DI void state_mfma(const bf16_t* kg, size_t ldk, const bf16_t* vg, size_t ldv, const LAS float* wj, LAS unsigned char* lds, float* out, float* nout, int tid) {
    constexpr int PK = DK == 128 ? 144 : 72, NE = DK == 128 ? 8 : 4, PR = DK / 8;
    const int wid = tid >> 6, lane = tid & 63, fr = lane & 15, fq = lane >> 4;
    const int dt = DK == 128 ? wid : (wid & 3), e0 = DK == 128 ? 0 : (wid >> 2) * 4;
    LAS bf16_t* sKw = (LAS bf16_t*)lds; LAS bf16_t* sV = (LAS bf16_t*)(lds + 36864);
    f32x4 acc[NE];
#pragma unroll
    for (int i = 0; i < NE; ++i) acc[i] = (f32x4){0.f, 0.f, 0.f, 0.f};
    float nacc = 0.f;
#pragma unroll 1
    for (int hf = 0; hf < 2; ++hf) {
        __syncthreads();
        for (int p = tid; p < 128 * PR; p += 512) { const int r = p / PR, c8 = p % PR; const u32x4 v = *(const u32x4*)(kg + (size_t)(128 * hf + r) * ldk + c8 * 8); const float w = wj[128 * hf + r];
            u32x4 o; o.x = pk2(bf_lo(v.x) * w, bf_hi(v.x) * w); o.y = pk2(bf_lo(v.y) * w, bf_hi(v.y) * w); o.z = pk2(bf_lo(v.z) * w, bf_hi(v.z) * w); o.w = pk2(bf_lo(v.w) * w, bf_hi(v.w) * w);
            *(LAS u32x4*)(sKw + r * PK + c8 * 8) = o; }
        stage_bf16<128>(sV, vg + (size_t)(128 * hf) * ldv, ldv, 128, 144, tid);
        __syncthreads();
#pragma unroll
        for (int s = 0; s < 4; ++s) {
            const LAS bf16_t* pa = sKw + (32 * s + 4 * fq + (fr >> 2)) * PK + 16 * dt + 4 * (fr & 3);
            const s16x4 alo = __builtin_amdgcn_ds_read_tr16_b64_v4i16((LAS s16x4*)pa), ahi = __builtin_amdgcn_ds_read_tr16_b64_v4i16((LAS s16x4*)(pa + 16 * PK));
            const bf16x8 af = __builtin_shufflevector(alo, ahi, 0, 1, 2, 3, 4, 5, 6, 7);
#pragma unroll
            for (int i = 0; i < NE; ++i) {
                const LAS bf16_t* pb = sV + (32 * s + 4 * fq + (fr >> 2)) * 144 + 16 * (e0 + i) + 4 * (fr & 3);
                const s16x4 blo = __builtin_amdgcn_ds_read_tr16_b64_v4i16((LAS s16x4*)pb), bhi = __builtin_amdgcn_ds_read_tr16_b64_v4i16((LAS s16x4*)(pb + 16 * 144));
                const bf16x8 bfv = __builtin_shufflevector(blo, bhi, 0, 1, 2, 3, 4, 5, 6, 7);
                acc[i] = MFMA16(af, bfv, acc[i]); }
        }
        if (nout && tid < DK) { for (int j = 0; j < 128; ++j) nacc += bf2f(sKw[j * PK + tid]); }
    }
#pragma unroll
    for (int i = 0; i < NE; ++i)
#pragma unroll
        for (int r = 0; r < 4; ++r) out[(size_t)(16 * dt + 4 * fq + r) * 128 + 16 * (e0 + i) + fr] = acc[i][r];
    if (nout && tid < DK) nout[tid] = nacc;
}
DI void ret_item(KParams& P, int item, LAS unsigned char* lds, int tid) {
    const int wid = tid >> 6, lane = tid & 63, fr = lane & 15, fq = lane >> 4;
    int b, h, c, L, rowbase, nc; bool lat;
    if (item < 128) { b = item >> 2; h = item & 3; c = 0; L = 256; rowbase = b * 256; nc = 2; lat = false; }
    else { const int it = item - 128; b = it >> 5; h = (it >> 3) & 3; c = it & 7; L = 2048; rowbase = MP_ + b * 2048; nc = 16; lat = true; }
    const bf16_t* qA = (const bf16_t*)(P.ws + A_QA); const bf16_t* kA = (const bf16_t*)(P.ws + A_KA); const bf16_t* vA = (const bf16_t*)(P.ws + A_VA); const bf16_t* gA = (const bf16_t*)(P.ws + A_GA);
    LAS bf16_t* sK = (LAS bf16_t*)lds; LAS bf16_t* sV = (LAS bf16_t*)(lds + 128 * 72 * 2);
    const float lgf = P.in[18][h], lgb = P.in[18][4 + h];
    const float lgf2 = lgf * 1.4426950408889634f, lgb2 = lgb * 1.4426950408889634f;
    const int ti0 = 256 * c + 32 * wid + fr;
    bf16x8 qf[2][2];
#pragma unroll
    for (int it = 0; it < 2; ++it)
#pragma unroll
        for (int s = 0; s < 2; ++s) qf[it][s] = *(const bf16x8*)(qA + (size_t)(rowbase + ti0 + 16 * it) * 256 + h * 64 + 32 * s + 8 * fq);
    f32x4 oacc[2][8];
#pragma unroll
    for (int it = 0; it < 2; ++it)
#pragma unroll
        for (int et = 0; et < 8; ++et) oacc[it][et] = (f32x4){0.f, 0.f, 0.f, 0.f};
    f32x4 sacc[8]; bf16x8 pf[2][4];
    auto pv2 = [&](const LAS bf16_t* cV) {
#pragma unroll
        for (int et = 0; et < 8; ++et)
#pragma unroll
            for (int s = 0; s < 4; ++s) {
                const LAS bf16_t* p0 = cV + (32 * s + 4 * fq + (fr >> 2)) * 144 + 16 * et + 4 * (fr & 3);
                const s16x4 lo = __builtin_amdgcn_ds_read_tr16_b64_v4i16((LAS s16x4*)p0), hi = __builtin_amdgcn_ds_read_tr16_b64_v4i16((LAS s16x4*)(p0 + 16 * 144));
                const bf16x8 vf = __builtin_shufflevector(lo, hi, 0, 1, 2, 3, 4, 5, 6, 7);
                oacc[0][et] = MFMA16(vf, pf[0][s], oacc[0][et]); oacc[1][et] = MFMA16(vf, pf[1][s], oacc[1][et]); if (s == 3 && (et & 1)) __builtin_amdgcn_sched_barrier(0); } };
    {
        u32x4 rk[2], rv[4];
        const bf16_t* kg = kA + (size_t)rowbase * 256 + h * 64; const bf16_t* vg = vA + (size_t)rowbase * 512 + h * 128;
        tile_load<64>(rk, kg, 256, tid); tile_load<128>(rv, vg, 512, tid);
        __syncthreads();
        tile_store<64>(sK, rk, 72, tid); tile_store<128>(sV, rv, 144, tid);
        if (nc > 1) { tile_load<64>(rk, kg + (size_t)128 * 256, 256, tid); tile_load<128>(rv, vg + (size_t)128 * 512, 512, tid); }
        __syncthreads();
        for (int kc = 0; kc < nc; ++kc) {
            const LAS bf16_t* cK = sK + (kc & 1) * 27648; const LAS bf16_t* cV = sV + (kc & 1) * 27648;
#pragma unroll
            for (int it = 0; it < 2; ++it) {
                qk_tile<64>(cK, qf[it], sacc, fr, fq);
#pragma unroll
                for (int jt = 0; jt < 8; ++jt)
#pragma unroll
                    for (int r = 0; r < 4; ++r) { const int tj = 128 * kc + 16 * jt + 4 * fq + r; const int dl = ti0 + 16 * it - tj;
                        const float e = __builtin_amdgcn_exp2f((dl > 0 ? lgf2 : lgb2) * (float)(dl > 0 ? dl : -dl)); sacc[jt][r] *= (dl == 0 ? 2.f : e); }
                pack_p(sacc, pf[it]); }
            pv2(cV);
            { const int tl = launder_v(tid);
            if (kc + 1 < nc) { tile_store<64>(sK + ((kc + 1) & 1) * 27648, rk, 72, tl); tile_store<128>(sV + ((kc + 1) & 1) * 27648, rv, 144, tl); }
            if (kc + 2 < nc) { tile_load<64>(rk, kg + (size_t)128 * (kc + 2) * 256, 256, tl); tile_load<128>(rv, vg + (size_t)128 * (kc + 2) * 512, 512, tl); } }
            __syncthreads();
        }
    }
    if (lat) {
        __syncthreads();
        const float* s0 = P.in[2] + (size_t)b * 2 * 4 * 64 * 128;
        stage_f32<128>(sV, s0 + (size_t)(0 * 4 + h) * 64 * 128, 128, 64, 144, tid);
        stage_f32<128>(sV + 64 * 144, s0 + (size_t)(1 * 4 + h) * 64 * 128, 128, 64, 144, tid);
        __syncthreads();
#pragma unroll
        for (int it = 0; it < 2; ++it) { const int ti = ti0 + 16 * it;
            pack_q_state<64>(qA + (size_t)(rowbase + ti) * 256 + h * 64, __expf(lgf * (float)(ti + 1)), __expf(lgb * (float)(L - ti)), pf[it], sacc, fq); }
        pv2(sV);
    }
#pragma unroll
    for (int it = 0; it < 2; ++it) { const int qrow = launder_v(rowbase + ti0) + 16 * it;
        ln_gate_store(oacc[it], 1e-5f, P.in[19] + h * 128, gA + (size_t)qrow * 512 + h * 128, (bf16_t*)(P.ws + WS_H) + (size_t)qrow * D_ + h * 128, fq); }
}
DI void ret_state_item(KParams& P, int item, LAS unsigned char* lds, int tid) {
    const int b = item >> 3, h = (item >> 1) & 3, dir = item & 1; const int rowbase = b * 256;
    const bf16_t* kA = (const bf16_t*)(P.ws + A_KA); const bf16_t* vA = (const bf16_t*)(P.ws + A_VA);
    LAS float* wj = (LAS float*)(lds + MISC_OFF);
    const float lg = P.in[18][dir * 4 + h];
    __syncthreads();
    if (tid < 256) wj[tid] = __expf(lg * (float)(dir ? tid : 255 - tid));
    state_mfma<64>(kA + (size_t)rowbase * 256 + h * 64, 256, vA + (size_t)rowbase * 512 + h * 128, 512, wj, lds, P.out + OUT_RET + (size_t)((b * 2 + dir) * 4 + h) * 64 * 128, nullptr, tid);
}
DI float wave_incl_sum(float v, int lane) {
#pragma unroll
    for (int o = 1; o < 64; o <<= 1) { const float t = __shfl_up(v, o); if (lane >= o) v += t; }
    return v;
}
DI float wave_incl_max(float v, int lane) {
#pragma unroll
    for (int o = 1; o < 64; o <<= 1) { const float t = __shfl_up(v, o); if (lane >= o) v = fmaxf(v, t); }
    return v;
}
DI void gate_scan(const LAS float* ig, const LAS float* lf, LAS float* cf, LAS float* rowf, LAS float* Fq, int L, int t0, bool rev, float m0, int lane, float& Ftot, float& Mtot) {
    float csum = 0.f, cmax = m0;
    for (int blk = 0; blk < L; blk += 64) { const int pos = blk + lane; const int t = rev ? L - 1 - pos : pos;
        const float F = csum + wave_incl_sum(lf[t], lane); const float c = ig[t] - F; const float pm = fmaxf(cmax, wave_incl_max(c, lane));
        cf[t] = c; if (t >= t0 && t < t0 + 128) { rowf[t - t0] = -pm; Fq[t - t0] = F; }
        csum = __shfl(F, 63); cmax = __shfl(pm, 63); }
    Ftot = csum; Mtot = cmax;
}
DI void mlstm_item(KParams& P, int item, LAS unsigned char* lds, int tid) {
    const int wid = tid >> 6, lane = tid & 63, fr = lane & 15, fq = lane >> 4;
    int b, h, c, L, rowbase, nc; bool lat;
    if (item < 256) { b = item >> 3; h = (item >> 1) & 3; c = item & 1; L = 256; rowbase = b * 256; nc = 2; lat = false; }
    else { const int it = item - 256; b = it >> 6; h = (it >> 4) & 3; c = it & 15; L = 2048; rowbase = MP_ + b * 2048; nc = 16; lat = true; }
    const bf16_t* qC = (const bf16_t*)(P.ws + O_QC); const bf16_t* kC = (const bf16_t*)(P.ws + O_KC); const bf16_t* vC = (const bf16_t*)(P.ws + O_VC); const bf16_t* oC = (const bf16_t*)(P.ws + O_OC);
    const float* gates = (const float*)(P.ws + O_GT); bf16_t* mix = (bf16_t*)(P.ws + WS_H);
    LAS bf16_t* sK = (LAS bf16_t*)lds; LAS bf16_t* sV = (LAS bf16_t*)(lds + 34816);
    LAS float* cfa = (LAS float*)(lds + 73728);
    LAS float* rowfa = (LAS float*)(lds + 90112);
    LAS float* Fqa = rowfa + 256;
    LAS float* tmp = (LAS float*)(lds + 94208);
    __syncthreads();
    for (int t = tid; t < L; t += 512) { const float* g = gates + (size_t)(rowbase + t) * 16; tmp[t] = g[h]; tmp[2048 + t] = g[8 + h]; tmp[4096 + t] = g[4 + h]; tmp[6144 + t] = g[12 + h]; }
    __syncthreads();
    float m0f = 0.f, m0b = 0.f;
    if (lat) { m0f = P.in[6][(b * 2 + 0) * 4 + h]; m0b = P.in[6][(b * 2 + 1) * 4 + h]; }
    {
        LAS float* bs = (LAS float*)(lds + MISC_OFF);
        const int nblk = L >> 6;
        for (int j = wid; j < 2 * nblk; j += 8) { const int dr = j >= nblk, blk = dr ? j - nblk : j; const int pos = 64 * blk + lane; const int t = dr ? L - 1 - pos : pos;
            LAS float* ig = tmp + dr * 4096; LAS float* lf = ig + 2048;
            const float Fl = wave_incl_sum(lf[t], lane); const float cl = ig[t] - Fl; const float pm = wave_incl_max(cl, lane);
            cfa[dr * 2048 + t] = cl; ig[t] = pm; lf[t] = Fl;
            if (lane == 63) { bs[dr * 32 + blk] = Fl; bs[64 + dr * 32 + blk] = pm; } }
        __syncthreads();
        if (wid == 0) { const int dr = lane >> 5, blk = lane & 31;
            if (blk < nblk) { float C = 0.f, cm = dr ? m0b : m0f;
                for (int q = 0; q < blk; ++q) { cm = fmaxf(cm, bs[64 + dr * 32 + q] - C); C += bs[dr * 32 + q]; }
                bs[128 + dr * 32 + blk] = C; bs[192 + dr * 32 + blk] = cm; } }
        __syncthreads();
        for (int e = tid; e < 2 * L; e += 512) { const int dr = e >= L, t = dr ? e - L : e; const int pos = dr ? L - 1 - t : t; const int blk = pos >> 6;
            const float C = bs[128 + dr * 32 + blk], cm = bs[192 + dr * 32 + blk];
            cfa[dr * 2048 + t] -= C;
            if (t >= 128 * c && t < 128 * c + 128) { rowfa[dr * 128 + t - 128 * c] = -fmaxf(cm, tmp[dr * 4096 + t] - C); Fqa[dr * 128 + t - 128 * c] = tmp[dr * 4096 + 2048 + t] + C; } }
    }
    __syncthreads();
    const int ti = 128 * c + 16 * wid + fr; const int qrow = rowbase + ti;
    bf16x8 qf[4];
#pragma unroll
    for (int s = 0; s < 4; ++s) qf[s] = *(const bf16x8*)(qC + (size_t)qrow * 512 + h * 128 + 32 * s + 8 * fq);
    f32x4 hsum[8];
#pragma unroll
    for (int et = 0; et < 8; ++et) hsum[et] = (f32x4){0.f, 0.f, 0.f, 0.f};
    f32x4 sacc[8]; bf16x8 pf[4];
#pragma unroll 1
    for (int dir = 0; dir < 2; ++dir) {
        f32x4 num[8];
#pragma unroll
        for (int et = 0; et < 8; ++et) num[et] = (f32x4){0.f, 0.f, 0.f, 0.f};
        float den = 0.f;
        const float rf = rowfa[dir * 128 + 16 * wid + fr]; const LAS float* cf = cfa + dir * 2048;
        const int k0 = dir ? c : 0, k1 = dir ? nc : c + 1;
        {
            u32x4 rk[4], rv[4];
            const bf16_t* kg = kC + (size_t)rowbase * 512 + h * 128; const bf16_t* vg = vC + (size_t)rowbase * 512 + h * 128;
            tile_load<128>(rk, kg + (size_t)128 * k0 * 512, 512, tid); tile_load<128>(rv, vg + (size_t)128 * k0 * 512, 512, tid);
            for (int kc = k0; kc < k1; ++kc) {
                __syncthreads();
                tile_store<128>(sK, rk, 136, tid); tile_store<128>(sV, rv, 144, tid);
                __syncthreads();
                if (kc + 1 < k1) { tile_load<128>(rk, kg + (size_t)128 * (kc + 1) * 512, 512, tid); tile_load<128>(rv, vg + (size_t)128 * (kc + 1) * 512, 512, tid); }
                qk_tile<128>(sK, qf, sacc, fr, fq);
#pragma unroll
                for (int jt = 0; jt < 8; ++jt) { const f32x4 cv = *(const LAS f32x4*)(cf + 128 * kc + 16 * jt + 4 * fq);
#pragma unroll
                    for (int r = 0; r < 4; ++r) { const int tj = 128 * kc + 16 * jt + 4 * fq + r; const bool ok = dir ? (tj >= ti) : (tj <= ti);
                        const float w = ok ? __expf(rf + cv[r]) : 0.f; const float p = sacc[jt][r] * w; sacc[jt][r] = p; den += p; } }
                pack_p(sacc, pf);
                pv_tile<128, 144>(sV, pf, num, fr, fq);
            }
        }
        if (lat) {
            __syncthreads();
            stage_f32<128>(sV, P.in[4] + (size_t)((b * 2 + dir) * 4 + h) * 128 * 128, 128, 128, 144, tid);
            __syncthreads();
            const float fac = __expf((dir ? m0b : m0f) + rf);
            pack_q_state<128>(qC + (size_t)qrow * 512 + h * 128, fac, fac, pf, sacc, fq);
            const float* n0 = P.in[5] + (size_t)((b * 2 + dir) * 4 + h) * 128;
#pragma unroll
            for (int jt = 0; jt < 8; ++jt) { const f32x4 nv = *(const f32x4*)(n0 + 16 * jt + 4 * fq); den += sacc[jt][0] * nv[0] + sacc[jt][1] * nv[1] + sacc[jt][2] * nv[2] + sacc[jt][3] * nv[3]; }
            pv_tile<128, 144>(sV, pf, num, fr, fq);
        }
        den = fq_sum(den);
        const float thr = __expf(rf - Fqa[dir * 128 + 16 * wid + fr]);
        const float dn = 1.f / fmaxf(fabsf(den), thr);
#pragma unroll
        for (int et = 0; et < 8; ++et) hsum[et] += num[et] * dn;
    }
    ln_gate_store(hsum, 1e-5f, P.in[35] + h * 128, oC + (size_t)qrow * 512 + h * 128, mix + (size_t)qrow * D_ + h * 128, fq);
}
DI void mlstm_state_item(KParams& P, int item, LAS unsigned char* lds, int tid) {
    const int wid = tid >> 6, lane = tid & 63;
    const int b = item >> 3, h = (item >> 1) & 3, dir = item & 1; const int rowbase = b * 256;
    const bf16_t* kC = (const bf16_t*)(P.ws + O_KC); const bf16_t* vC = (const bf16_t*)(P.ws + O_VC); const float* gates = (const float*)(P.ws + O_GT);
    LAS float* mi = (LAS float*)(lds + MISC_OFF);
    __syncthreads();
    if (tid < 256) { const float* g = gates + (size_t)(rowbase + tid) * 16; mi[tid] = g[dir * 4 + h]; mi[256 + tid] = g[8 + dir * 4 + h]; }
    __syncthreads();
    if (wid == 0) { float Ft, Mt; gate_scan(mi, mi + 256, mi + 512, mi + 768, mi + 896, 256, 0, dir == 1, 0.f, lane, Ft, Mt); if (lane == 0) { mi[1024] = Ft; mi[1025] = Mt; } }
    __syncthreads();
    const float Ft = mi[1024], Mt = mi[1025];
    if (tid < 256) mi[512 + tid] = __expf(mi[512 + tid] - Mt);
    const size_t sidx = (size_t)(b * 2 + dir) * 4 + h;
    state_mfma<128>(kC + (size_t)rowbase * 512 + h * 128, 512, vC + (size_t)rowbase * 512 + h * 128, 512, mi + 512, lds, P.out + OUT_MC + sidx * 128 * 128, P.out + OUT_MN + sidx * 128, tid);
    if (tid == 0) P.out[OUT_MM + sidx] = Ft + Mt;
}
DI void attn_item(KParams& P, int item, LAS unsigned char* lds, int tid) {
    const int wid = tid >> 6, lane = tid & 63, fr = lane & 15, fq = lane >> 4;
    int b, qh, qb, rowbase, nkt; bool lat;
    if (item >= 512) { const int it = item - 512; b = it >> 3; qh = it & 7; qb = 0; rowbase = b * 256; nkt = 2; lat = false; }
    else { b = item >> 6; qh = (item >> 3) & 7; qb = item & 7; rowbase = MP_ + b * 2048; nkt = 20; lat = true; }
    const int kvh = qh >> 2;
    const bf16_t* qD = (const bf16_t*)(P.ws + O_QD); const bf16_t* kD = (const bf16_t*)(P.ws + O_KD); const bf16_t* vD = (const bf16_t*)(P.ws + O_VD); bf16_t* mix = (bf16_t*)(P.ws + WS_H);
    LAS bf16_t* sK = (LAS bf16_t*)lds; LAS bf16_t* sV = (LAS bf16_t*)(lds + 128 * 72 * 2);
    const int qrow = rowbase + 256 * qb + 32 * wid + fr;
    bf16x8 qf[2][2];
#pragma unroll
    for (int it = 0; it < 2; ++it)
#pragma unroll
        for (int s = 0; s < 2; ++s) qf[it][s] = *(const bf16x8*)(qD + (size_t)(qrow + 16 * it) * 512 + qh * 64 + 32 * s + 8 * fq);
    f32x4 oacc[2][4];
#pragma unroll
    for (int it = 0; it < 2; ++it)
#pragma unroll
        for (int et = 0; et < 4; ++et) oacc[it][et] = (f32x4){0.f, 0.f, 0.f, 0.f};
    float mrun[2] = {-1e30f, -1e30f}, lpart[2] = {0.f, 0.f};
    f32x4 sacc[2][8]; bf16x8 pf[2][4];
    {
        u32x4 ra[2], rc[2];
        const bf16_t* cKb = (const bf16_t*)(P.ws + WS_CK); const bf16_t* cVb = (const bf16_t*)(P.ws + WS_CV);
        auto t_load = [&](int kt) {
            if (lat && kt < 4) { const size_t off = ((size_t)(b * 2 + kvh) * 512 + 128 * kt) * 64; tile_load<64>(ra, cKb + off, 64, tid); tile_load<64>(rc, cVb + off, 64, tid); }
            else { const size_t r0 = (size_t)rowbase + 128 * (lat ? kt - 4 : kt); tile_load<64>(ra, kD + r0 * 128 + kvh * 64, 128, tid); tile_load<64>(rc, vD + r0 * 128 + kvh * 64, 128, tid); } };
        auto t_store = [&](int kt) { tile_store<64>(sK + (kt & 1) * 18432, ra, 72, tid); tile_store<64>(sV + (kt & 1) * 18432, rc, 72, tid); };
        t_load(0);
        __syncthreads();
        t_store(0);
        if (nkt > 1) t_load(1);
        __syncthreads();
        for (int kt = 0; kt < nkt; ++kt) {
            const LAS bf16_t* cK = sK + (kt & 1) * 18432; const LAS bf16_t* cV = sV + (kt & 1) * 18432;
#pragma unroll
            for (int jt = 0; jt < 8; ++jt) { f32x4 a0 = {0.f, 0.f, 0.f, 0.f}, a1 = {0.f, 0.f, 0.f, 0.f};
#pragma unroll
                for (int s = 0; s < 2; ++s) { const bf16x8 kf = *(const LAS bf16x8*)(cK + (16 * jt + fr) * 72 + 32 * s + 8 * fq); a0 = MFMA16(kf, qf[0][s], a0); a1 = MFMA16(kf, qf[1][s], a1); }
                sacc[0][jt] = a0; sacc[1][jt] = a1; }
#pragma unroll
            for (int it = 0; it < 2; ++it) {
                float tmax = -1e30f;
#pragma unroll
                for (int jt = 0; jt < 8; ++jt)
#pragma unroll
                    for (int r = 0; r < 4; ++r) tmax = fmaxf(tmax, sacc[it][jt][r]);
                tmax = fq_max(tmax) * 0.18033688011112042f;
                const float mnew = fmaxf(mrun[it], tmax), alpha = __builtin_amdgcn_exp2f(mrun[it] - mnew); float ps = 0.f;
#pragma unroll
                for (int jt = 0; jt < 8; ++jt)
#pragma unroll
                    for (int r = 0; r < 4; ++r) { const float p = __builtin_amdgcn_exp2f(sacc[it][jt][r] * 0.18033688011112042f - mnew); sacc[it][jt][r] = p; ps += p; }
                lpart[it] = lpart[it] * alpha + ps; mrun[it] = mnew;
                if (__builtin_amdgcn_ballot_w64(alpha != 1.f)) {
#pragma unroll
                    for (int et = 0; et < 4; ++et) oacc[it][et] *= alpha; }
                pack_p(sacc[it], pf[it]);
            }
#pragma unroll
            for (int et = 0; et < 4; ++et)
#pragma unroll
                for (int s = 0; s < 4; ++s) {
                    const LAS bf16_t* p0 = cV + (32 * s + 4 * fq + (fr >> 2)) * 72 + 16 * et + 4 * (fr & 3);
                    const s16x4 lo = __builtin_amdgcn_ds_read_tr16_b64_v4i16((LAS s16x4*)p0), hi = __builtin_amdgcn_ds_read_tr16_b64_v4i16((LAS s16x4*)(p0 + 16 * 72));
                    const bf16x8 vf = __builtin_shufflevector(lo, hi, 0, 1, 2, 3, 4, 5, 6, 7);
                    oacc[0][et] = MFMA16(vf, pf[0][s], oacc[0][et]); oacc[1][et] = MFMA16(vf, pf[1][s], oacc[1][et]); }
            if (kt + 1 < nkt) t_store(kt + 1);
            if (kt + 2 < nkt) t_load(kt + 2);
            __syncthreads();
        }
    }
#pragma unroll
    for (int it = 0; it < 2; ++it) {
        const float inv = 1.f / fq_sum(lpart[it]);
        bf16_t* dst = (bf16_t*)(P.ws + WS_H) + (size_t)(launder_v(qrow) + 16 * it) * D_ + 512 + qh * 64 + 4 * fq;
#pragma unroll
        for (int et = 0; et < 4; ++et) { u32x2 w; w.x = pk2(oacc[it][et][0] * inv, oacc[it][et][1] * inv); w.y = pk2(oacc[it][et][2] * inv, oacc[it][et][3] * inv); *(u32x2*)(dst + 16 * et) = w; }
    }
}

DI void rwkv_shift_row(const bf16_t* pB, const float* mu, bf16_t* rB, bf16_t* kB, bf16_t* vB, bf16_t* X, int row, int lane) {
    const int t = seqpos_of_row(row), L = row < MP_ ? 256 : 2048; const bool hp = t > 0, hn = t < L - 1;
    const bf16_t* pr = pB + (size_t)row * 1792;
    u32x2 cu[7], pu[7], nu[7];
#pragma unroll
    for (int g = 0; g < 7; ++g) { const int c = 256 * g + 4 * lane; cu[g] = *(const u32x2*)(pr + c); pu[g] = (u32x2){0u, 0u}; nu[g] = (u32x2){0u, 0u};
        if (hp) pu[g] = *(const u32x2*)(pr - 1792 + c); if (hn) nu[g] = *(const u32x2*)(pr + 1792 + c); }
#pragma unroll
    for (int g = 0; g < 7; ++g) { const int c = 256 * g + 4 * lane;
        const f32x4 m4 = *(const f32x4*)(mu + c);
        float x[4] = {bf_lo(cu[g].x), bf_hi(cu[g].x), bf_lo(cu[g].y), bf_hi(cu[g].y)}; const float pv[4] = {bf_lo(pu[g].x), bf_hi(pu[g].x), bf_lo(pu[g].y), bf_hi(pu[g].y)}, nv[4] = {bf_lo(nu[g].x), bf_hi(nu[g].x), bf_lo(nu[g].y), bf_hi(nu[g].y)};
#pragma unroll
        for (int j = 0; j < 4; ++j) x[j] = x[j] + m4[j] * (0.5f * (pv[j] + nv[j]) - x[j]);
        u32x2 w;
        if (g < 6) { w.x = pk2(x[0], x[1]); w.y = pk2(x[2], x[3]); bf16_t* dst = g < 2 ? rB : (g < 4 ? kB : vB); *(u32x2*)(dst + (size_t)row * 512 + (g & 1) * 256 + 4 * lane) = w; }
        else { const int cc = 4 * lane;
#pragma unroll
            for (int j = 0; j < 4; ++j) x[j] = cc < 64 ? tanhf(x[j]) : (cc < 128 ? x[j] : sigmoid_f(x[j]));
            w.x = pk2(x[0], x[1]); w.y = pk2(x[2], x[3]); *(u32x2*)(X + (size_t)row * 256 + cc) = w; }
    }
}
DI void rwkv_shift_phase(KParams& P, int tid) {
    const int wid = tid >> 6, lane = tid & 63;
    const bf16_t* pB = (const bf16_t*)(P.ws + A_PB); const float* mu = P.in[20];
    bf16_t* rB = (bf16_t*)(P.ws + A_R); bf16_t* kB = (bf16_t*)(P.ws + A_K); bf16_t* vB = (bf16_t*)(P.ws + A_V); bf16_t* X = (bf16_t*)(P.ws + A_X);
    for (int row = blockIdx.x * 8 + wid; row < M_; row += gridDim.x * 8) rwkv_shift_row(pB, mu, rB, kB, vB, X, row, lane);
}
DI float dpp_xor1(float v) { return __int_as_float(__builtin_amdgcn_mov_dpp(__float_as_int(v), 0xB1, 0xf, 0xf, true)); }
DI float dpp_xor2(float v) { return __int_as_float(__builtin_amdgcn_mov_dpp(__float_as_int(v), 0x4E, 0xf, 0xf, true)); }
DI float dpp_hmir(float v) { return __int_as_float(__builtin_amdgcn_mov_dpp(__float_as_int(v), 0x141, 0xf, 0xf, true)); }
DI float sum8(float v) { v += dpp_xor1(v); v += dpp_xor2(v); v += dpp_hmir(v); return v; }
DI float dpp_rmir(float v) { return __int_as_float(__builtin_amdgcn_mov_dpp(__float_as_int(v), 0x140, 0xf, 0xf, true)); }
DI float sum16(float v) { v += dpp_xor1(v); v += dpp_xor2(v); v += dpp_hmir(v); v += dpp_rmir(v); return v; }
DI void rwkv_scan_item(KParams& P, int item, LAS unsigned char* lds, int tid) {
    int b, h, dir, L, rowbase; bool lat;
    if (item < 128) { b = item >> 4; h = (item >> 1) & 7; dir = item & 1; L = 2048; rowbase = MP_ + b * 2048; lat = true; }
    else { const int it = item - 128; b = it >> 4; h = (it >> 1) & 7; dir = it & 1; L = 256; rowbase = b * 256; lat = false; }
    const bf16_t* rB = (const bf16_t*)(P.ws + A_R); const bf16_t* kB = (const bf16_t*)(P.ws + A_K); const bf16_t* vB = (const bf16_t*)(P.ws + A_V);
    const bf16_t* uB = (const bf16_t*)(P.ws + (dir ? A_U1 : A_U0)); const bf16_t* aB = (const bf16_t*)(P.ws + (dir ? A_A1 : A_A0)); bf16_t* y = (bf16_t*)(P.ws + A_Y) + (dir ? (size_t)M_ * 512 : 0);
    LAS float* buf = (LAS float*)lds;
    LAS float* ybuf = (LAS float*)(lds + 98304);
    const int i = tid >> 3, cg = tid & 7, tt_s = tid >> 4, jc = (tid & 15) * 4;
    LAS float* ydst = (cg == 0) ? (ybuf + i) : ((LAS float*)(lds + 114688) + tid);
    f32x2 S[4];
    if (lat) { const float* s0 = P.in[3] + ((size_t)((b * 2 + dir) * 8 + h) * 64 + i) * 64 + 8 * cg; const f32x4 a = *(const f32x4*)s0, c = *(const f32x4*)(s0 + 4);
        S[0] = (f32x2){a[0], a[1]}; S[1] = (f32x2){a[2], a[3]}; S[2] = (f32x2){c[0], c[1]}; S[3] = (f32x2){c[2], c[3]}; }
    else {
#pragma unroll
        for (int q = 0; q < 4; ++q) S[q] = (f32x2){0.f, 0.f}; }
    const f32x4 kk4 = *(const f32x4*)(P.in[26] + h * 64 + jc), ka4 = *(const f32x4*)(P.in[27] + h * 64 + jc);
    u32x2 gr, gk, gv, gu, ga;
    auto gload = [&](int ci) { const int pos = 32 * ci + tt_s; const int t = dir ? L - 1 - pos : pos; const size_t o = (size_t)(rowbase + t) * 512 + h * 64 + jc;
        gr = *(const u32x2*)(rB + o); gk = *(const u32x2*)(kB + o); gv = *(const u32x2*)(vB + o); gu = *(const u32x2*)(uB + o); ga = *(const u32x2*)(aB + o); };
    auto pstore = [&](int bi) { LAS float* bb = buf + bi * 12288 + tt_s * 64 + jc;
        const float k[4] = {bf_lo(gk.x), bf_hi(gk.x), bf_lo(gk.y), bf_hi(gk.y)}, a[4] = {bf_lo(ga.x), bf_hi(ga.x), bf_lo(ga.y), bf_hi(ga.y)}, u[4] = {bf_lo(gu.x), bf_hi(gu.x), bf_lo(gu.y), bf_hi(gu.y)};
        float kv[4]; float ss = 0.f;
#pragma unroll
        for (int j = 0; j < 4; ++j) { kv[j] = k[j] * kk4[j]; ss += kv[j] * kv[j]; }
        ss = sum16(ss);
        const float rn = 1.f / fmaxf(sqrtf(ss), 1e-12f);
        f32x4 w4, a4, b4, d4;
#pragma unroll
        for (int j = 0; j < 4; ++j) { const float kkn = kv[j] * rn; w4[j] = __expf(-u[j]); a4[j] = -kkn; b4[j] = kkn * a[j]; d4[j] = k[j] * (1.f + (a[j] - 1.f) * ka4[j]); }
        *(LAS f32x4*)(bb) = w4; *(LAS f32x4*)(bb + 2048) = a4; *(LAS f32x4*)(bb + 4096) = b4; *(LAS f32x4*)(bb + 6144) = d4;
        *(LAS f32x4*)(bb + 8192) = (f32x4){bf_lo(gr.x), bf_hi(gr.x), bf_lo(gr.y), bf_hi(gr.y)}; *(LAS f32x4*)(bb + 10240) = (f32x4){bf_lo(gv.x), bf_hi(gv.x), bf_lo(gv.y), bf_hi(gv.y)}; };
    const int nch = L >> 5;
    __syncthreads();
    gload(0); pstore(0);
    __syncthreads();
    for (int ci = 0; ci < nch; ++ci) {
        if (ci + 1 < nch) gload(ci + 1);
        const LAS float* bb = buf + (ci & 1) * 12288 + 8 * cg; const LAS float* bvv = buf + (ci & 1) * 12288 + 10240 + i;
        struct SV { f32x4 w0, w1, a0, a1, b0, b1, d0, d1, r0, r1; float vi; };
        auto ld = [&](int tt) { SV v; const LAS float* p = bb + tt * 64;
            v.w0 = *(const LAS f32x4*)(p); v.w1 = *(const LAS f32x4*)(p + 4); v.a0 = *(const LAS f32x4*)(p + 2048); v.a1 = *(const LAS f32x4*)(p + 2052);
            v.b0 = *(const LAS f32x4*)(p + 4096); v.b1 = *(const LAS f32x4*)(p + 4100); v.d0 = *(const LAS f32x4*)(p + 6144); v.d1 = *(const LAS f32x4*)(p + 6148);
            v.r0 = *(const LAS f32x4*)(p + 8192); v.r1 = *(const LAS f32x4*)(p + 8196); v.vi = bvv[tt * 64]; return v; };
        LAS float* ydc = ydst + ((cg == 0) ? (ci & 1) * 2048 : 0);
        SV cur = ld(0);
#pragma unroll 4
        for (int tt = 0; tt < 32; ++tt) {
            const SV nx = ld(tt < 31 ? tt + 1 : 31);
            const f32x2 A[4] = {{cur.a0[0], cur.a0[1]}, {cur.a0[2], cur.a0[3]}, {cur.a1[0], cur.a1[1]}, {cur.a1[2], cur.a1[3]}}, W[4] = {{cur.w0[0], cur.w0[1]}, {cur.w0[2], cur.w0[3]}, {cur.w1[0], cur.w1[1]}, {cur.w1[2], cur.w1[3]}};
            const f32x2 B[4] = {{cur.b0[0], cur.b0[1]}, {cur.b0[2], cur.b0[3]}, {cur.b1[0], cur.b1[1]}, {cur.b1[2], cur.b1[3]}}, D[4] = {{cur.d0[0], cur.d0[1]}, {cur.d0[2], cur.d0[3]}, {cur.d1[0], cur.d1[1]}, {cur.d1[2], cur.d1[3]}};
            const f32x2 R[4] = {{cur.r0[0], cur.r0[1]}, {cur.r0[2], cur.r0[3]}, {cur.r1[0], cur.r1[1]}, {cur.r1[2], cur.r1[3]}};
            const f32x2 t2 = (S[1] * A[1] + S[0] * A[0]) + (S[3] * A[3] + S[2] * A[2]);
            const float sa = sum8(t2[0] + t2[1]);
            const f32x2 sv = {sa, sa}, vv = {cur.vi, cur.vi};
#pragma unroll
            for (int q = 0; q < 4; ++q) { const f32x2 T = S[q] * W[q] + vv * D[q]; S[q] = sv * B[q] + T; }
            const f32x2 u2 = (S[1] * R[1] + S[0] * R[0]) + (S[3] * R[3] + S[2] * R[2]);
            const float yv = sum8(u2[0] + u2[1]);
            ydc[tt * 64] = yv;
            cur = nx; }
        if (ci + 1 < nch) pstore((ci + 1) & 1);
        __syncthreads();
        { const int pos = 32 * ci + tt_s; const int t = dir ? L - 1 - pos : pos; const f32x4 yv = *(const LAS f32x4*)(ybuf + (ci & 1) * 2048 + tt_s * 64 + jc);
            u32x2 w; w.x = pk2(yv[0], yv[1]); w.y = pk2(yv[2], yv[3]); *(u32x2*)(y + (size_t)(rowbase + t) * 512 + h * 64 + jc) = w; }
    }
    if (!lat) { float* op = P.out + OUT_RWKV + ((size_t)((b * 2 + dir) * 8 + h) * 64 + i) * 64 + 8 * cg; *(f32x4*)op = (f32x4){S[0][0], S[0][1], S[1][0], S[1][1]}; *(f32x4*)(op + 4) = (f32x4){S[2][0], S[2][1], S[3][0], S[3][1]}; }
}
DI void rwkv_scan_half_item(KParams& P, int item, LAS unsigned char* lds, int tid) {
    const int b = item >> 5, h = (item >> 2) & 7, dir = (item >> 1) & 1, half = item & 1; const int L = 2048, rowbase = MP_ + b * 2048, nch = 64;
    LAS float* buf = (LAS float*)lds;
    LAS float* ybuf = (LAS float*)(lds + 98304);
    __syncthreads();
    if (tid >= 256) {
        const int lt = tid - 256, jc = (lt & 15) * 4;
        const bf16_t* rB = (const bf16_t*)(P.ws + A_R); const bf16_t* kB = (const bf16_t*)(P.ws + A_K); const bf16_t* vB = (const bf16_t*)(P.ws + A_V);
        const bf16_t* uB = (const bf16_t*)(P.ws + (dir ? A_U1 : A_U0)); const bf16_t* aB = (const bf16_t*)(P.ws + (dir ? A_A1 : A_A0)); bf16_t* y = (bf16_t*)(P.ws + A_Y) + (dir ? (size_t)M_ * 512 : 0);
        const f32x4 kk4 = *(const f32x4*)(P.in[26] + h * 64 + jc), ka4 = *(const f32x4*)(P.in[27] + h * 64 + jc);
        auto stage = [&](int ci) {
            u32x2 gr[2], gk[2], gv[2], gu[2], ga[2];
#pragma unroll
            for (int g = 0; g < 2; ++g) { const int pos = 32 * ci + (lt >> 4) + 16 * g; const int t = dir ? L - 1 - pos : pos; const size_t o = (size_t)(rowbase + t) * 512 + h * 64 + jc;
                gr[g] = *(const u32x2*)(rB + o); gk[g] = *(const u32x2*)(kB + o); gv[g] = *(const u32x2*)(vB + o); gu[g] = *(const u32x2*)(uB + o); ga[g] = *(const u32x2*)(aB + o); }
#pragma unroll
            for (int g = 0; g < 2; ++g) { LAS float* bb = buf + (ci & 1) * 12288 + ((lt >> 4) + 16 * g) * 64 + jc;
                const float k[4] = {bf_lo(gk[g].x), bf_hi(gk[g].x), bf_lo(gk[g].y), bf_hi(gk[g].y)}, a[4] = {bf_lo(ga[g].x), bf_hi(ga[g].x), bf_lo(ga[g].y), bf_hi(ga[g].y)}, u[4] = {bf_lo(gu[g].x), bf_hi(gu[g].x), bf_lo(gu[g].y), bf_hi(gu[g].y)};
                float kv[4]; float ss = 0.f;
#pragma unroll
                for (int j = 0; j < 4; ++j) { kv[j] = k[j] * kk4[j]; ss += kv[j] * kv[j]; }
                ss = sum16(ss);
                const float rn = 1.f / fmaxf(sqrtf(ss), 1e-12f);
                f32x4 w4, a4, b4, d4;
#pragma unroll
                for (int j = 0; j < 4; ++j) { const float kkn = kv[j] * rn; w4[j] = __expf(-u[j]); a4[j] = -kkn; b4[j] = kkn * a[j]; d4[j] = k[j] * (1.f + (a[j] - 1.f) * ka4[j]); }
                *(LAS f32x4*)(bb) = w4; *(LAS f32x4*)(bb + 2048) = a4; *(LAS f32x4*)(bb + 4096) = b4; *(LAS f32x4*)(bb + 6144) = d4;
                *(LAS f32x4*)(bb + 8192) = (f32x4){bf_lo(gr[g].x), bf_hi(gr[g].x), bf_lo(gr[g].y), bf_hi(gr[g].y)}; *(LAS f32x4*)(bb + 10240) = (f32x4){bf_lo(gv[g].x), bf_hi(gv[g].x), bf_lo(gv[g].y), bf_hi(gv[g].y)}; } };
        auto flush = [&](int ci) { const int tok = lt >> 3, r4 = (lt & 7) * 4; const int pos = 32 * ci + tok; const int t = dir ? L - 1 - pos : pos;
            const f32x4 yv = *(const LAS f32x4*)(ybuf + (ci & 1) * 1024 + tok * 32 + r4); u32x2 w; w.x = pk2(yv[0], yv[1]); w.y = pk2(yv[2], yv[3]);
            *(u32x2*)(y + (size_t)(rowbase + t) * 512 + h * 64 + 32 * half + r4) = w; };
        stage(0);
        __syncthreads();
        for (int ci = 0; ci < nch; ++ci) {
            if (ci + 1 < nch) stage(ci + 1);
            if (ci >= 1) flush(ci - 1);
            __syncthreads();
        }
        flush(nch - 1);
    } else {
        const int il = tid >> 3, cg = tid & 7, i = 32 * half + il;
        f32x2 S[4];
        { const float* s0 = P.in[3] + ((size_t)((b * 2 + dir) * 8 + h) * 64 + i) * 64 + 8 * cg; const f32x4 a = *(const f32x4*)s0, c = *(const f32x4*)(s0 + 4);
          S[0] = (f32x2){a[0], a[1]}; S[1] = (f32x2){a[2], a[3]}; S[2] = (f32x2){c[0], c[1]}; S[3] = (f32x2){c[2], c[3]}; }
        LAS float* ydst = (cg == 0) ? (ybuf + il) : ((LAS float*)(lds + 106496) + tid);
        __syncthreads();
        for (int ci = 0; ci < nch; ++ci) {
            const LAS float* bb = buf + (ci & 1) * 12288 + 8 * cg; const LAS float* bvv = buf + (ci & 1) * 12288 + 10240 + i;
            LAS float* ydc = ydst + ((cg == 0) ? (ci & 1) * 1024 : 0);
            struct SV { f32x4 w0, w1, a0, a1, b0, b1, d0, d1, r0, r1; float vi; };
            auto ld = [&](int tt) { SV v; const LAS float* p = bb + tt * 64;
                v.w0 = *(const LAS f32x4*)(p); v.w1 = *(const LAS f32x4*)(p + 4); v.a0 = *(const LAS f32x4*)(p + 2048); v.a1 = *(const LAS f32x4*)(p + 2052);
                v.b0 = *(const LAS f32x4*)(p + 4096); v.b1 = *(const LAS f32x4*)(p + 4100); v.d0 = *(const LAS f32x4*)(p + 6144); v.d1 = *(const LAS f32x4*)(p + 6148);
                v.r0 = *(const LAS f32x4*)(p + 8192); v.r1 = *(const LAS f32x4*)(p + 8196); v.vi = bvv[tt * 64]; return v; };
            SV cur = ld(0);
#pragma unroll 4
            for (int tt = 0; tt < 32; ++tt) {
                const SV nx = ld(tt < 31 ? tt + 1 : 31);
                const f32x2 A[4] = {{cur.a0[0], cur.a0[1]}, {cur.a0[2], cur.a0[3]}, {cur.a1[0], cur.a1[1]}, {cur.a1[2], cur.a1[3]}}, W[4] = {{cur.w0[0], cur.w0[1]}, {cur.w0[2], cur.w0[3]}, {cur.w1[0], cur.w1[1]}, {cur.w1[2], cur.w1[3]}};
                const f32x2 B[4] = {{cur.b0[0], cur.b0[1]}, {cur.b0[2], cur.b0[3]}, {cur.b1[0], cur.b1[1]}, {cur.b1[2], cur.b1[3]}}, D[4] = {{cur.d0[0], cur.d0[1]}, {cur.d0[2], cur.d0[3]}, {cur.d1[0], cur.d1[1]}, {cur.d1[2], cur.d1[3]}};
                const f32x2 R[4] = {{cur.r0[0], cur.r0[1]}, {cur.r0[2], cur.r0[3]}, {cur.r1[0], cur.r1[1]}, {cur.r1[2], cur.r1[3]}};
                const f32x2 t2 = (S[1] * A[1] + S[0] * A[0]) + (S[3] * A[3] + S[2] * A[2]);
                const float sa = sum8(t2[0] + t2[1]);
                const f32x2 sv = {sa, sa}, vv = {cur.vi, cur.vi};
#pragma unroll
                for (int q = 0; q < 4; ++q) { const f32x2 T = S[q] * W[q] + vv * D[q]; S[q] = sv * B[q] + T; }
                const f32x2 u2 = (S[1] * R[1] + S[0] * R[0]) + (S[3] * R[3] + S[2] * R[2]);
                const float yv = sum8(u2[0] + u2[1]);
                ydc[tt * 32] = yv;
                cur = nx; }
            __syncthreads();
        }
    }
}
DI void rwkv_post_phase(KParams& P, int tid) {
    const int wid = tid >> 6, lane = tid & 63;
    const bf16_t* rB = (const bf16_t*)(P.ws + A_R); const bf16_t* kB = (const bf16_t*)(P.ws + A_K); const bf16_t* vB = (const bf16_t*)(P.ws + A_V); const bf16_t* gB = (const bf16_t*)(P.ws + A_G);
    const bf16_t* yA = (const bf16_t*)(P.ws + A_Y); const bf16_t* yBk = yA + (size_t)M_ * 512; bf16_t* mix = (bf16_t*)(P.ws + WS_H);
    const int c = 8 * lane;
    f32x4 lw[2], lb[2], rk[2];
#pragma unroll
    for (int q = 0; q < 2; ++q) { lw[q] = *(const f32x4*)(P.in[29] + c + 4 * q); lb[q] = *(const f32x4*)(P.in[30] + c + 4 * q); rk[q] = *(const f32x4*)(P.in[28] + c + 4 * q); }
    for (int row = blockIdx.x * 8 + wid; row < M_; row += gridDim.x * 8) { const size_t o = (size_t)row * 512 + c;
        const u32x4 ya = *(const u32x4*)(yA + o), yb = *(const u32x4*)(yBk + o);
        const u32x4 ru = *(const u32x4*)(rB + o), ku = *(const u32x4*)(kB + o), vu = *(const u32x4*)(vB + o), gu = *(const u32x4*)(gB + o);
        float yy[8]; float r[8], k[8], v[8], g[8];
#pragma unroll
        for (int q = 0; q < 4; ++q) { yy[2 * q] = bf_lo(ya[q]) + bf_lo(yb[q]); yy[2 * q + 1] = bf_hi(ya[q]) + bf_hi(yb[q]); }
#pragma unroll
        for (int q = 0; q < 4; ++q) { r[2 * q] = bf_lo(ru[q]); r[2 * q + 1] = bf_hi(ru[q]); k[2 * q] = bf_lo(ku[q]); k[2 * q + 1] = bf_hi(ku[q]); v[2 * q] = bf_lo(vu[q]); v[2 * q + 1] = bf_hi(vu[q]); g[2 * q] = bf_lo(gu[q]); g[2 * q + 1] = bf_hi(gu[q]); }
        float s = 0.f, bs = 0.f;
#pragma unroll
        for (int q = 0; q < 8; ++q) { s += yy[q]; bs += r[q] * k[q] * rk[q >> 2][q & 3]; }
        s = sum8(s); bs = sum8(bs); const float mu = s * (1.f / 64.f); float vs = 0.f;
#pragma unroll
        for (int q = 0; q < 8; ++q) { const float d = yy[q] - mu; vs += d * d; }
        vs = sum8(vs); const float rs = rsqrtf(vs * (1.f / 64.f) + 64e-5f);
        float o8[8];
#pragma unroll
        for (int q = 0; q < 8; ++q) o8[q] = ((yy[q] - mu) * rs * lw[q >> 2][q & 3] + lb[q >> 2][q & 3] + bs * v[q]) * g[q];
        u32x4 w; w.x = pk2(o8[0], o8[1]); w.y = pk2(o8[2], o8[3]); w.z = pk2(o8[4], o8[5]); w.w = pk2(o8[6], o8[7]);
        *(u32x4*)(mix + (size_t)row * D_ + 512 + c) = w; }
}
#define XB_TMO      128
#define XB_XCNT(j)  (256  + 64 * (j))
#define XB_XSUB(j)  (1280 + 64 * (j))
#define XB_XGEN(j)  (2304 + 64 * (j))
#define XB_TOP      3328
#define XB_TOPGEN   3392
#define XCD_BAR_WORDS 3456
#define XB_SPIN_CAP (1u << 18)

__device__ __forceinline__ unsigned xb_ld(unsigned* p)              { return __hip_atomic_load(p, __ATOMIC_RELAXED, __HIP_MEMORY_SCOPE_AGENT); }
__device__ __forceinline__ unsigned xb_add(unsigned* p, unsigned v) { return __hip_atomic_fetch_add(p, v, __ATOMIC_RELAXED, __HIP_MEMORY_SCOPE_AGENT); }
__device__ __forceinline__ unsigned xb_xcc_id() { return (unsigned)__builtin_amdgcn_s_getreg((3 << 11) | 20) & 0xFu; }
#define XB_SPIN(cond, bar) do { unsigned _sp = 0; while (cond) { __builtin_amdgcn_s_sleep(1); \
    if ((++_sp & 255u) == 0u) { if (xb_ld(&(bar)[XB_TMO])) break; if (_sp > XB_SPIN_CAP) { atomicAdd(&(bar)[XB_TMO], 1u); break; } } } } while (0)

struct XcdBarrier {
    unsigned* bar; unsigned x;
    volatile LAS unsigned* st;
};

__device__ __forceinline__ XcdBarrier xcd_barrier_post(unsigned* bar, volatile LAS unsigned* st) {
    XcdBarrier b; b.bar = bar; b.x = xb_xcc_id(); b.st = st;
    if (threadIdx.x == 0) (void)xb_add(&bar[XB_XCNT(b.x)], 1u);
    return b;
}
__device__ __forceinline__ void xcd_barrier_complete(unsigned* bar, unsigned x, unsigned& nloc, unsigned& nx) {
    const unsigned G = gridDim.x * gridDim.y * gridDim.z;
    unsigned sum, cnt, mine, sp = 0u;
    for (;;) {
        sum = 0u; cnt = 0u; mine = 0u;
#pragma unroll
        for (unsigned j = 0; j < 16; ++j) { const unsigned c = xb_ld(&bar[XB_XCNT(j)]); sum += c; cnt += (c > 0u) ? 1u : 0u; mine = (j == x) ? c : mine; }
        if (sum == G) break;
        __builtin_amdgcn_s_sleep(1);
        if ((++sp & 255u) == 0u) { if (xb_ld(&bar[XB_TMO])) break; if (sp > XB_SPIN_CAP) { atomicAdd(&bar[XB_TMO], 1u); break; } }
    }
    nloc = mine > 0u ? mine : 1u; nx = cnt > 0u ? cnt : 1u;
}

__device__ __forceinline__ void xcd_barrier(const XcdBarrier& b) {
    asm volatile("s_waitcnt vmcnt(0)" ::: "memory");
    __syncthreads();
    if (threadIdx.x == 0) {
        unsigned* bar = b.bar;
        __builtin_amdgcn_s_waitcnt(0);
        unsigned nloc = b.st[0], nx = b.st[1];
        if (nloc == 0u) { xcd_barrier_complete(bar, b.x, nloc, nx); b.st[0] = nloc; b.st[1] = nx; }
        const unsigned old = xb_add(&bar[XB_XSUB(b.x)], 1u);
        const unsigned gen = old / nloc;
        if (old + 1u == (gen + 1u) * nloc) {
            __builtin_amdgcn_fence(__ATOMIC_RELEASE, "agent");
            asm volatile("s_waitcnt vmcnt(0)" ::: "memory");
            const unsigned og = xb_add(&bar[XB_TOP], 1u);
            const unsigned tg = og / nx;
            if (og + 1u == (tg + 1u) * nx) xb_add(&bar[XB_TOPGEN], 1u);
            else XB_SPIN(xb_ld(&bar[XB_TOPGEN]) == tg, bar);
            __builtin_amdgcn_fence(__ATOMIC_ACQUIRE, "agent");
            xb_add(&bar[XB_XGEN(b.x)], 1u);
            asm volatile("s_waitcnt vmcnt(0)" ::: "memory");
        } else {
            XB_SPIN(xb_ld(&bar[XB_XGEN(b.x)]) == gen, bar);
            __builtin_amdgcn_fence(__ATOMIC_ACQUIRE, "agent");
            asm volatile("s_waitcnt vmcnt(0)" ::: "memory");
        }
    }
    __syncthreads();
}


DI int next_item(unsigned* c, LAS int* slot, int tid) { __syncthreads(); if (tid == 0) *slot = (int)atomicAdd(c, 1u); __syncthreads(); return *slot; }

template <class Epi> DI void run_gemm(LAS unsigned char* lds, const bf16_t* A, const bf16_t* Bt, int N, int K, const Epi& E) {
    N = launder_s(N); K = launder_s(K);
    pg8::StaticOrder S; S.init(M_, N, (int)gridDim.x, (int)blockIdx.x);
    pg8::gemm_phase<Epi, pg8::StaticOrder>(lds, pg8::Gemm{A, Bt, M_, N, K}, S, E);
    __syncthreads();
}

__global__ void __launch_bounds__(512) fwd_kernel(Params Pk) {
#define P (kparams())
    extern __shared__ __attribute__((aligned(16))) unsigned char smem[];
    LAS unsigned char* lds = (LAS unsigned char*)smem;
    LAS int* slot = (LAS int*)(lds + MISC_OFF + 8064);
#define ws (P.ws)
#define tid (launder_v((int)threadIdx.x))
#define ctr ((unsigned*)(ws + WS_CTR))
#define rope ((float*)(ws + WS_ROPE))
#define mod ((float*)(ws + WS_MOD))
#define XRES (P.out)
#define hb ((bf16_t*)(ws + WS_H))
#define act ((bf16_t*)(ws + A_ACT))
    if (blockIdx.x == 0) { if (threadIdx.x < 16) ctr[threadIdx.x] = 0u; unsigned* bz = (unsigned*)(ws + WS_BAR); for (int i = threadIdx.x; i < XCD_BAR_WORDS; i += 512) bz[i] = 0u; }
    if (blockIdx.x == gridDim.x - 1) for (int e = tid; e < 1024; e += 512) { const int pos = e >> 4, i = e & 15; const float inv = powf(10000.f, -(float)i / 16.f); const float ang = (float)pos * inv; rope[2 * e] = cosf(ang); rope[2 * e + 1] = sinf(ang); }
    { bf16_t* ck = (bf16_t*)(ws + WS_CK); bf16_t* cv = (bf16_t*)(ws + WS_CV); const float* sk = P.in[7]; const float* sv = P.in[8];
      for (int i = blockIdx.x * 512 + threadIdx.x; i < 131072; i += gridDim.x * 512) { const f32x4 a = *(const f32x4*)(sk + 4 * (size_t)i), c = *(const f32x4*)(sv + 4 * (size_t)i); u32x2 w; w.x = pk2(a[0], a[1]); w.y = pk2(a[2], a[3]); *(u32x2*)(ck + 4 * (size_t)i) = w; w.x = pk2(c[0], c[1]); w.y = pk2(c[2], c[3]); *(u32x2*)(cv + 4 * (size_t)i) = w; } }
    mod_phase(P, lds, tid);
    convert_layer(P, 0, lds, tid, 63);
    cg::this_grid().sync();
    { volatile LAS unsigned* st_ = (volatile LAS unsigned*)(lds + MISC_OFF + 8072); if (threadIdx.x < 2) st_[threadIdx.x] = 0u; __syncthreads(); (void)xcd_barrier_post((unsigned*)(ws + WS_BAR), st_); }
#define GBAR() do { XcdBarrier b_; b_.bar = (unsigned*)(ws + WS_BAR); b_.x = xb_xcc_id(); b_.st = (volatile LAS unsigned*)(lds + MISC_OFF + 8072); xcd_barrier(b_); } while (0)
    { constexpr int l = 0;
#define modl (mod + (size_t)launder_s(l) * 9 * 9216)
#define ng (P.in[13] + (size_t)launder_s(l) * 3 * 1024)
        if (l == 1) convert_layer(P, 1, lds, tid, 42);
        norm_phase(l == 0 ? P.in[0] : XRES, l == 0 ? P.in[1] : XRES + (size_t)MP_ * D_, hb, ng, modl, 0, tid);
        GBAR();
        run_gemm(lds, hb, (const bf16_t*)(ws + W_W1A), 2 * DFF_, D_, EpiSwiglu{act});
        GBAR();
        run_gemm(lds, act, (const bf16_t*)(ws + W_W2A), D_, DFF_, EpiResid{l == 0 ? P.in[0] : XRES, l == 0 ? P.in[1] : XRES + (size_t)MP_ * D_, XRES, modl + 2 * 1024, 0.5f});
        GBAR();
        norm_phase(XRES, XRES + (size_t)MP_ * D_, hb, ng + 1024, modl, 3, tid);
        GBAR();
        if (l == 0) {
            run_gemm(lds, hb, (const bf16_t*)(ws + W_WIN), 3328, D_, EpiInEven{ws, rope});
            GBAR();
            for (;;) { const int it = next_item(ctr + 0, slot, tid); if (it >= 640) break;
                if (it < 256) ret_item(P, it + 128, lds, tid); else if (it < 512) ret_state_item(P, it - 256, lds, tid); else ret_item(P, it - 512, lds, tid); }
            rwkv_shift_phase(P, tid);
            GBAR();
            run_gemm(lds, (const bf16_t*)(ws + A_X), (const bf16_t*)(ws + W_WL), 2560, 256,
                     EpiLora{ws, P.in[21], P.in[23]});
            GBAR();
            for (;;) { const int it = next_item(ctr + 1, slot, tid); if (it >= 768 + 2880) break; if (it < 256) rwkv_scan_half_item(P, it, lds, tid); else if (it < 768) rwkv_scan_item(P, it - 128, lds, tid); else conv_l1_early_item(P, it - 768, lds, tid); }
            GBAR();
            rwkv_post_phase(P, tid);
            GBAR();
        } else {
            run_gemm(lds, hb, (const bf16_t*)(ws + W_WIN), 3072, D_, EpiInOdd{ws, rope, P.in[36], P.in[33], P.in[34], P.out});
            GBAR();
            for (;;) { const int it = next_item(ctr + 2, slot, tid); if (it >= 1792) break;
                if (it < 512) attn_item(P, it, lds, tid); else if (it < 1024) mlstm_item(P, it - 256, lds, tid); else if (it < 1280) mlstm_state_item(P, it - 1024, lds, tid);
                else if (it < 1536) mlstm_item(P, it - 1280, lds, tid); else attn_item(P, 512 + it - 1536, lds, tid); }
            GBAR();
        }
        run_gemm(lds, hb, (const bf16_t*)(ws + W_WOUT), D_, D_, EpiResid{XRES, XRES + (size_t)MP_ * D_, XRES, modl + 5 * 1024, 1.0f});
        GBAR();
        norm_phase(XRES, XRES + (size_t)MP_ * D_, hb, ng + 2048, modl, 6, tid);
        GBAR();
        run_gemm(lds, hb, (const bf16_t*)(ws + W_W1B), 2 * DFF_, D_, EpiSwiglu{act});
        GBAR();
        run_gemm(lds, act, (const bf16_t*)(ws + W_W2B), D_, DFF_, EpiResid{XRES, XRES + (size_t)MP_ * D_, XRES, modl + 8 * 1024, 0.5f});
        GBAR();
    }
    { constexpr int l = 1;
#define modl (mod + (size_t)launder_s(l) * 9 * 9216)
#define ng (P.in[13] + (size_t)launder_s(l) * 3 * 1024)
        if (l == 1) convert_layer(P, 1, lds, tid, 42);
        norm_phase(l == 0 ? P.in[0] : XRES, l == 0 ? P.in[1] : XRES + (size_t)MP_ * D_, hb, ng, modl, 0, tid);
        GBAR();
        run_gemm(lds, hb, (const bf16_t*)(ws + W_W1A), 2 * DFF_, D_, EpiSwiglu{act});
        GBAR();
        run_gemm(lds, act, (const bf16_t*)(ws + W_W2A), D_, DFF_, EpiResid{l == 0 ? P.in[0] : XRES, l == 0 ? P.in[1] : XRES + (size_t)MP_ * D_, XRES, modl + 2 * 1024, 0.5f});
        GBAR();
        norm_phase(XRES, XRES + (size_t)MP_ * D_, hb, ng + 1024, modl, 3, tid);
        GBAR();
        if (l == 0) {
            run_gemm(lds, hb, (const bf16_t*)(ws + W_WIN), 3328, D_, EpiInEven{ws, rope});
            GBAR();
            for (;;) { const int it = next_item(ctr + 0, slot, tid); if (it >= 640) break;
                if (it < 256) ret_item(P, it + 128, lds, tid); else if (it < 512) ret_state_item(P, it - 256, lds, tid); else ret_item(P, it - 512, lds, tid); }
            rwkv_shift_phase(P, tid);
            GBAR();
            run_gemm(lds, (const bf16_t*)(ws + A_X), (const bf16_t*)(ws + W_WL), 2560, 256,
                     EpiLora{ws, P.in[21], P.in[23]});
            GBAR();
            for (;;) { const int it = next_item(ctr + 1, slot, tid); if (it >= 768 + 2880) break; if (it < 256) rwkv_scan_half_item(P, it, lds, tid); else if (it < 768) rwkv_scan_item(P, it - 128, lds, tid); else conv_l1_early_item(P, it - 768, lds, tid); }
            GBAR();
            rwkv_post_phase(P, tid);
            GBAR();
        } else {
            run_gemm(lds, hb, (const bf16_t*)(ws + W_WIN), 3072, D_, EpiInOdd{ws, rope, P.in[36], P.in[33], P.in[34], P.out});
            GBAR();
            for (;;) { const int it = next_item(ctr + 2, slot, tid); if (it >= 1792) break;
                if (it < 512) attn_item(P, it, lds, tid); else if (it < 1024) mlstm_item(P, it - 256, lds, tid); else if (it < 1280) mlstm_state_item(P, it - 1024, lds, tid);
                else if (it < 1536) mlstm_item(P, it - 1280, lds, tid); else attn_item(P, 512 + it - 1536, lds, tid); }
            GBAR();
        }
        run_gemm(lds, hb, (const bf16_t*)(ws + W_WOUT), D_, D_, EpiResid{XRES, XRES + (size_t)MP_ * D_, XRES, modl + 5 * 1024, 1.0f});
        GBAR();
        norm_phase(XRES, XRES + (size_t)MP_ * D_, hb, ng + 2048, modl, 6, tid);
        GBAR();
        run_gemm(lds, hb, (const bf16_t*)(ws + W_W1B), 2 * DFF_, D_, EpiSwiglu{act});
        GBAR();
        run_gemm(lds, act, (const bf16_t*)(ws + W_W2B), D_, DFF_, EpiResid{XRES, XRES + (size_t)MP_ * D_, XRES, modl + 8 * 1024, 0.5f});
        GBAR();
    }
    final_norm_phase(XRES, P.in[37], tid);
#undef tid
#undef GBAR
#undef modl
#undef ng
#undef ctr
#undef rope
#undef mod
#undef XRES
#undef hb
#undef act
#undef ws
#undef P
}

extern "C" void kernel_launch(void* const* d_in, const int* in_sizes, int n_in, void* d_out, int out_size, void* d_ws, size_t ws_size, hipStream_t stream) {
    static int grid_blocks = 0;
    if (grid_blocks == 0) {
        if (n_in != 38 || ws_size < WS_NEED) { fprintf(stderr, "kernel_launch: need 38 inputs and %zu bytes of workspace, got %d / %zu\n", (size_t)WS_NEED, n_in, ws_size); grid_blocks = -1; return; }
        int dev = 0, cus = 0, per_cu = 0;
        hipGetDevice(&dev); hipDeviceGetAttribute(&cus, hipDeviceAttributeMultiprocessorCount, dev);
        if (hipFuncSetAttribute((const void*)fwd_kernel, hipFuncAttributeMaxDynamicSharedMemorySize, LDS_BYTES) != hipSuccess) { fprintf(stderr, "kernel_launch: hipFuncSetAttribute failed\n"); grid_blocks = -1; return; }
        if (hipOccupancyMaxActiveBlocksPerMultiprocessor(&per_cu, (const void*)fwd_kernel, 512, LDS_BYTES) != hipSuccess || per_cu < 1) { fprintf(stderr, "kernel_launch: occupancy query failed (%d)\n", per_cu); grid_blocks = -1; return; }
        grid_blocks = cus * per_cu;
    }
    if (grid_blocks < 0) return;
    Params p{};
    for (int i = 0; i < 38; ++i) p.in[i] = (const float*)d_in[i];
    p.out = (float*)d_out; p.ws = (unsigned char*)d_ws;
    void* args[] = {&p};
    hipError_t e = hipLaunchCooperativeKernel((const void*)fwd_kernel, dim3(grid_blocks), dim3(512), args, LDS_BYTES, stream);
    if (e != hipSuccess) fprintf(stderr, "cooperative launch failed: %s (grid %d)\n", hipGetErrorString(e), grid_blocks);
}
```

```cpp
#include <hip/hip_runtime.h>
#include <hip/hip_cooperative_groups.h>
#include <cstdio>
namespace cg = cooperative_groups;

#define DI __device__ __forceinline__
#define LAS __attribute__((address_space(3)))
typedef unsigned short bf16_t;
typedef short s16x4 __attribute__((ext_vector_type(4)));
typedef float f32x2 __attribute__((ext_vector_type(2)));
typedef unsigned u32x2 __attribute__((ext_vector_type(2)));
typedef __bf16 bf2_t __attribute__((ext_vector_type(2)));

constexpr int M_ = 24576, MP_ = 8192, D_ = 1024, DFF_ = 2816;
constexpr int LDS_BYTES = 139264;
constexpr int MISC_OFF = 131072;

DI unsigned pk2(float a, float b) { f32x2 v = {a, b}; bf2_t r = __builtin_convertvector(v, bf2_t); return __builtin_bit_cast(unsigned, r); }
DI float bf_lo(unsigned u) { return __uint_as_float(u << 16); }
DI float bf_hi(unsigned u) { return __uint_as_float(u & 0xffff0000u); }
DI float bf2f(bf16_t h) { return __uint_as_float(((unsigned)h) << 16); }
DI float silu_f(float x) { return x * __builtin_amdgcn_rcpf(1.f + __expf(-x)); }
DI float sigmoid_f(float x) { return __builtin_amdgcn_rcpf(1.f + __expf(-x)); }
DI float softplus_f(float z) { return fmaxf(z, 0.f) + __logf(1.f + __expf(-fabsf(z))); }
DI float wave_sum(float v) { v += __shfl_xor(v, 32); v += __shfl_xor(v, 16); v += __shfl_xor(v, 8); v += __shfl_xor(v, 4); v += __shfl_xor(v, 2); v += __shfl_xor(v, 1); return v; }
DI float fq_sum(float v) { unsigned u = __float_as_uint(v); const auto a = __builtin_amdgcn_permlane16_swap(u, u, false, false); v = __uint_as_float(a[0]) + __uint_as_float(a[1]);
    u = __float_as_uint(v); const auto b = __builtin_amdgcn_permlane32_swap(u, u, false, false); return __uint_as_float(b[0]) + __uint_as_float(b[1]); }
DI float fq_max(float v) { unsigned u = __float_as_uint(v); const auto a = __builtin_amdgcn_permlane16_swap(u, u, false, false); v = fmaxf(__uint_as_float(a[0]), __uint_as_float(a[1]));
    u = __float_as_uint(v); const auto b = __builtin_amdgcn_permlane32_swap(u, u, false, false); return fmaxf(__uint_as_float(b[0]), __uint_as_float(b[1])); }
DI int cond_of_row(int row) { return row < MP_ ? 0 : 1 + ((row - MP_) >> 11); }
DI int seqpos_of_row(int row) { return row < MP_ ? (row & 255) : ((row - MP_) & 2047); }

DI int launder_v(int v) { asm volatile("" : "+v"(v)); return v; }
DI int launder_s(int v) { asm volatile("" : "+s"(v)); return v; }
struct Params { const float* in[38]; float* out; unsigned char* ws; };

typedef __attribute__((address_space(4))) const Params KParams;
DI KParams& kparams() { KParams* p = (KParams*)__builtin_amdgcn_kernarg_segment_ptr(); asm volatile("" : "+s"(p)); return *p; }
constexpr size_t WS_CTR = 0, WS_ROPE = 256, WS_MOD = 16384, WS_BAR = 786432, WS_W = 1048576;
constexpr size_t W_W1A = WS_W, W_W1B = W_W1A + 11534336, W_W2A = W_W1B + 11534336, W_W2B = W_W2A + 5767168, W_WIN = W_W2B + 5767168,
                 W_WOUT = W_WIN + 6815744, W_WL = W_WOUT + 2097152, WS_H = W_WL + 1310720, WS_AR = WS_H + 50331648;
constexpr size_t SZ512 = (size_t)M_ * 512 * 2;
constexpr size_t A_R = WS_AR, A_K = A_R + SZ512, A_V = A_K + SZ512, A_X = A_V + SZ512, A_Z = A_X + (size_t)M_ * 256 * 2;
constexpr size_t A_QA = A_Z, A_KA = A_QA + (size_t)M_ * 256 * 2, A_VA = A_KA + (size_t)M_ * 256 * 2, A_GA = A_VA + SZ512, A_PB = A_GA + SZ512;
constexpr size_t A_U0 = A_Z, A_U1 = A_U0 + SZ512, A_A0 = A_U1 + SZ512, A_A1 = A_A0 + SZ512, A_G = A_A1 + SZ512, A_Y = A_G + SZ512, A_END = A_Y + 2 * SZ512;
constexpr size_t O_QC = WS_AR, O_KC = O_QC + SZ512, O_VC = O_KC + SZ512, O_OC = O_VC + SZ512, O_QD = O_OC + SZ512,
                 O_KD = O_QD + SZ512, O_VD = O_KD + (size_t)M_ * 128 * 2, O_GT = O_VD + (size_t)M_ * 128 * 2;
constexpr size_t A_ACT = WS_AR;
constexpr size_t WS_CK = A_END, WS_CV = WS_CK + 1048576, WS_NEED = WS_CV + 1048576;
constexpr size_t OUT_RET = 25165824, OUT_RWKV = 27262976, OUT_MC = 29360128, OUT_MN = 33554432, OUT_MM = 33587200, OUT_CK = 33587456, OUT_CV = 34636032;
typedef short bf16x8 __attribute__((ext_vector_type(8)));
typedef float f32x4 __attribute__((ext_vector_type(4)));
typedef unsigned u32x4 __attribute__((ext_vector_type(4)));
namespace pg8 {
#define PG8_LAS __attribute__((address_space(3)))
typedef unsigned short bf16_t;
typedef short bf16x8 __attribute__((ext_vector_type(8)));
typedef float f32x4 __attribute__((ext_vector_type(4)));
typedef unsigned u32x4 __attribute__((ext_vector_type(4)));
constexpr int BM = 256, BK = 64, HALF = 128, HTB = HALF * BK * 2  , STAGE_BYTES = 8 * HTB, NXCD = 8, WGM = 8;

__host__ __device__ __forceinline__ int lds_byte(int r, int c) { const int st = (r >> 4) * 2 + (c >> 5), rr = r & 15, cc = c & 31, ob = rr * 64 + cc * 2; return st * 1024 + (ob ^ (((ob >> 9) & 1) << 5)); }
__host__ __device__ __forceinline__ void stage_rc(int b, int& R, int& C) { const int st = b / 1024, sb = b % 1024, swz = sb ^ (((sb >> 9) & 1) << 5); R = (st >> 1) * 16 + swz / 64; C = (st & 1) * 32 + (swz % 64) / 2; }
__host__ __device__ __forceinline__ int perm32(int rho) { const int n = rho >> 4, i = rho & 15; return 8 * (i >> 2) + 4 * n + (i & 3); }

struct Unit { int pm, pn; };
struct Gemm { const bf16_t* A; const bf16_t* Bt; int M, N, K; };

struct StaticOrder {
    int nM, nN, nwg, G, c;
    __host__ __device__ void init(int M, int N, int G_, int c_) { nM = M / BM; nN = N / BM; nwg = nM * nN; G = G_; c = c_; }
    __host__ __device__ bool next(int i, Unit& u) const {
        const long L = (long)i * G + c; if (L >= nwg) return false;
        int wgid = (int)L; { const int q = nwg / NXCD, r = nwg % NXCD, xcd = wgid % NXCD, off = wgid / NXCD; wgid = (xcd < r ? xcd * (q + 1) : r * (q + 1) + (xcd - r) * q) + off; }
        const int nig = WGM * nN, gid = wgid / nig, fm = gid * WGM, gsz = (nM - fm) < WGM ? (nM - fm) : WGM;
        u.pm = fm + ((wgid % nig) % gsz); u.pn = (wgid % nig) / gsz; return true;
    }
    __device__ __forceinline__ void a_ready(const Unit&) const {}
    __device__ __forceinline__ void done(const Unit&) const {}
};
template <class Epi, class Sched>
__device__ __forceinline__ void gemm_phase(PG8_LAS unsigned char* lds, const Gemm g, const Sched& S, const Epi& E) {
    const int tid = launder_v((int)threadIdx.x), wid = __builtin_amdgcn_readfirstlane(tid >> 6), lane = tid & 63, wr = wid >> 2, wc = wid & 3, fr = lane & 15, fq = lane >> 4;
    const int K = g.K, nt = K / BK;
    unsigned voffA[2], voffB[2];
#pragma unroll
    for (int i = 0; i < 2; ++i) { int R, C; stage_rc(tid * 16 + i * 8192, R, C); const int Rb = Epi::PERM ? ((R & ~31) + perm32(R & 31)) : R;
        voffA[i] = (unsigned)(R * K + C) * 2u; voffB[i] = (unsigned)(Rb * K + C) * 2u; }
    const size_t kstep = (size_t)(BK * 2);
    const size_t hstep = (size_t)HALF * K * 2;
    const size_t tstep = 2 * hstep;
    const unsigned ldsw = (unsigned)wid * 1024u;
    const int aoff = lds_byte(wr * 64 + fr, fq * 8), boff = lds_byte(wc * 32 + fr, fq * 8);
#define PG8_SA(b, h) (((b) * 2 + (h)) * HTB)
#define PG8_SB(b, h) ((4 + (b) * 2 + (h)) * HTB)
#define PG8_STAGE(bufoff, gbase, voff) do { _Pragma("unroll") for (int _i = 0; _i < 2; ++_i) \
        __builtin_amdgcn_global_load_lds((const unsigned*)((const char*)(gbase) + (voff)[_i]), (PG8_LAS unsigned*)(lds + (bufoff) + ldsw + _i * 8192), 16, 0, 0); } while (0)
#define PG8_LDA(dst, b, h) do { _Pragma("unroll") for (int m = 0; m < 4; ++m) _Pragma("unroll") for (int k = 0; k < 2; ++k) dst[m][k] = *(const PG8_LAS bf16x8*)(lds + PG8_SA(b, h) + aoff + m * 2048 + k * 1024); } while (0)
#define PG8_LDB(dst, b, h) do { _Pragma("unroll") for (int n = 0; n < 2; ++n) _Pragma("unroll") for (int k = 0; k < 2; ++k) dst[n][k] = *(const PG8_LAS bf16x8*)(lds + PG8_SB(b, h) + boff + n * 2048 + k * 1024); } while (0)
#define PG8_MMA(ai, bj, At, Bt) do { __builtin_amdgcn_s_setprio(1); _Pragma("unroll") for (int m = 0; m < 4; ++m) _Pragma("unroll") for (int n = 0; n < 2; ++n) _Pragma("unroll") for (int k = 0; k < 2; ++k) \
        acc[ai][bj][m][n] = __builtin_amdgcn_mfma_f32_16x16x32_bf16(Bt[n][k], At[m][k], acc[ai][bj][m][n], 0, 0, 0); __builtin_amdgcn_s_setprio(0); } while (0)
#define PG8_WAIT_V(n) asm volatile("s_waitcnt vmcnt(" #n ")" ::: "memory")
#define PG8_WAIT_L(n) asm volatile("s_waitcnt lgkmcnt(" #n ")" ::: "memory")
#define PG8_BAR __builtin_amdgcn_s_barrier()
#define PG8_SCHED __builtin_amdgcn_sched_barrier(0)
    Unit cur, nxt; int ui = 0;
    if (!S.next(0, cur)) return;
    f32x4 acc[2][2][4][2];
#pragma unroll
    for (int a = 0; a < 2; ++a)
#pragma unroll
        for (int b = 0; b < 2; ++b)
#pragma unroll
            for (int m = 0; m < 4; ++m)
#pragma unroll
                for (int n = 0; n < 2; ++n) acc[a][b][m][n] = (f32x4){0.f, 0.f, 0.f, 0.f};
    bf16x8 At[4][2], B0[2][2], B1[2][2];
    const char* cA = (const char*)g.A + (size_t)cur.pm * tstep; const char* cB = (const char*)g.Bt + (size_t)cur.pn * tstep;
    S.a_ready(cur);
    PG8_STAGE(PG8_SB(0, 0), cB, voffB); PG8_STAGE(PG8_SA(0, 0), cA, voffA); PG8_STAGE(PG8_SB(0, 1), cB + hstep, voffB); PG8_STAGE(PG8_SA(0, 1), cA + hstep, voffA);
    if (wr == 1) PG8_BAR;
    PG8_WAIT_V(4); PG8_BAR;
    PG8_STAGE(PG8_SB(1, 0), cB + kstep, voffB); PG8_STAGE(PG8_SA(1, 0), cA + kstep, voffA); PG8_STAGE(PG8_SB(1, 1), cB + hstep + kstep, voffB);
    PG8_WAIT_V(6); PG8_BAR;
    for (;;) {
        const bool has_next = S.next(ui + 1, nxt);
        const char* nA = has_next ? (const char*)g.A + (size_t)nxt.pm * tstep : cA; const char* nB = has_next ? (const char*)g.Bt + (size_t)nxt.pn * tstep : cB;
        for (int t = 0; t < nt; t += 2) {
            const bool last = (t == nt - 2);
            const char* a1 = cA + (size_t)(t + 1) * kstep;
            const char* a2 = last ? nA : cA + (size_t)(t + 2) * kstep; const char* b2 = last ? nB : cB + (size_t)(t + 2) * kstep;
            const char* a3 = a2 + kstep; const char* b3 = b2 + kstep;
            if (last && has_next) S.a_ready(nxt);
            PG8_LDB(B0, 0, 0); PG8_SCHED; PG8_LDA(At, 0, 0); PG8_STAGE(PG8_SA(1, 1), a1 + hstep, voffA);
            PG8_WAIT_L(8); PG8_BAR; PG8_WAIT_L(0); PG8_MMA(0, 0, At, B0); PG8_BAR; PG8_SCHED;
            PG8_LDB(B1, 0, 1); PG8_STAGE(PG8_SB(0, 0), b2, voffB);
            PG8_BAR; PG8_WAIT_L(0); PG8_MMA(0, 1, At, B1); PG8_BAR;
            PG8_LDA(At, 0, 1); PG8_STAGE(PG8_SA(0, 0), a2, voffA);
            PG8_BAR; PG8_WAIT_L(0); PG8_MMA(1, 0, At, B0); PG8_BAR; PG8_SCHED;
            PG8_STAGE(PG8_SB(0, 1), b2 + hstep, voffB);
            PG8_WAIT_V(6); PG8_BAR; PG8_MMA(1, 1, At, B1); PG8_BAR;
            PG8_LDB(B0, 1, 0); PG8_SCHED; PG8_LDA(At, 1, 0); PG8_STAGE(PG8_SA(0, 1), a2 + hstep, voffA);
            PG8_WAIT_L(8); PG8_BAR; PG8_WAIT_L(0); PG8_MMA(0, 0, At, B0); PG8_BAR; PG8_SCHED;
            PG8_LDB(B1, 1, 1); PG8_STAGE(PG8_SB(1, 0), b3, voffB);
            PG8_BAR; PG8_WAIT_L(0); PG8_MMA(0, 1, At, B1); PG8_BAR;
            PG8_LDA(At, 1, 1); PG8_STAGE(PG8_SA(1, 0), a3, voffA);
            PG8_BAR; PG8_WAIT_L(0); PG8_MMA(1, 0, At, B0); PG8_BAR; PG8_SCHED;
            PG8_STAGE(PG8_SB(1, 1), b3 + hstep, voffB);
            PG8_WAIT_V(6); PG8_BAR; PG8_MMA(1, 1, At, B1); PG8_BAR;
        }
        if constexpr (!Epi::AFTER_DRAIN) { E(acc, cur, wr, wc, fr, fq); S.done(cur); }
        if (!has_next) break;
#pragma unroll
        for (int a = 0; a < 2; ++a)
#pragma unroll
            for (int b = 0; b < 2; ++b)
#pragma unroll
                for (int m = 0; m < 4; ++m)
#pragma unroll
                    for (int n = 0; n < 2; ++n) acc[a][b][m][n] = (f32x4){0.f, 0.f, 0.f, 0.f};
        cur = nxt; cA = nA; cB = nB; ++ui;
    }
    PG8_WAIT_V(0);
    if (wr == 0) PG8_BAR;
    PG8_BAR;
    if constexpr (Epi::AFTER_DRAIN) { E.fused(acc, cur, wr, wc, fr, fq, lds, wid, lane); S.done(cur); }
#undef PG8_SA
#undef PG8_SB
#undef PG8_STAGE
#undef PG8_LDA
#undef PG8_LDB
#undef PG8_MMA
#undef PG8_WAIT_V
#undef PG8_WAIT_L
#undef PG8_BAR
#undef PG8_SCHED
}
}
using pg8::Unit;
typedef f32x4 Acc[2][2][4][2];

template <class F> DI void store_tile_bf16(const Acc& acc, bf16_t* dst, int ld, int coloff, const Unit& u, int wr, int wc, int fr, int fq, F f) {
    const int row0 = u.pm * 256 + wr * 64 + fr, col0 = coloff + wc * 32 + 4 * fq;
#pragma unroll
    for (int ai = 0; ai < 2; ++ai)
#pragma unroll
        for (int m = 0; m < 4; ++m) { bf16_t* rp = dst + (size_t)(row0 + ai * 128 + m * 16) * ld + col0;
#pragma unroll
            for (int bj = 0; bj < 2; ++bj)
#pragma unroll
                for (int n = 0; n < 2; ++n) { const f32x4 v = acc[ai][bj][m][n]; u32x2 w; w.x = pk2(f(v[0]), f(v[1])); w.y = pk2(f(v[2]), f(v[3])); *(u32x2*)(rp + bj * 128 + n * 16) = w; } }
}

struct EpiSwiglu {
    static constexpr bool PERM = false, AFTER_DRAIN = false;
    bf16_t* act;
    DI void operator()(const Acc& acc, const Unit& u, int wr, int wc, int fr, int fq) const {
        const int row0 = u.pm * 256 + wr * 64 + fr, col0 = u.pn * 128 + wc * 32 + 4 * fq;
#pragma unroll
        for (int ai = 0; ai < 2; ++ai)
#pragma unroll
            for (int m = 0; m < 4; ++m) { bf16_t* rp = act + (size_t)(row0 + ai * 128 + m * 16) * DFF_ + col0;
#pragma unroll
                for (int n = 0; n < 2; ++n) { const f32x4 g = acc[ai][0][m][n], up = acc[ai][1][m][n]; u32x2 w;
                    w.x = pk2(silu_f(g[0]) * up[0], silu_f(g[1]) * up[1]); w.y = pk2(silu_f(g[2]) * up[2], silu_f(g[3]) * up[3]); *(u32x2*)(rp + n * 16) = w; } }
    }
};

struct EpiResid {
    static constexpr bool PERM = false, AFTER_DRAIN = false;
    const float* xin_p; const float* xin_s; float* xout; const float* gate; float scale;
    DI void operator()(const Acc& acc, const Unit& u, int wr, int wc, int fr, int fq) const {
        const int row0 = u.pm * 256 + wr * 64 + fr, col0 = u.pn * 256 + wc * 32 + 4 * fq;
        const int ci = u.pm < 32 ? 0 : 1 + ((u.pm - 32) >> 3);
        const float* gt = gate + (size_t)ci * 9216 + col0;
        f32x4 gv[2][2];
#pragma unroll
        for (int bj = 0; bj < 2; ++bj)
#pragma unroll
            for (int n = 0; n < 2; ++n) gv[bj][n] = *(const f32x4*)(gt + bj * 128 + n * 16) * scale;
#pragma unroll
        for (int ai = 0; ai < 2; ++ai)
#pragma unroll
            for (int m = 0; m < 4; ++m) { const int row = row0 + ai * 128 + m * 16;
                const float* ip = (row < MP_ ? xin_p + (size_t)row * D_ : xin_s + (size_t)(row - MP_) * D_) + col0; float* op = xout + (size_t)row * D_ + col0;
#pragma unroll
                for (int bj = 0; bj < 2; ++bj)
#pragma unroll
                    for (int n = 0; n < 2; ++n) { const f32x4 xv = *(const f32x4*)(ip + bj * 128 + n * 16); *(f32x4*)(op + bj * 128 + n * 16) = xv + gv[bj][n] * acc[ai][bj][m][n]; } }
    }
};

DI void rope_pair(f32x4& x1, f32x4& x2, const float* tab, int pos, int fq) {
    const f32x4 t0 = *(const f32x4*)(tab + (pos * 16 + 4 * fq) * 2), t1 = *(const f32x4*)(tab + (pos * 16 + 4 * fq) * 2 + 4);
    const float c[4] = {t0[0], t0[2], t1[0], t1[2]}, s[4] = {t0[1], t0[3], t1[1], t1[3]};
#pragma unroll
    for (int j = 0; j < 4; ++j) { const float a = x1[j], b = x2[j]; x1[j] = a * c[j] - b * s[j]; x2[j] = a * s[j] + b * c[j]; }
}

struct EpiInEven {
    static constexpr bool PERM = false, AFTER_DRAIN = false;
    unsigned char* wsb; const float* rope;
    DI void operator()(const Acc& acc, const Unit& u, int wr, int wc, int fr, int fq) const {
        const int pn = u.pn;
        if (pn < 2) {
            bf16_t* dst = (bf16_t*)(wsb + (pn == 0 ? A_QA : A_KA)); const float sc = pn == 0 ? 1.f : 0.125f; const bool lat = u.pm >= 32;
            const int row0 = u.pm * 256 + wr * 64 + fr, col0 = wc * 32 + 4 * fq;
#pragma unroll
            for (int ai = 0; ai < 2; ++ai)
#pragma unroll
                for (int m = 0; m < 4; ++m) { const int row = row0 + ai * 128 + m * 16; const int t = (row - MP_) & 2047; const int pos = (wc & 1) ? (t & 63) : (t >> 6);
#pragma unroll
                    for (int bj = 0; bj < 2; ++bj) { f32x4 x1 = acc[ai][bj][m][0], x2 = acc[ai][bj][m][1];
                        if (lat) rope_pair(x1, x2, rope, pos, fq);
                        bf16_t* rp = dst + (size_t)row * 256 + bj * 128 + col0; u32x2 w;
                        w.x = pk2(x1[0] * sc, x1[1] * sc); w.y = pk2(x1[2] * sc, x1[3] * sc); *(u32x2*)rp = w;
                        w.x = pk2(x2[0] * sc, x2[1] * sc); w.y = pk2(x2[2] * sc, x2[3] * sc); *(u32x2*)(rp + 16) = w; } }
        } else if (pn < 4) { store_tile_bf16(acc, (bf16_t*)(wsb + A_VA), 512, (pn - 2) * 256, u, wr, wc, fr, fq, [](float x) { return x; });
        } else if (pn < 6) { store_tile_bf16(acc, (bf16_t*)(wsb + A_GA), 512, (pn - 4) * 256, u, wr, wc, fr, fq, [](float x) { return silu_f(x); });
        } else { store_tile_bf16(acc, (bf16_t*)(wsb + A_PB), 1792, (pn - 6) * 256, u, wr, wc, fr, fq, [](float x) { return x; }); }
    }
};

struct EpiInOdd {
    static constexpr bool PERM = false, AFTER_DRAIN = false;
    unsigned char* wsb; const float* rope; const float* qk_gain; const float* ibias; const float* fbias; float* outb;
    DI void operator()(const Acc& acc, const Unit& u, int wr, int wc, int fr, int fq) const {
        const int pn = u.pn;
        if (pn < 2) { store_tile_bf16(acc, (bf16_t*)(wsb + O_QC), 512, pn * 256, u, wr, wc, fr, fq, [](float x) { return x; });
        } else if (pn < 4) { store_tile_bf16(acc, (bf16_t*)(wsb + O_KC), 512, (pn - 2) * 256, u, wr, wc, fr, fq, [](float x) { return x * 0.08838834764831845f; });
        } else if (pn < 6) { store_tile_bf16(acc, (bf16_t*)(wsb + O_VC), 512, (pn - 4) * 256, u, wr, wc, fr, fq, [](float x) { return x; });
        } else if (pn < 8) { store_tile_bf16(acc, (bf16_t*)(wsb + O_OC), 512, (pn - 6) * 256, u, wr, wc, fr, fq, [](float x) { return sigmoid_f(x); });
        } else if (pn < 11) {
            const bool lat = u.pm >= 32; const bool isv = (pn == 10) && (wc >= 2); const bool isk = (pn == 10) && (wc < 2);
            const float* gain = qk_gain + (isk ? 64 : 0);
            const int row0 = u.pm * 256 + wr * 64 + fr;
#pragma unroll
            for (int ai = 0; ai < 2; ++ai)
#pragma unroll
                for (int m = 0; m < 4; ++m) { const int row = row0 + ai * 128 + m * 16;
                    f32x4 v[2][2];
#pragma unroll
                    for (int bj = 0; bj < 2; ++bj)
#pragma unroll
                        for (int n = 0; n < 2; ++n) v[bj][n] = acc[ai][bj][m][n];
                    if (!isv) {
                        float ss = 0.f;
#pragma unroll
                        for (int bj = 0; bj < 2; ++bj)
#pragma unroll
                            for (int n = 0; n < 2; ++n)
#pragma unroll
                                for (int j = 0; j < 4; ++j) ss += v[bj][n][j] * v[bj][n][j];
                        ss = fq_sum(ss);
                        const float rs = rsqrtf(ss * (1.f / 64.f) + 1e-6f);
#pragma unroll
                        for (int bj = 0; bj < 2; ++bj)
#pragma unroll
                            for (int n = 0; n < 2; ++n) v[bj][n] = v[bj][n] * rs * *(const f32x4*)(gain + 32 * bj + 16 * n + 4 * fq);
                    }
                    if (!lat && pn == 10) {
                        const int b = row >> 8, t = row & 255, hh = wc & 1; float* op = outb + (isk ? OUT_CK : OUT_CV) + ((size_t)(b * 2 + hh) * 256 + t) * 64 + 4 * fq;
#pragma unroll
                        for (int bj = 0; bj < 2; ++bj)
#pragma unroll
                            for (int n = 0; n < 2; ++n) *(f32x4*)(op + 32 * bj + 16 * n) = v[bj][n];
                    }
                    if (lat && !isv) { const int t = (row - MP_) & 2047; rope_pair(v[0][0], v[0][1], rope, t >> 6, fq); rope_pair(v[1][0], v[1][1], rope, t & 63, fq); }
                    bf16_t* rp;
                    if (pn < 10) rp = (bf16_t*)(wsb + O_QD) + (size_t)row * 512 + (4 * (pn - 8) + wc) * 64 + 4 * fq;
                    else rp = (bf16_t*)(wsb + (isk ? O_KD : O_VD)) + (size_t)row * 128 + (wc & 1) * 64 + 4 * fq;
#pragma unroll
                    for (int bj = 0; bj < 2; ++bj)
#pragma unroll
                        for (int n = 0; n < 2; ++n) { u32x2 w; w.x = pk2(v[bj][n][0], v[bj][n][1]); w.y = pk2(v[bj][n][2], v[bj][n][3]); *(u32x2*)(rp + 32 * bj + 16 * n) = w; }
                }
        } else {
            if (wc == 0) {
                const int row0 = u.pm * 256 + wr * 64 + fr; const int c0 = 4 * fq;
                const f32x4 bias = c0 < 8 ? *(const f32x4*)(ibias + c0) : *(const f32x4*)(fbias + c0 - 8);
#pragma unroll
                for (int ai = 0; ai < 2; ++ai)
#pragma unroll
                    for (int m = 0; m < 4; ++m) { const int row = row0 + ai * 128 + m * 16; f32x4 v = acc[ai][0][m][0] + bias;
                        if (c0 >= 8) { v[0] = -softplus_f(-v[0]); v[1] = -softplus_f(-v[1]); v[2] = -softplus_f(-v[2]); v[3] = -softplus_f(-v[3]); }
                        *(f32x4*)((float*)(wsb + O_GT) + (size_t)row * 16 + c0) = v; }
            }
        }
    }
};

struct EpiLora {
    static constexpr bool PERM = false, AFTER_DRAIN = false;
    unsigned char* wsb; const float* w0; const float* a0b;
    DI void operator()(const Acc& acc, const Unit& u, int wr, int wc, int fr, int fq) const {
        const int pn = u.pn;
        if (pn >= 8) { store_tile_bf16(acc, (bf16_t*)(wsb + A_G), 512, (pn - 8) * 256, u, wr, wc, fr, fq, [](float x) { return x; }); return; }
        const int d = (pn >> 1) & 1, cb = (pn & 1) * 256; const bool isw = pn < 4;
        bf16_t* dst = (bf16_t*)(wsb + (isw ? (d ? A_U1 : A_U0) : (d ? A_A1 : A_A0))); const int boff = d * 512 + cb;
        const int row0 = u.pm * 256 + wr * 64 + fr, col0 = wc * 32 + 4 * fq;
#pragma unroll
        for (int ai = 0; ai < 2; ++ai)
#pragma unroll
            for (int m = 0; m < 4; ++m) { bf16_t* rp = dst + (size_t)(row0 + ai * 128 + m * 16) * 512 + cb + col0;
#pragma unroll
                for (int bj = 0; bj < 2; ++bj)
#pragma unroll
                    for (int n = 0; n < 2; ++n) { const float* bp = (isw ? w0 : a0b) + boff + col0 + bj * 128 + n * 16; f32x4 v = acc[ai][bj][m][n] + *(const f32x4*)bp;
#pragma unroll
                        for (int j = 0; j < 4; ++j) { const float ez = __expf(-v[j]); const float sg = __builtin_amdgcn_rcpf(1.f + ez); v[j] = isw ? sg * 0.6065306597f : sg; }
                        u32x2 w; w.x = pk2(v[0], v[1]); w.y = pk2(v[2], v[3]); *(u32x2*)(rp + bj * 128 + n * 16) = w; } }
    }
};
DI int map_col(int kind, int n) {
    if (kind == 0) return n;
    if (kind == 1) { const int pn = n >> 8, bj = (n >> 7) & 1, q = n & 127; return bj * DFF_ + pn * 128 + q; }
    const int pn = n >> 8, tc = n & 255;
    if (pn < 6) return n;
    if (pn < 8) return 1552 + (n - 1536);
    const int hh = (tc & 127) >> 5, bj = tc >> 7, d = 32 * bj + (tc & 31);
    if (pn < 10) return 2064 + (4 * (pn - 8) + hh) * 64 + d;
    if (pn == 10) return hh < 2 ? 2576 + hh * 64 + d : 2704 + (hh - 2) * 64 + d;
    return tc < 16 ? 1536 + tc : -1;
}
DI void conv_load(float (&r)[8], const float* src, int ld, int K, int kind, int tile, int tid) {
    const int tk = K >> 6, n0 = (tile / tk) << 6, k0 = (tile % tk) << 6;
#pragma unroll
    for (int q = 0; q < 8; ++q) { const int e = tid + 512 * q; const int kk = e >> 6, nn = e & 63; const int col = map_col(kind, n0 + nn); r[q] = col >= 0 ? __builtin_nontemporal_load(src + (size_t)(k0 + kk) * ld + col) : 0.f; }
}
DI void conv_finish(const float (&r)[8], bf16_t* dst, int K, int tile, LAS float* T, int tid) {
    const int tk = K >> 6, n0 = (tile / tk) << 6, k0 = (tile % tk) << 6;
    __syncthreads();
#pragma unroll
    for (int q = 0; q < 8; ++q) { const int e = tid + 512 * q; T[(e >> 6) * 65 + (e & 63)] = r[q]; }
    __syncthreads();
    for (int e = tid; e < 2048; e += 512) { const int nn = e >> 5, kp = e & 31; *(unsigned*)(dst + (size_t)(n0 + nn) * K + k0 + 2 * kp) = pk2(T[(2 * kp) * 65 + nn], T[(2 * kp + 1) * 65 + nn]); }
}
DI void conv_tile(const float* src, int ld, bf16_t* dst, int K, int kind, int tile, LAS float* T, int tid) {
    float r[8]; conv_load(r, src, ld, K, kind, tile, tid); conv_finish(r, dst, K, tile, T, tid);
}
struct ConvJob { const float* src; int ld; bf16_t* dst; int K, N, kind; };
DI void convert_layer(KParams& P, int l, LAS unsigned char* lds, int tid, int mask) {
    unsigned char* ws = P.ws;
    ConvJob jobs[6];
    jobs[0] = {P.in[14] + (size_t)(l * 2 + 0) * D_ * 2 * DFF_, 2 * DFF_, (bf16_t*)(ws + W_W1A), D_, 2 * DFF_, 1};
    jobs[1] = {P.in[14] + (size_t)(l * 2 + 1) * D_ * 2 * DFF_, 2 * DFF_, (bf16_t*)(ws + W_W1B), D_, 2 * DFF_, 1};
    jobs[2] = {P.in[15] + (size_t)(l * 2 + 0) * DFF_ * D_, D_, (bf16_t*)(ws + W_W2A), DFF_, D_, 0};
    jobs[3] = {P.in[15] + (size_t)(l * 2 + 1) * DFF_ * D_, D_, (bf16_t*)(ws + W_W2B), DFF_, D_, 0};
    if (l == 0) { jobs[4] = {P.in[16], 3328, (bf16_t*)(ws + W_WIN), D_, 3328, 0}; jobs[5] = {P.in[17], D_, (bf16_t*)(ws + W_WOUT), D_, D_, 0}; }
    else        { jobs[4] = {P.in[31], 2832, (bf16_t*)(ws + W_WIN), D_, 3072, 3}; jobs[5] = {P.in[32], D_, (bf16_t*)(ws + W_WOUT), D_, D_, 0}; }
    LAS float* T = (LAS float*)lds;
#pragma unroll
    for (int j = 0; j < 6; ++j) { if (!((mask >> j) & 1)) continue; const ConvJob J = jobs[j]; const int nt = (J.N >> 6) * (J.K >> 6);
        int t = blockIdx.x; float r0[8], r1[8];
        if (t < nt) conv_load(r0, J.src, J.ld, J.K, J.kind, t, tid);
        for (; t < nt; t += 2 * (int)gridDim.x) {
            const int t1 = t + (int)gridDim.x, t2 = t1 + (int)gridDim.x;
            if (t1 < nt) conv_load(r1, J.src, J.ld, J.K, J.kind, t1, tid);
            conv_finish(r0, J.dst, J.K, t, T, tid);
            if (t2 < nt) conv_load(r0, J.src, J.ld, J.K, J.kind, t2, tid);
            if (t1 < nt) conv_finish(r1, J.dst, J.K, t1, T, tid);
        } }
    if (l == 0) {
        bf16_t* wl = (bf16_t*)(ws + W_WL); const float* w2 = P.in[22]; const float* a2 = P.in[24]; const float* g2 = P.in[25];
        for (int e = blockIdx.x * 512 + tid; e < 2560 * 128; e += gridDim.x * 512) { const int n = e >> 7, k = (e & 127) * 2; const int sel = n >> 9, c = n & 511; float v0 = 0.f, v1 = 0.f;
            if (sel < 2) { if (k < 64) { v0 = w2[(size_t)(sel * 64 + k) * 512 + c]; v1 = w2[(size_t)(sel * 64 + k + 1) * 512 + c]; } }
            else if (sel < 4) { if (k >= 64 && k < 128) { v0 = a2[(size_t)((sel - 2) * 64 + k - 64) * 512 + c]; v1 = a2[(size_t)((sel - 2) * 64 + k - 63) * 512 + c]; } }
            else { if (k >= 128) { v0 = g2[(size_t)(k - 128) * 512 + c]; v1 = g2[(size_t)(k - 127) * 512 + c]; } }
            *(unsigned*)(wl + (size_t)n * 256 + k) = pk2(v0, v1); }
    }
}


DI void conv_l1_early_item(KParams& P, int idx, LAS unsigned char* lds, int tid) {
    LAS float* T = (LAS float*)lds;
    if (idx < 1408) conv_tile(P.in[14] + (size_t)(1 * 2 + 0) * D_ * 2 * DFF_, 2 * DFF_, (bf16_t*)(P.ws + W_W1A), D_, 1, idx, T, tid);
    else if (idx < 2112) conv_tile(P.in[15] + (size_t)(1 * 2 + 0) * DFF_ * D_, D_, (bf16_t*)(P.ws + W_W2A), DFF_, 0, idx - 1408, T, tid);
    else conv_tile(P.in[31], 2832, (bf16_t*)(P.ws + W_WIN), D_, 3, idx - 2112, T, tid);
}
DI void mod_phase(KParams& P, LAS unsigned char* lds, int tid) {
    LAS float* sc = (LAS float*)lds;
    LAS float* red = sc + 9 * 1024;
    const float* c = P.in[9]; const float* cctx = P.in[10];
    for (int e = tid; e < 9 * 1024; e += 512) { const int ci = e >> 10, k = e & 1023; const float v = ci == 0 ? cctx[k] : c[(ci - 1) * 1024 + k]; sc[e] = silu_f(v); }
    __syncthreads();
    float* mod = (float*)(P.ws + WS_MOD);
    const int wid = tid >> 6, lane = tid & 63;
    for (int it = blockIdx.x; it < 288; it += gridDim.x) { const int l = it / 144, n0 = (it % 144) * 64;
        const float* w = P.in[11] + (size_t)l * D_ * 9216 + n0 + lane;
        float acc[9];
#pragma unroll
        for (int i = 0; i < 9; ++i) acc[i] = 0.f;
        for (int k = wid * 128; k < wid * 128 + 128; k += 16) {
            float wv[16];
#pragma unroll
            for (int q = 0; q < 16; ++q) wv[q] = __builtin_nontemporal_load(w + (size_t)(k + q) * 9216);
#pragma unroll
            for (int q = 0; q < 16; ++q)
#pragma unroll
                for (int i = 0; i < 9; ++i) acc[i] += sc[i * 1024 + k + q] * wv[q];
        }
#pragma unroll
        for (int i = 0; i < 9; ++i) red[(wid * 9 + i) * 64 + lane] = acc[i];
        __syncthreads();
        for (int o = tid; o < 576; o += 512) { const int i = o >> 6, ln = o & 63; float s = 0.f;
#pragma unroll
            for (int w8 = 0; w8 < 8; ++w8) s += red[(w8 * 9 + i) * 64 + ln];
            mod[(size_t)(l * 9 + i) * 9216 + n0 + ln] = s + P.in[12][(size_t)l * 9216 + n0 + ln]; }
        __syncthreads();
    }
}

DI void norm_phase(const float* xp, const float* xs, bf16_t* h, const float* g, const float* modl, int qsh, int tid) {
    const int wid = tid >> 6, lane = tid & 63; const int stride = gridDim.x * 8;
    int row = blockIdx.x * 8 + wid;
    f32x4 v[4], nv[4];
    if (row < M_) { const float* xr = row < MP_ ? xp + (size_t)row * D_ : xs + (size_t)(row - MP_) * D_;
#pragma unroll
        for (int i = 0; i < 4; ++i) v[i] = *(const f32x4*)(xr + 4 * lane + 256 * i); }
    for (; row < M_; row += stride) {
        const int nrow = row + stride;
        if (nrow < M_) { const float* xr = nrow < MP_ ? xp + (size_t)nrow * D_ : xs + (size_t)(nrow - MP_) * D_;
#pragma unroll
            for (int i = 0; i < 4; ++i) nv[i] = *(const f32x4*)(xr + 4 * lane + 256 * i); }
        const float* sh = modl + (size_t)cond_of_row(row) * 9216 + qsh * 1024; const float* sc = sh + 1024;
        float ss = 0.f;
#pragma unroll
        for (int i = 0; i < 4; ++i) ss += v[i][0] * v[i][0] + v[i][1] * v[i][1] + v[i][2] * v[i][2] + v[i][3] * v[i][3];
        ss = wave_sum(ss); const float rs = rsqrtf(ss * (1.f / 1024.f) + 1e-6f);
#pragma unroll
        for (int i = 0; i < 4; ++i) { const int c = 4 * lane + 256 * i; const f32x4 gg = *(const f32x4*)(g + c), s1 = *(const f32x4*)(sc + c), s0 = *(const f32x4*)(sh + c);
            const f32x4 y = v[i] * rs * gg * (s1 + 1.f) + s0; u32x2 w; w.x = pk2(y[0], y[1]); w.y = pk2(y[2], y[3]); *(u32x2*)(h + (size_t)row * D_ + c) = w; }
#pragma unroll
        for (int i = 0; i < 4; ++i) v[i] = nv[i];
    }
}
DI void final_norm_phase(float* x, const float* g, int tid) {
    const int wid = tid >> 6, lane = tid & 63; const int stride = gridDim.x * 8;
    int row = blockIdx.x * 8 + wid;
    f32x4 v[4], nv[4];
    if (row < M_) {
#pragma unroll
        for (int i = 0; i < 4; ++i) v[i] = *(const f32x4*)(x + (size_t)row * D_ + 4 * lane + 256 * i); }
    for (; row < M_; row += stride) {
        const int nrow = row + stride;
        if (nrow < M_) {
#pragma unroll
            for (int i = 0; i < 4; ++i) nv[i] = *(const f32x4*)(x + (size_t)nrow * D_ + 4 * lane + 256 * i); }
        float* xr = x + (size_t)row * D_; float ss = 0.f;
#pragma unroll
        for (int i = 0; i < 4; ++i) ss += v[i][0] * v[i][0] + v[i][1] * v[i][1] + v[i][2] * v[i][2] + v[i][3] * v[i][3];
        ss = wave_sum(ss); const float rs = rsqrtf(ss * (1.f / 1024.f) + 1e-6f);
#pragma unroll
        for (int i = 0; i < 4; ++i) { const int c = 4 * lane + 256 * i; *(f32x4*)(xr + c) = v[i] * rs * *(const f32x4*)(g + c); }
#pragma unroll
        for (int i = 0; i < 4; ++i) v[i] = nv[i];
    }
}
#define MFMA16(a, b, c) __builtin_amdgcn_mfma_f32_16x16x32_bf16((a), (b), (c), 0, 0, 0)
template <int COLS> DI void stage_bf16(LAS bf16_t* dst, const bf16_t* src, size_t ldg, int rows, int pitch, int tid) {
    constexpr int PR = COLS / 8;
    for (int p = tid; p < rows * PR; p += 512) { const int r = p / PR, c8 = p % PR; const u32x4 v = *(const u32x4*)(src + (size_t)r * ldg + c8 * 8); *(LAS u32x4*)(dst + r * pitch + c8 * 8) = v; }
}
template <int COLS> DI void stage_f32(LAS bf16_t* dst, const float* src, size_t ldg, int rows, int pitch, int tid) {
    constexpr int PR = COLS / 4;
    for (int p = tid; p < rows * PR; p += 512) { const int r = p / PR, c4 = p % PR; const f32x4 v = *(const f32x4*)(src + (size_t)r * ldg + c4 * 4); u32x2 w; w.x = pk2(v[0], v[1]); w.y = pk2(v[2], v[3]); *(LAS u32x2*)(dst + r * pitch + c4 * 4) = w; }
}

template <int COLS> DI void tile_load(u32x4 (&r)[COLS / 32], const bf16_t* src, size_t ldg, int tid) {
    constexpr int PR = COLS / 8;
#pragma unroll
    for (int i = 0; i < COLS / 32; ++i) { const int p = tid + 512 * i; r[i] = *(const u32x4*)(src + (size_t)(p / PR) * ldg + (p % PR) * 8); }
}
template <int COLS> DI void tile_store(LAS bf16_t* dst, const u32x4 (&r)[COLS / 32], int pitch, int tid) {
    constexpr int PR = COLS / 8;
#pragma unroll
    for (int i = 0; i < COLS / 32; ++i) { const int p = tid + 512 * i; *(LAS u32x4*)(dst + (p / PR) * pitch + (p % PR) * 8) = r[i]; }
}
DI void tile_load_f32x64(f32x4 (&r)[4], const float* src, int tid) {
#pragma unroll
    for (int i = 0; i < 4; ++i) r[i] = *(const f32x4*)(src + (size_t)(tid + 512 * i) * 4);
}
DI void tile_store_f32x64(LAS bf16_t* dst, const f32x4 (&r)[4], int pitch, int tid) {
#pragma unroll
    for (int i = 0; i < 4; ++i) { const int p = tid + 512 * i; u32x2 w; w.x = pk2(r[i][0], r[i][1]); w.y = pk2(r[i][2], r[i][3]); *(LAS u32x2*)(dst + (p >> 4) * pitch + (p & 15) * 4) = w; }
}
template <int DK> DI void qk_tile(const LAS bf16_t* sK, const bf16x8 (&qf)[DK / 32], f32x4 (&sacc)[8], int fr, int fq) {
#pragma unroll
    for (int jt = 0; jt < 8; ++jt) { f32x4 a = {0.f, 0.f, 0.f, 0.f};
#pragma unroll
        for (int s = 0; s < DK / 32; ++s) { const bf16x8 kf = *(const LAS bf16x8*)(sK + (16 * jt + fr) * (DK + 8) + 32 * s + 8 * fq); a = MFMA16(kf, qf[s], a); }
        sacc[jt] = a; }
}
template <int DV, int PITCH = DV + 8> DI void pv_tile(const LAS bf16_t* sV, const bf16x8 (&pf)[4], f32x4 (&oacc)[DV / 16], int fr, int fq) {
#pragma unroll
    for (int et = 0; et < DV / 16; ++et)
#pragma unroll
        for (int s = 0; s < 4; ++s) {
            const LAS bf16_t* p0 = sV + (32 * s + 4 * fq + (fr >> 2)) * PITCH + 16 * et + 4 * (fr & 3);
            const s16x4 lo = __builtin_amdgcn_ds_read_tr16_b64_v4i16((LAS s16x4*)p0), hi = __builtin_amdgcn_ds_read_tr16_b64_v4i16((LAS s16x4*)(p0 + 16 * PITCH));
            const bf16x8 vf = __builtin_shufflevector(lo, hi, 0, 1, 2, 3, 4, 5, 6, 7);
            oacc[et] = MFMA16(vf, pf[s], oacc[et]); }
}
DI void pack_p(const f32x4 (&p)[8], bf16x8 (&pf)[4]) {
#pragma unroll
    for (int s = 0; s < 4; ++s) { u32x4 w; w.x = pk2(p[2 * s][0], p[2 * s][1]); w.y = pk2(p[2 * s][2], p[2 * s][3]); w.z = pk2(p[2 * s + 1][0], p[2 * s + 1][1]); w.w = pk2(p[2 * s + 1][2], p[2 * s + 1][3]); pf[s] = __builtin_bit_cast(bf16x8, w); }
}
template <int DKQ> DI void pack_q_state(const bf16_t* qrow, float f0, float f1, bf16x8 (&pf)[4], f32x4 (&pv)[8], int fq) {
#pragma unroll
    for (int s = 0; s < 4; ++s)
#pragma unroll
        for (int hh = 0; hh < 2; ++hh) { const int key = 32 * s + 16 * hh + 4 * fq; const int d = DKQ == 64 ? (key & 63) : key; const float fac = (DKQ == 64 && key >= 64) ? f1 : f0;
            const u32x2 w = *(const u32x2*)(qrow + d); f32x4 v; v[0] = bf_lo(w.x) * fac; v[1] = bf_hi(w.x) * fac; v[2] = bf_lo(w.y) * fac; v[3] = bf_hi(w.y) * fac; pv[2 * s + hh] = v; }
    pack_p(pv, pf);
}
DI void ln_gate_store(f32x4 (&o)[8], float eps, const float* wgt, const bf16_t* gate, bf16_t* dst, int fq) {
    float s = 0.f;
#pragma unroll
    for (int et = 0; et < 8; ++et) s += o[et][0] + o[et][1] + o[et][2] + o[et][3];
    s = fq_sum(s); const float mu = s * (1.f / 128.f); float vs = 0.f;
#pragma unroll
    for (int et = 0; et < 8; ++et)
#pragma unroll
        for (int j = 0; j < 4; ++j) { const float d = o[et][j] - mu; vs += d * d; }
    vs = fq_sum(vs); const float rs = rsqrtf(vs * (1.f / 128.f) + eps);
#pragma unroll
    for (int et = 0; et < 8; ++et) { const int e = 16 * et + 4 * fq; const f32x4 wv = *(const f32x4*)(wgt + e); const u32x2 gw = *(const u32x2*)(gate + e);
        u32x2 w; w.x = pk2((o[et][0] - mu) * rs * wv[0] * bf_lo(gw.x), (o[et][1] - mu) * rs * wv[1] * bf_hi(gw.x));
        w.y = pk2((o[et][2] - mu) * rs * wv[2] * bf_lo(gw.y), (o[et][3] - mu) * rs * wv[3] * bf_hi(gw.y)); *(u32x2*)(dst + e) = w; }
}


template <int DK> DI void state_mfma(const bf16_t* kg, size_t ldk, const bf16_t* vg, size_t ldv, const LAS float* wj, LAS unsigned char* lds, float* out, float* nout, int tid) {
    constexpr int PK = DK == 128 ? 144 : 72, NE = DK == 128 ? 8 : 4, PR = DK / 8;
    const int wid = tid >> 6, lane = tid & 63, fr = lane & 15, fq = lane >> 4;
    const int dt = DK == 128 ? wid : (wid & 3), e0 = DK == 128 ? 0 : (wid >> 2) * 4;
    LAS bf16_t* sKw = (LAS bf16_t*)lds; LAS bf16_t* sV = (LAS bf16_t*)(lds + 36864);
    f32x4 acc[NE];
#pragma unroll
    for (int i = 0; i < NE; ++i) acc[i] = (f32x4){0.f, 0.f, 0.f, 0.f};
    float nacc = 0.f;
#pragma unroll 1
    for (int hf = 0; hf < 2; ++hf) {
        __syncthreads();
        for (int p = tid; p < 128 * PR; p += 512) { const int r = p / PR, c8 = p % PR; const u32x4 v = *(const u32x4*)(kg + (size_t)(128 * hf + r) * ldk + c8 * 8); const float w = wj[128 * hf + r];
            u32x4 o; o.x = pk2(bf_lo(v.x) * w, bf_hi(v.x) * w); o.y = pk2(bf_lo(v.y) * w, bf_hi(v.y) * w); o.z = pk2(bf_lo(v.z) * w, bf_hi(v.z) * w); o.w = pk2(bf_lo(v.w) * w, bf_hi(v.w) * w);
            *(LAS u32x4*)(sKw + r * PK + c8 * 8) = o; }
        stage_bf16<128>(sV, vg + (size_t)(128 * hf) * ldv, ldv, 128, 144, tid);
        __syncthreads();
#pragma unroll
        for (int s = 0; s < 4; ++s) {
            const LAS bf16_t* pa = sKw + (32 * s + 4 * fq + (fr >> 2)) * PK + 16 * dt + 4 * (fr & 3);
            const s16x4 alo = __builtin_amdgcn_ds_read_tr16_b64_v4i16((LAS s16x4*)pa), ahi = __builtin_amdgcn_ds_read_tr16_b64_v4i16((LAS s16x4*)(pa + 16 * PK));
            const bf16x8 af = __builtin_shufflevector(alo, ahi, 0, 1, 2, 3, 4, 5, 6, 7);
#pragma unroll
            for (int i = 0; i < NE; ++i) {
                const LAS bf16_t* pb = sV + (32 * s + 4 * fq + (fr >> 2)) * 144 + 16 * (e0 + i) + 4 * (fr & 3);
                const s16x4 blo = __builtin_amdgcn_ds_read_tr16_b64_v4i16((LAS s16x4*)pb), bhi = __builtin_amdgcn_ds_read_tr16_b64_v4i16((LAS s16x4*)(pb + 16 * 144));
                const bf16x8 bfv = __builtin_shufflevector(blo, bhi, 0, 1, 2, 3, 4, 5, 6, 7);
                acc[i] = MFMA16(af, bfv, acc[i]); }
        }
        if (nout && tid < DK) { for (int j = 0; j < 128; ++j) nacc += bf2f(sKw[j * PK + tid]); }
    }
#pragma unroll
    for (int i = 0; i < NE; ++i)
#pragma unroll
        for (int r = 0; r < 4; ++r) out[(size_t)(16 * dt + 4 * fq + r) * 128 + 16 * (e0 + i) + fr] = acc[i][r];
    if (nout && tid < DK) nout[tid] = nacc;
}
DI void ret_item(KParams& P, int item, LAS unsigned char* lds, int tid) {
    const int wid = tid >> 6, lane = tid & 63, fr = lane & 15, fq = lane >> 4;
    int b, h, c, L, rowbase, nc; bool lat;
    if (item < 128) { b = item >> 2; h = item & 3; c = 0; L = 256; rowbase = b * 256; nc = 2; lat = false; }
    else { const int it = item - 128; b = it >> 5; h = (it >> 3) & 3; c = it & 7; L = 2048; rowbase = MP_ + b * 2048; nc = 16; lat = true; }
    const bf16_t* qA = (const bf16_t*)(P.ws + A_QA); const bf16_t* kA = (const bf16_t*)(P.ws + A_KA); const bf16_t* vA = (const bf16_t*)(P.ws + A_VA); const bf16_t* gA = (const bf16_t*)(P.ws + A_GA);
    LAS bf16_t* sK = (LAS bf16_t*)lds; LAS bf16_t* sV = (LAS bf16_t*)(lds + 128 * 72 * 2);
    const float lgf = P.in[18][h], lgb = P.in[18][4 + h];
    const float lgf2 = lgf * 1.4426950408889634f, lgb2 = lgb * 1.4426950408889634f;
    const int ti0 = 256 * c + 32 * wid + fr;
    bf16x8 qf[2][2];
#pragma unroll
    for (int it = 0; it < 2; ++it)
#pragma unroll
        for (int s = 0; s < 2; ++s) qf[it][s] = *(const bf16x8*)(qA + (size_t)(rowbase + ti0 + 16 * it) * 256 + h * 64 + 32 * s + 8 * fq);
    f32x4 oacc[2][8];
#pragma unroll
    for (int it = 0; it < 2; ++it)
#pragma unroll
        for (int et = 0; et < 8; ++et) oacc[it][et] = (f32x4){0.f, 0.f, 0.f, 0.f};
    f32x4 sacc[8]; bf16x8 pf[2][4];
    auto pv2 = [&](const LAS bf16_t* cV) {
#pragma unroll
        for (int et = 0; et < 8; ++et)
#pragma unroll
            for (int s = 0; s < 4; ++s) {
                const LAS bf16_t* p0 = cV + (32 * s + 4 * fq + (fr >> 2)) * 144 + 16 * et + 4 * (fr & 3);
                const s16x4 lo = __builtin_amdgcn_ds_read_tr16_b64_v4i16((LAS s16x4*)p0), hi = __builtin_amdgcn_ds_read_tr16_b64_v4i16((LAS s16x4*)(p0 + 16 * 144));
                const bf16x8 vf = __builtin_shufflevector(lo, hi, 0, 1, 2, 3, 4, 5, 6, 7);
                oacc[0][et] = MFMA16(vf, pf[0][s], oacc[0][et]); oacc[1][et] = MFMA16(vf, pf[1][s], oacc[1][et]); if (s == 3 && (et & 1)) __builtin_amdgcn_sched_barrier(0); } };
    {
        u32x4 rk[2], rv[4];
        const bf16_t* kg = kA + (size_t)rowbase * 256 + h * 64; const bf16_t* vg = vA + (size_t)rowbase * 512 + h * 128;
        tile_load<64>(rk, kg, 256, tid); tile_load<128>(rv, vg, 512, tid);
        __syncthreads();
        tile_store<64>(sK, rk, 72, tid); tile_store<128>(sV, rv, 144, tid);
        if (nc > 1) { tile_load<64>(rk, kg + (size_t)128 * 256, 256, tid); tile_load<128>(rv, vg + (size_t)128 * 512, 512, tid); }
        __syncthreads();
        for (int kc = 0; kc < nc; ++kc) {
            const LAS bf16_t* cK = sK + (kc & 1) * 27648; const LAS bf16_t* cV = sV + (kc & 1) * 27648;
#pragma unroll
            for (int it = 0; it < 2; ++it) {
                qk_tile<64>(cK, qf[it], sacc, fr, fq);
#pragma unroll
                for (int jt = 0; jt < 8; ++jt)
#pragma unroll
                    for (int r = 0; r < 4; ++r) { const int tj = 128 * kc + 16 * jt + 4 * fq + r; const int dl = ti0 + 16 * it - tj;
                        const float e = __builtin_amdgcn_exp2f((dl > 0 ? lgf2 : lgb2) * (float)(dl > 0 ? dl : -dl)); sacc[jt][r] *= (dl == 0 ? 2.f : e); }
                pack_p(sacc, pf[it]); }
            pv2(cV);
            { const int tl = launder_v(tid);
            if (kc + 1 < nc) { tile_store<64>(sK + ((kc + 1) & 1) * 27648, rk, 72, tl); tile_store<128>(sV + ((kc + 1) & 1) * 27648, rv, 144, tl); }
            if (kc + 2 < nc) { tile_load<64>(rk, kg + (size_t)128 * (kc + 2) * 256, 256, tl); tile_load<128>(rv, vg + (size_t)128 * (kc + 2) * 512, 512, tl); } }
            __syncthreads();
        }
    }
    if (lat) {
        __syncthreads();
        const float* s0 = P.in[2] + (size_t)b * 2 * 4 * 64 * 128;
        stage_f32<128>(sV, s0 + (size_t)(0 * 4 + h) * 64 * 128, 128, 64, 144, tid);
        stage_f32<128>(sV + 64 * 144, s0 + (size_t)(1 * 4 + h) * 64 * 128, 128, 64, 144, tid);
        __syncthreads();
#pragma unroll
        for (int it = 0; it < 2; ++it) { const int ti = ti0 + 16 * it;
            pack_q_state<64>(qA + (size_t)(rowbase + ti) * 256 + h * 64, __expf(lgf * (float)(ti + 1)), __expf(lgb * (float)(L - ti)), pf[it], sacc, fq); }
        pv2(sV);
    }
#pragma unroll
    for (int it = 0; it < 2; ++it) { const int qrow = launder_v(rowbase + ti0) + 16 * it;
        ln_gate_store(oacc[it], 1e-5f, P.in[19] + h * 128, gA + (size_t)qrow * 512 + h * 128, (bf16_t*)(P.ws + WS_H) + (size_t)qrow * D_ + h * 128, fq); }
}
DI void ret_state_item(KParams& P, int item, LAS unsigned char* lds, int tid) {
    const int b = item >> 3, h = (item >> 1) & 3, dir = item & 1; const int rowbase = b * 256;
    const bf16_t* kA = (const bf16_t*)(P.ws + A_KA); const bf16_t* vA = (const bf16_t*)(P.ws + A_VA);
    LAS float* wj = (LAS float*)(lds + MISC_OFF);
    const float lg = P.in[18][dir * 4 + h];
    __syncthreads();
    if (tid < 256) wj[tid] = __expf(lg * (float)(dir ? tid : 255 - tid));
    state_mfma<64>(kA + (size_t)rowbase * 256 + h * 64, 256, vA + (size_t)rowbase * 512 + h * 128, 512, wj, lds, P.out + OUT_RET + (size_t)((b * 2 + dir) * 4 + h) * 64 * 128, nullptr, tid);
}
DI float wave_incl_sum(float v, int lane) {
#pragma unroll
    for (int o = 1; o < 64; o <<= 1) { const float t = __shfl_up(v, o); if (lane >= o) v += t; }
    return v;
}
DI float wave_incl_max(float v, int lane) {
#pragma unroll
    for (int o = 1; o < 64; o <<= 1) { const float t = __shfl_up(v, o); if (lane >= o) v = fmaxf(v, t); }
    return v;
}
DI void gate_scan(const LAS float* ig, const LAS float* lf, LAS float* cf, LAS float* rowf, LAS float* Fq, int L, int t0, bool rev, float m0, int lane, float& Ftot, float& Mtot) {
    float csum = 0.f, cmax = m0;
    for (int blk = 0; blk < L; blk += 64) { const int pos = blk + lane; const int t = rev ? L - 1 - pos : pos;
        const float F = csum + wave_incl_sum(lf[t], lane); const float c = ig[t] - F; const float pm = fmaxf(cmax, wave_incl_max(c, lane));
        cf[t] = c; if (t >= t0 && t < t0 + 128) { rowf[t - t0] = -pm; Fq[t - t0] = F; }
        csum = __shfl(F, 63); cmax = __shfl(pm, 63); }
    Ftot = csum; Mtot = cmax;
}
DI void mlstm_item(KParams& P, int item, LAS unsigned char* lds, int tid) {
    const int wid = tid >> 6, lane = tid & 63, fr = lane & 15, fq = lane >> 4;
    int b, h, c, L, rowbase, nc; bool lat;
    if (item < 256) { b = item >> 3; h = (item >> 1) & 3; c = item & 1; L = 256; rowbase = b * 256; nc = 2; lat = false; }
    else { const int it = item - 256; b = it >> 6; h = (it >> 4) & 3; c = it & 15; L = 2048; rowbase = MP_ + b * 2048; nc = 16; lat = true; }
    const bf16_t* qC = (const bf16_t*)(P.ws + O_QC); const bf16_t* kC = (const bf16_t*)(P.ws + O_KC); const bf16_t* vC = (const bf16_t*)(P.ws + O_VC); const bf16_t* oC = (const bf16_t*)(P.ws + O_OC);
    const float* gates = (const float*)(P.ws + O_GT); bf16_t* mix = (bf16_t*)(P.ws + WS_H);
    LAS bf16_t* sK = (LAS bf16_t*)lds; LAS bf16_t* sV = (LAS bf16_t*)(lds + 34816);
    LAS float* cfa = (LAS float*)(lds + 73728);
    LAS float* rowfa = (LAS float*)(lds + 90112);
    LAS float* Fqa = rowfa + 256;
    LAS float* tmp = (LAS float*)(lds + 94208);
    __syncthreads();
    for (int t = tid; t < L; t += 512) { const float* g = gates + (size_t)(rowbase + t) * 16; tmp[t] = g[h]; tmp[2048 + t] = g[8 + h]; tmp[4096 + t] = g[4 + h]; tmp[6144 + t] = g[12 + h]; }
    __syncthreads();
    float m0f = 0.f, m0b = 0.f;
    if (lat) { m0f = P.in[6][(b * 2 + 0) * 4 + h]; m0b = P.in[6][(b * 2 + 1) * 4 + h]; }
    {
        LAS float* bs = (LAS float*)(lds + MISC_OFF);
        const int nblk = L >> 6;
        for (int j = wid; j < 2 * nblk; j += 8) { const int dr = j >= nblk, blk = dr ? j - nblk : j; const int pos = 64 * blk + lane; const int t = dr ? L - 1 - pos : pos;
            LAS float* ig = tmp + dr * 4096; LAS float* lf = ig + 2048;
            const float Fl = wave_incl_sum(lf[t], lane); const float cl = ig[t] - Fl; const float pm = wave_incl_max(cl, lane);
            cfa[dr * 2048 + t] = cl; ig[t] = pm; lf[t] = Fl;
            if (lane == 63) { bs[dr * 32 + blk] = Fl; bs[64 + dr * 32 + blk] = pm; } }
        __syncthreads();
        if (wid == 0) { const int dr = lane >> 5, blk = lane & 31;
            if (blk < nblk) { float C = 0.f, cm = dr ? m0b : m0f;
                for (int q = 0; q < blk; ++q) { cm = fmaxf(cm, bs[64 + dr * 32 + q] - C); C += bs[dr * 32 + q]; }
                bs[128 + dr * 32 + blk] = C; bs[192 + dr * 32 + blk] = cm; } }
        __syncthreads();
        for (int e = tid; e < 2 * L; e += 512) { const int dr = e >= L, t = dr ? e - L : e; const int pos = dr ? L - 1 - t : t; const int blk = pos >> 6;
            const float C = bs[128 + dr * 32 + blk], cm = bs[192 + dr * 32 + blk];
            cfa[dr * 2048 + t] -= C;
            if (t >= 128 * c && t < 128 * c + 128) { rowfa[dr * 128 + t - 128 * c] = -fmaxf(cm, tmp[dr * 4096 + t] - C); Fqa[dr * 128 + t - 128 * c] = tmp[dr * 4096 + 2048 + t] + C; } }
    }
    __syncthreads();
    const int ti = 128 * c + 16 * wid + fr; const int qrow = rowbase + ti;
    bf16x8 qf[4];
#pragma unroll
    for (int s = 0; s < 4; ++s) qf[s] = *(const bf16x8*)(qC + (size_t)qrow * 512 + h * 128 + 32 * s + 8 * fq);
    f32x4 hsum[8];
#pragma unroll
    for (int et = 0; et < 8; ++et) hsum[et] = (f32x4){0.f, 0.f, 0.f, 0.f};
    f32x4 sacc[8]; bf16x8 pf[4];
#pragma unroll 1
    for (int dir = 0; dir < 2; ++dir) {
        f32x4 num[8];
#pragma unroll
        for (int et = 0; et < 8; ++et) num[et] = (f32x4){0.f, 0.f, 0.f, 0.f};
        float den = 0.f;
        const float rf = rowfa[dir * 128 + 16 * wid + fr]; const LAS float* cf = cfa + dir * 2048;
        const int k0 = dir ? c : 0, k1 = dir ? nc : c + 1;
        {
            u32x4 rk[4], rv[4];
            const bf16_t* kg = kC + (size_t)rowbase * 512 + h * 128; const bf16_t* vg = vC + (size_t)rowbase * 512 + h * 128;
            tile_load<128>(rk, kg + (size_t)128 * k0 * 512, 512, tid); tile_load<128>(rv, vg + (size_t)128 * k0 * 512, 512, tid);
            for (int kc = k0; kc < k1; ++kc) {
                __syncthreads();
                tile_store<128>(sK, rk, 136, tid); tile_store<128>(sV, rv, 144, tid);
                __syncthreads();
                if (kc + 1 < k1) { tile_load<128>(rk, kg + (size_t)128 * (kc + 1) * 512, 512, tid); tile_load<128>(rv, vg + (size_t)128 * (kc + 1) * 512, 512, tid); }
                qk_tile<128>(sK, qf, sacc, fr, fq);
#pragma unroll
                for (int jt = 0; jt < 8; ++jt) { const f32x4 cv = *(const LAS f32x4*)(cf + 128 * kc + 16 * jt + 4 * fq);
#pragma unroll
                    for (int r = 0; r < 4; ++r) { const int tj = 128 * kc + 16 * jt + 4 * fq + r; const bool ok = dir ? (tj >= ti) : (tj <= ti);
                        const float w = ok ? __expf(rf + cv[r]) : 0.f; const float p = sacc[jt][r] * w; sacc[jt][r] = p; den += p; } }
                pack_p(sacc, pf);
                pv_tile<128, 144>(sV, pf, num, fr, fq);
            }
        }
        if (lat) {
            __syncthreads();
            stage_f32<128>(sV, P.in[4] + (size_t)((b * 2 + dir) * 4 + h) * 128 * 128, 128, 128, 144, tid);
            __syncthreads();
            const float fac = __expf((dir ? m0b : m0f) + rf);
            pack_q_state<128>(qC + (size_t)qrow * 512 + h * 128, fac, fac, pf, sacc, fq);
            const float* n0 = P.in[5] + (size_t)((b * 2 + dir) * 4 + h) * 128;
#pragma unroll
            for (int jt = 0; jt < 8; ++jt) { const f32x4 nv = *(const f32x4*)(n0 + 16 * jt + 4 * fq); den += sacc[jt][0] * nv[0] + sacc[jt][1] * nv[1] + sacc[jt][2] * nv[2] + sacc[jt][3] * nv[3]; }
            pv_tile<128, 144>(sV, pf, num, fr, fq);
        }
        den = fq_sum(den);
        const float thr = __expf(rf - Fqa[dir * 128 + 16 * wid + fr]);
        const float dn = 1.f / fmaxf(fabsf(den), thr);
#pragma unroll
        for (int et = 0; et < 8; ++et) hsum[et] += num[et] * dn;
    }
    ln_gate_store(hsum, 1e-5f, P.in[35] + h * 128, oC + (size_t)qrow * 512 + h * 128, mix + (size_t)qrow * D_ + h * 128, fq);
}
DI void mlstm_state_item(KParams& P, int item, LAS unsigned char* lds, int tid) {
    const int wid = tid >> 6, lane = tid & 63;
    const int b = item >> 3, h = (item >> 1) & 3, dir = item & 1; const int rowbase = b * 256;
    const bf16_t* kC = (const bf16_t*)(P.ws + O_KC); const bf16_t* vC = (const bf16_t*)(P.ws + O_VC); const float* gates = (const float*)(P.ws + O_GT);
    LAS float* mi = (LAS float*)(lds + MISC_OFF);
    __syncthreads();
    if (tid < 256) { const float* g = gates + (size_t)(rowbase + tid) * 16; mi[tid] = g[dir * 4 + h]; mi[256 + tid] = g[8 + dir * 4 + h]; }
    __syncthreads();
    if (wid == 0) { float Ft, Mt; gate_scan(mi, mi + 256, mi + 512, mi + 768, mi + 896, 256, 0, dir == 1, 0.f, lane, Ft, Mt); if (lane == 0) { mi[1024] = Ft; mi[1025] = Mt; } }
    __syncthreads();
    const float Ft = mi[1024], Mt = mi[1025];
    if (tid < 256) mi[512 + tid] = __expf(mi[512 + tid] - Mt);
    const size_t sidx = (size_t)(b * 2 + dir) * 4 + h;
    state_mfma<128>(kC + (size_t)rowbase * 512 + h * 128, 512, vC + (size_t)rowbase * 512 + h * 128, 512, mi + 512, lds, P.out + OUT_MC + sidx * 128 * 128, P.out + OUT_MN + sidx * 128, tid);
    if (tid == 0) P.out[OUT_MM + sidx] = Ft + Mt;
}
DI void attn_item(KParams& P, int item, LAS unsigned char* lds, int tid) {
    const int wid = tid >> 6, lane = tid & 63, fr = lane & 15, fq = lane >> 4;
    int b, qh, qb, rowbase, nkt; bool lat;
    if (item >= 512) { const int it = item - 512; b = it >> 3; qh = it & 7; qb = 0; rowbase = b * 256; nkt = 2; lat = false; }
    else { b = item >> 6; qh = (item >> 3) & 7; qb = item & 7; rowbase = MP_ + b * 2048; nkt = 20; lat = true; }
    const int kvh = qh >> 2;
    const bf16_t* qD = (const bf16_t*)(P.ws + O_QD); const bf16_t* kD = (const bf16_t*)(P.ws + O_KD); const bf16_t* vD = (const bf16_t*)(P.ws + O_VD); bf16_t* mix = (bf16_t*)(P.ws + WS_H);
    LAS bf16_t* sK = (LAS bf16_t*)lds; LAS bf16_t* sV = (LAS bf16_t*)(lds + 128 * 72 * 2);
    const int qrow = rowbase + 256 * qb + 32 * wid + fr;
    bf16x8 qf[2][2];
#pragma unroll
    for (int it = 0; it < 2; ++it)
#pragma unroll
        for (int s = 0; s < 2; ++s) qf[it][s] = *(const bf16x8*)(qD + (size_t)(qrow + 16 * it) * 512 + qh * 64 + 32 * s + 8 * fq);
    f32x4 oacc[2][4];
#pragma unroll
    for (int it = 0; it < 2; ++it)
#pragma unroll
        for (int et = 0; et < 4; ++et) oacc[it][et] = (f32x4){0.f, 0.f, 0.f, 0.f};
    float mrun[2] = {-1e30f, -1e30f}, lpart[2] = {0.f, 0.f};
    f32x4 sacc[2][8]; bf16x8 pf[2][4];
    {
        u32x4 ra[2], rc[2];
        const bf16_t* cKb = (const bf16_t*)(P.ws + WS_CK); const bf16_t* cVb = (const bf16_t*)(P.ws + WS_CV);
        auto t_load = [&](int kt) {
            if (lat && kt < 4) { const size_t off = ((size_t)(b * 2 + kvh) * 512 + 128 * kt) * 64; tile_load<64>(ra, cKb + off, 64, tid); tile_load<64>(rc, cVb + off, 64, tid); }
            else { const size_t r0 = (size_t)rowbase + 128 * (lat ? kt - 4 : kt); tile_load<64>(ra, kD + r0 * 128 + kvh * 64, 128, tid); tile_load<64>(rc, vD + r0 * 128 + kvh * 64, 128, tid); } };
        auto t_store = [&](int kt) { tile_store<64>(sK + (kt & 1) * 18432, ra, 72, tid); tile_store<64>(sV + (kt & 1) * 18432, rc, 72, tid); };
        t_load(0);
        __syncthreads();
        t_store(0);
        if (nkt > 1) t_load(1);
        __syncthreads();
        for (int kt = 0; kt < nkt; ++kt) {
            const LAS bf16_t* cK = sK + (kt & 1) * 18432; const LAS bf16_t* cV = sV + (kt & 1) * 18432;
#pragma unroll
            for (int jt = 0; jt < 8; ++jt) { f32x4 a0 = {0.f, 0.f, 0.f, 0.f}, a1 = {0.f, 0.f, 0.f, 0.f};
#pragma unroll
                for (int s = 0; s < 2; ++s) { const bf16x8 kf = *(const LAS bf16x8*)(cK + (16 * jt + fr) * 72 + 32 * s + 8 * fq); a0 = MFMA16(kf, qf[0][s], a0); a1 = MFMA16(kf, qf[1][s], a1); }
                sacc[0][jt] = a0; sacc[1][jt] = a1; }
#pragma unroll
            for (int it = 0; it < 2; ++it) {
                float tmax = -1e30f;
#pragma unroll
                for (int jt = 0; jt < 8; ++jt)
#pragma unroll
                    for (int r = 0; r < 4; ++r) tmax = fmaxf(tmax, sacc[it][jt][r]);
                tmax = fq_max(tmax) * 0.18033688011112042f;
                const float mnew = fmaxf(mrun[it], tmax), alpha = __builtin_amdgcn_exp2f(mrun[it] - mnew); float ps = 0.f;
#pragma unroll
                for (int jt = 0; jt < 8; ++jt)
#pragma unroll
                    for (int r = 0; r < 4; ++r) { const float p = __builtin_amdgcn_exp2f(sacc[it][jt][r] * 0.18033688011112042f - mnew); sacc[it][jt][r] = p; ps += p; }
                lpart[it] = lpart[it] * alpha + ps; mrun[it] = mnew;
                if (__builtin_amdgcn_ballot_w64(alpha != 1.f)) {
#pragma unroll
                    for (int et = 0; et < 4; ++et) oacc[it][et] *= alpha; }
                pack_p(sacc[it], pf[it]);
            }
#pragma unroll
            for (int et = 0; et < 4; ++et)
#pragma unroll
                for (int s = 0; s < 4; ++s) {
                    const LAS bf16_t* p0 = cV + (32 * s + 4 * fq + (fr >> 2)) * 72 + 16 * et + 4 * (fr & 3);
                    const s16x4 lo = __builtin_amdgcn_ds_read_tr16_b64_v4i16((LAS s16x4*)p0), hi = __builtin_amdgcn_ds_read_tr16_b64_v4i16((LAS s16x4*)(p0 + 16 * 72));
                    const bf16x8 vf = __builtin_shufflevector(lo, hi, 0, 1, 2, 3, 4, 5, 6, 7);
                    oacc[0][et] = MFMA16(vf, pf[0][s], oacc[0][et]); oacc[1][et] = MFMA16(vf, pf[1][s], oacc[1][et]); }
            if (kt + 1 < nkt) t_store(kt + 1);
            if (kt + 2 < nkt) t_load(kt + 2);
            __syncthreads();
        }
    }
#pragma unroll
    for (int it = 0; it < 2; ++it) {
        const float inv = 1.f / fq_sum(lpart[it]);
        bf16_t* dst = (bf16_t*)(P.ws + WS_H) + (size_t)(launder_v(qrow) + 16 * it) * D_ + 512 + qh * 64 + 4 * fq;
#pragma unroll
        for (int et = 0; et < 4; ++et) { u32x2 w; w.x = pk2(oacc[it][et][0] * inv, oacc[it][et][1] * inv); w.y = pk2(oacc[it][et][2] * inv, oacc[it][et][3] * inv); *(u32x2*)(dst + 16 * et) = w; }
    }
}

DI void rwkv_shift_row(const bf16_t* pB, const float* mu, bf16_t* rB, bf16_t* kB, bf16_t* vB, bf16_t* X, int row, int lane) {
    const int t = seqpos_of_row(row), L = row < MP_ ? 256 : 2048; const bool hp = t > 0, hn = t < L - 1;
    const bf16_t* pr = pB + (size_t)row * 1792;
    u32x2 cu[7], pu[7], nu[7];
#pragma unroll
    for (int g = 0; g < 7; ++g) { const int c = 256 * g + 4 * lane; cu[g] = *(const u32x2*)(pr + c); pu[g] = (u32x2){0u, 0u}; nu[g] = (u32x2){0u, 0u};
        if (hp) pu[g] = *(const u32x2*)(pr - 1792 + c); if (hn) nu[g] = *(const u32x2*)(pr + 1792 + c); }
#pragma unroll
    for (int g = 0; g < 7; ++g) { const int c = 256 * g + 4 * lane;
        const f32x4 m4 = *(const f32x4*)(mu + c);
        float x[4] = {bf_lo(cu[g].x), bf_hi(cu[g].x), bf_lo(cu[g].y), bf_hi(cu[g].y)}; const float pv[4] = {bf_lo(pu[g].x), bf_hi(pu[g].x), bf_lo(pu[g].y), bf_hi(pu[g].y)}, nv[4] = {bf_lo(nu[g].x), bf_hi(nu[g].x), bf_lo(nu[g].y), bf_hi(nu[g].y)};
#pragma unroll
        for (int j = 0; j < 4; ++j) x[j] = x[j] + m4[j] * (0.5f * (pv[j] + nv[j]) - x[j]);
        u32x2 w;
        if (g < 6) { w.x = pk2(x[0], x[1]); w.y = pk2(x[2], x[3]); bf16_t* dst = g < 2 ? rB : (g < 4 ? kB : vB); *(u32x2*)(dst + (size_t)row * 512 + (g & 1) * 256 + 4 * lane) = w; }
        else { const int cc = 4 * lane;
#pragma unroll
            for (int j = 0; j < 4; ++j) x[j] = cc < 64 ? tanhf(x[j]) : (cc < 128 ? x[j] : sigmoid_f(x[j]));
            w.x = pk2(x[0], x[1]); w.y = pk2(x[2], x[3]); *(u32x2*)(X + (size_t)row * 256 + cc) = w; }
    }
}
DI void rwkv_shift_phase(KParams& P, int tid) {
    const int wid = tid >> 6, lane = tid & 63;
    const bf16_t* pB = (const bf16_t*)(P.ws + A_PB); const float* mu = P.in[20];
    bf16_t* rB = (bf16_t*)(P.ws + A_R); bf16_t* kB = (bf16_t*)(P.ws + A_K); bf16_t* vB = (bf16_t*)(P.ws + A_V); bf16_t* X = (bf16_t*)(P.ws + A_X);
    for (int row = blockIdx.x * 8 + wid; row < M_; row += gridDim.x * 8) rwkv_shift_row(pB, mu, rB, kB, vB, X, row, lane);
}
DI float dpp_xor1(float v) { return __int_as_float(__builtin_amdgcn_mov_dpp(__float_as_int(v), 0xB1, 0xf, 0xf, true)); }
DI float dpp_xor2(float v) { return __int_as_float(__builtin_amdgcn_mov_dpp(__float_as_int(v), 0x4E, 0xf, 0xf, true)); }
DI float dpp_hmir(float v) { return __int_as_float(__builtin_amdgcn_mov_dpp(__float_as_int(v), 0x141, 0xf, 0xf, true)); }
DI float sum8(float v) { v += dpp_xor1(v); v += dpp_xor2(v); v += dpp_hmir(v); return v; }
DI float dpp_rmir(float v) { return __int_as_float(__builtin_amdgcn_mov_dpp(__float_as_int(v), 0x140, 0xf, 0xf, true)); }
DI float sum16(float v) { v += dpp_xor1(v); v += dpp_xor2(v); v += dpp_hmir(v); v += dpp_rmir(v); return v; }
DI void rwkv_scan_item(KParams& P, int item, LAS unsigned char* lds, int tid) {
    int b, h, dir, L, rowbase; bool lat;
    if (item < 128) { b = item >> 4; h = (item >> 1) & 7; dir = item & 1; L = 2048; rowbase = MP_ + b * 2048; lat = true; }
    else { const int it = item - 128; b = it >> 4; h = (it >> 1) & 7; dir = it & 1; L = 256; rowbase = b * 256; lat = false; }
    const bf16_t* rB = (const bf16_t*)(P.ws + A_R); const bf16_t* kB = (const bf16_t*)(P.ws + A_K); const bf16_t* vB = (const bf16_t*)(P.ws + A_V);
    const bf16_t* uB = (const bf16_t*)(P.ws + (dir ? A_U1 : A_U0)); const bf16_t* aB = (const bf16_t*)(P.ws + (dir ? A_A1 : A_A0)); bf16_t* y = (bf16_t*)(P.ws + A_Y) + (dir ? (size_t)M_ * 512 : 0);
    LAS float* buf = (LAS float*)lds;
    LAS float* ybuf = (LAS float*)(lds + 98304);
    const int i = tid >> 3, cg = tid & 7, tt_s = tid >> 4, jc = (tid & 15) * 4;
    LAS float* ydst = (cg == 0) ? (ybuf + i) : ((LAS float*)(lds + 114688) + tid);
    f32x2 S[4];
    if (lat) { const float* s0 = P.in[3] + ((size_t)((b * 2 + dir) * 8 + h) * 64 + i) * 64 + 8 * cg; const f32x4 a = *(const f32x4*)s0, c = *(const f32x4*)(s0 + 4);
        S[0] = (f32x2){a[0], a[1]}; S[1] = (f32x2){a[2], a[3]}; S[2] = (f32x2){c[0], c[1]}; S[3] = (f32x2){c[2], c[3]}; }
    else {
#pragma unroll
        for (int q = 0; q < 4; ++q) S[q] = (f32x2){0.f, 0.f}; }
    const f32x4 kk4 = *(const f32x4*)(P.in[26] + h * 64 + jc), ka4 = *(const f32x4*)(P.in[27] + h * 64 + jc);
    u32x2 gr, gk, gv, gu, ga;
    auto gload = [&](int ci) { const int pos = 32 * ci + tt_s; const int t = dir ? L - 1 - pos : pos; const size_t o = (size_t)(rowbase + t) * 512 + h * 64 + jc;
        gr = *(const u32x2*)(rB + o); gk = *(const u32x2*)(kB + o); gv = *(const u32x2*)(vB + o); gu = *(const u32x2*)(uB + o); ga = *(const u32x2*)(aB + o); };
    auto pstore = [&](int bi) { LAS float* bb = buf + bi * 12288 + tt_s * 64 + jc;
        const float k[4] = {bf_lo(gk.x), bf_hi(gk.x), bf_lo(gk.y), bf_hi(gk.y)}, a[4] = {bf_lo(ga.x), bf_hi(ga.x), bf_lo(ga.y), bf_hi(ga.y)}, u[4] = {bf_lo(gu.x), bf_hi(gu.x), bf_lo(gu.y), bf_hi(gu.y)};
        float kv[4]; float ss = 0.f;
#pragma unroll
        for (int j = 0; j < 4; ++j) { kv[j] = k[j] * kk4[j]; ss += kv[j] * kv[j]; }
        ss = sum16(ss);
        const float rn = 1.f / fmaxf(sqrtf(ss), 1e-12f);
        f32x4 w4, a4, b4, d4;
#pragma unroll
        for (int j = 0; j < 4; ++j) { const float kkn = kv[j] * rn; w4[j] = __expf(-u[j]); a4[j] = -kkn; b4[j] = kkn * a[j]; d4[j] = k[j] * (1.f + (a[j] - 1.f) * ka4[j]); }
        *(LAS f32x4*)(bb) = w4; *(LAS f32x4*)(bb + 2048) = a4; *(LAS f32x4*)(bb + 4096) = b4; *(LAS f32x4*)(bb + 6144) = d4;
        *(LAS f32x4*)(bb + 8192) = (f32x4){bf_lo(gr.x), bf_hi(gr.x), bf_lo(gr.y), bf_hi(gr.y)}; *(LAS f32x4*)(bb + 10240) = (f32x4){bf_lo(gv.x), bf_hi(gv.x), bf_lo(gv.y), bf_hi(gv.y)}; };
    const int nch = L >> 5;
    __syncthreads();
    gload(0); pstore(0);
    __syncthreads();
    for (int ci = 0; ci < nch; ++ci) {
        if (ci + 1 < nch) gload(ci + 1);
        const LAS float* bb = buf + (ci & 1) * 12288 + 8 * cg; const LAS float* bvv = buf + (ci & 1) * 12288 + 10240 + i;
        struct SV { f32x4 w0, w1, a0, a1, b0, b1, d0, d1, r0, r1; float vi; };
        auto ld = [&](int tt) { SV v; const LAS float* p = bb + tt * 64;
            v.w0 = *(const LAS f32x4*)(p); v.w1 = *(const LAS f32x4*)(p + 4); v.a0 = *(const LAS f32x4*)(p + 2048); v.a1 = *(const LAS f32x4*)(p + 2052);
            v.b0 = *(const LAS f32x4*)(p + 4096); v.b1 = *(const LAS f32x4*)(p + 4100); v.d0 = *(const LAS f32x4*)(p + 6144); v.d1 = *(const LAS f32x4*)(p + 6148);
            v.r0 = *(const LAS f32x4*)(p + 8192); v.r1 = *(const LAS f32x4*)(p + 8196); v.vi = bvv[tt * 64]; return v; };
        LAS float* ydc = ydst + ((cg == 0) ? (ci & 1) * 2048 : 0);
        SV cur = ld(0);
#pragma unroll 4
        for (int tt = 0; tt < 32; ++tt) {
            const SV nx = ld(tt < 31 ? tt + 1 : 31);
            const f32x2 A[4] = {{cur.a0[0], cur.a0[1]}, {cur.a0[2], cur.a0[3]}, {cur.a1[0], cur.a1[1]}, {cur.a1[2], cur.a1[3]}}, W[4] = {{cur.w0[0], cur.w0[1]}, {cur.w0[2], cur.w0[3]}, {cur.w1[0], cur.w1[1]}, {cur.w1[2], cur.w1[3]}};
            const f32x2 B[4] = {{cur.b0[0], cur.b0[1]}, {cur.b0[2], cur.b0[3]}, {cur.b1[0], cur.b1[1]}, {cur.b1[2], cur.b1[3]}}, D[4] = {{cur.d0[0], cur.d0[1]}, {cur.d0[2], cur.d0[3]}, {cur.d1[0], cur.d1[1]}, {cur.d1[2], cur.d1[3]}};
            const f32x2 R[4] = {{cur.r0[0], cur.r0[1]}, {cur.r0[2], cur.r0[3]}, {cur.r1[0], cur.r1[1]}, {cur.r1[2], cur.r1[3]}};
            const f32x2 t2 = (S[1] * A[1] + S[0] * A[0]) + (S[3] * A[3] + S[2] * A[2]);
            const float sa = sum8(t2[0] + t2[1]);
            const f32x2 sv = {sa, sa}, vv = {cur.vi, cur.vi};
#pragma unroll
            for (int q = 0; q < 4; ++q) { const f32x2 T = S[q] * W[q] + vv * D[q]; S[q] = sv * B[q] + T; }
            const f32x2 u2 = (S[1] * R[1] + S[0] * R[0]) + (S[3] * R[3] + S[2] * R[2]);
            const float yv = sum8(u2[0] + u2[1]);
            ydc[tt * 64] = yv;
            cur = nx; }
        if (ci + 1 < nch) pstore((ci + 1) & 1);
        __syncthreads();
        { const int pos = 32 * ci + tt_s; const int t = dir ? L - 1 - pos : pos; const f32x4 yv = *(const LAS f32x4*)(ybuf + (ci & 1) * 2048 + tt_s * 64 + jc);
            u32x2 w; w.x = pk2(yv[0], yv[1]); w.y = pk2(yv[2], yv[3]); *(u32x2*)(y + (size_t)(rowbase + t) * 512 + h * 64 + jc) = w; }
    }
    if (!lat) { float* op = P.out + OUT_RWKV + ((size_t)((b * 2 + dir) * 8 + h) * 64 + i) * 64 + 8 * cg; *(f32x4*)op = (f32x4){S[0][0], S[0][1], S[1][0], S[1][1]}; *(f32x4*)(op + 4) = (f32x4){S[2][0], S[2][1], S[3][0], S[3][1]}; }
}
DI void rwkv_scan_half_item(KParams& P, int item, LAS unsigned char* lds, int tid) {
    const int b = item >> 5, h = (item >> 2) & 7, dir = (item >> 1) & 1, half = item & 1; const int L = 2048, rowbase = MP_ + b * 2048, nch = 64;
    LAS float* buf = (LAS float*)lds;
    LAS float* ybuf = (LAS float*)(lds + 98304);
    __syncthreads();
    if (tid >= 256) {
        const int lt = tid - 256, jc = (lt & 15) * 4;
        const bf16_t* rB = (const bf16_t*)(P.ws + A_R); const bf16_t* kB = (const bf16_t*)(P.ws + A_K); const bf16_t* vB = (const bf16_t*)(P.ws + A_V);
        const bf16_t* uB = (const bf16_t*)(P.ws + (dir ? A_U1 : A_U0)); const bf16_t* aB = (const bf16_t*)(P.ws + (dir ? A_A1 : A_A0)); bf16_t* y = (bf16_t*)(P.ws + A_Y) + (dir ? (size_t)M_ * 512 : 0);
        const f32x4 kk4 = *(const f32x4*)(P.in[26] + h * 64 + jc), ka4 = *(const f32x4*)(P.in[27] + h * 64 + jc);
        auto stage = [&](int ci) {
            u32x2 gr[2], gk[2], gv[2], gu[2], ga[2];
#pragma unroll
            for (int g = 0; g < 2; ++g) { const int pos = 32 * ci + (lt >> 4) + 16 * g; const int t = dir ? L - 1 - pos : pos; const size_t o = (size_t)(rowbase + t) * 512 + h * 64 + jc;
                gr[g] = *(const u32x2*)(rB + o); gk[g] = *(const u32x2*)(kB + o); gv[g] = *(const u32x2*)(vB + o); gu[g] = *(const u32x2*)(uB + o); ga[g] = *(const u32x2*)(aB + o); }
#pragma unroll
            for (int g = 0; g < 2; ++g) { LAS float* bb = buf + (ci & 1) * 12288 + ((lt >> 4) + 16 * g) * 64 + jc;
                const float k[4] = {bf_lo(gk[g].x), bf_hi(gk[g].x), bf_lo(gk[g].y), bf_hi(gk[g].y)}, a[4] = {bf_lo(ga[g].x), bf_hi(ga[g].x), bf_lo(ga[g].y), bf_hi(ga[g].y)}, u[4] = {bf_lo(gu[g].x), bf_hi(gu[g].x), bf_lo(gu[g].y), bf_hi(gu[g].y)};
                float kv[4]; float ss = 0.f;
#pragma unroll
                for (int j = 0; j < 4; ++j) { kv[j] = k[j] * kk4[j]; ss += kv[j] * kv[j]; }
                ss = sum16(ss);
                const float rn = 1.f / fmaxf(sqrtf(ss), 1e-12f);
                f32x4 w4, a4, b4, d4;
#pragma unroll
                for (int j = 0; j < 4; ++j) { const float kkn = kv[j] * rn; w4[j] = __expf(-u[j]); a4[j] = -kkn; b4[j] = kkn * a[j]; d4[j] = k[j] * (1.f + (a[j] - 1.f) * ka4[j]); }
                *(LAS f32x4*)(bb) = w4; *(LAS f32x4*)(bb + 2048) = a4; *(LAS f32x4*)(bb + 4096) = b4; *(LAS f32x4*)(bb + 6144) = d4;
                *(LAS f32x4*)(bb + 8192) = (f32x4){bf_lo(gr[g].x), bf_hi(gr[g].x), bf_lo(gr[g].y), bf_hi(gr[g].y)}; *(LAS f32x4*)(bb + 10240) = (f32x4){bf_lo(gv[g].x), bf_hi(gv[g].x), bf_lo(gv[g].y), bf_hi(gv[g].y)}; } };
        auto flush = [&](int ci) { const int tok = lt >> 3, r4 = (lt & 7) * 4; const int pos = 32 * ci + tok; const int t = dir ? L - 1 - pos : pos;
            const f32x4 yv = *(const LAS f32x4*)(ybuf + (ci & 1) * 1024 + tok * 32 + r4); u32x2 w; w.x = pk2(yv[0], yv[1]); w.y = pk2(yv[2], yv[3]);
            *(u32x2*)(y + (size_t)(rowbase + t) * 512 + h * 64 + 32 * half + r4) = w; };
        stage(0);
        __syncthreads();
        for (int ci = 0; ci < nch; ++ci) {
            if (ci + 1 < nch) stage(ci + 1);
            if (ci >= 1) flush(ci - 1);
            __syncthreads();
        }
        flush(nch - 1);
    } else {
        const int il = tid >> 3, cg = tid & 7, i = 32 * half + il;
        f32x2 S[4];
        { const float* s0 = P.in[3] + ((size_t)((b * 2 + dir) * 8 + h) * 64 + i) * 64 + 8 * cg; const f32x4 a = *(const f32x4*)s0, c = *(const f32x4*)(s0 + 4);
          S[0] = (f32x2){a[0], a[1]}; S[1] = (f32x2){a[2], a[3]}; S[2] = (f32x2){c[0], c[1]}; S[3] = (f32x2){c[2], c[3]}; }
        LAS float* ydst = (cg == 0) ? (ybuf + il) : ((LAS float*)(lds + 106496) + tid);
        __syncthreads();
        for (int ci = 0; ci < nch; ++ci) {
            const LAS float* bb = buf + (ci & 1) * 12288 + 8 * cg; const LAS float* bvv = buf + (ci & 1) * 12288 + 10240 + i;
            LAS float* ydc = ydst + ((cg == 0) ? (ci & 1) * 1024 : 0);
            struct SV { f32x4 w0, w1, a0, a1, b0, b1, d0, d1, r0, r1; float vi; };
            auto ld = [&](int tt) { SV v; const LAS float* p = bb + tt * 64;
                v.w0 = *(const LAS f32x4*)(p); v.w1 = *(const LAS f32x4*)(p + 4); v.a0 = *(const LAS f32x4*)(p + 2048); v.a1 = *(const LAS f32x4*)(p + 2052);
                v.b0 = *(const LAS f32x4*)(p + 4096); v.b1 = *(const LAS f32x4*)(p + 4100); v.d0 = *(const LAS f32x4*)(p + 6144); v.d1 = *(const LAS f32x4*)(p + 6148);
                v.r0 = *(const LAS f32x4*)(p + 8192); v.r1 = *(const LAS f32x4*)(p + 8196); v.vi = bvv[tt * 64]; return v; };
            SV cur = ld(0);
#pragma unroll 4
            for (int tt = 0; tt < 32; ++tt) {
                const SV nx = ld(tt < 31 ? tt + 1 : 31);
                const f32x2 A[4] = {{cur.a0[0], cur.a0[1]}, {cur.a0[2], cur.a0[3]}, {cur.a1[0], cur.a1[1]}, {cur.a1[2], cur.a1[3]}}, W[4] = {{cur.w0[0], cur.w0[1]}, {cur.w0[2], cur.w0[3]}, {cur.w1[0], cur.w1[1]}, {cur.w1[2], cur.w1[3]}};
                const f32x2 B[4] = {{cur.b0[0], cur.b0[1]}, {cur.b0[2], cur.b0[3]}, {cur.b1[0], cur.b1[1]}, {cur.b1[2], cur.b1[3]}}, D[4] = {{cur.d0[0], cur.d0[1]}, {cur.d0[2], cur.d0[3]}, {cur.d1[0], cur.d1[1]}, {cur.d1[2], cur.d1[3]}};
                const f32x2 R[4] = {{cur.r0[0], cur.r0[1]}, {cur.r0[2], cur.r0[3]}, {cur.r1[0], cur.r1[1]}, {cur.r1[2], cur.r1[3]}};
                const f32x2 t2 = (S[1] * A[1] + S[0] * A[0]) + (S[3] * A[3] + S[2] * A[2]);
                const float sa = sum8(t2[0] + t2[1]);
                const f32x2 sv = {sa, sa}, vv = {cur.vi, cur.vi};
#pragma unroll
                for (int q = 0; q < 4; ++q) { const f32x2 T = S[q] * W[q] + vv * D[q]; S[q] = sv * B[q] + T; }
                const f32x2 u2 = (S[1] * R[1] + S[0] * R[0]) + (S[3] * R[3] + S[2] * R[2]);
                const float yv = sum8(u2[0] + u2[1]);
                ydc[tt * 32] = yv;
                cur = nx; }
            __syncthreads();
        }
    }
}
DI void rwkv_post_phase(KParams& P, int tid) {
    const int wid = tid >> 6, lane = tid & 63;
    const bf16_t* rB = (const bf16_t*)(P.ws + A_R); const bf16_t* kB = (const bf16_t*)(P.ws + A_K); const bf16_t* vB = (const bf16_t*)(P.ws + A_V); const bf16_t* gB = (const bf16_t*)(P.ws + A_G);
    const bf16_t* yA = (const bf16_t*)(P.ws + A_Y); const bf16_t* yBk = yA + (size_t)M_ * 512; bf16_t* mix = (bf16_t*)(P.ws + WS_H);
    const int c = 8 * lane;
    f32x4 lw[2], lb[2], rk[2];
#pragma unroll
    for (int q = 0; q < 2; ++q) { lw[q] = *(const f32x4*)(P.in[29] + c + 4 * q); lb[q] = *(const f32x4*)(P.in[30] + c + 4 * q); rk[q] = *(const f32x4*)(P.in[28] + c + 4 * q); }
    for (int row = blockIdx.x * 8 + wid; row < M_; row += gridDim.x * 8) { const size_t o = (size_t)row * 512 + c;
        const u32x4 ya = *(const u32x4*)(yA + o), yb = *(const u32x4*)(yBk + o);
        const u32x4 ru = *(const u32x4*)(rB + o), ku = *(const u32x4*)(kB + o), vu = *(const u32x4*)(vB + o), gu = *(const u32x4*)(gB + o);
        float yy[8]; float r[8], k[8], v[8], g[8];
#pragma unroll
        for (int q = 0; q < 4; ++q) { yy[2 * q] = bf_lo(ya[q]) + bf_lo(yb[q]); yy[2 * q + 1] = bf_hi(ya[q]) + bf_hi(yb[q]); }
#pragma unroll
        for (int q = 0; q < 4; ++q) { r[2 * q] = bf_lo(ru[q]); r[2 * q + 1] = bf_hi(ru[q]); k[2 * q] = bf_lo(ku[q]); k[2 * q + 1] = bf_hi(ku[q]); v[2 * q] = bf_lo(vu[q]); v[2 * q + 1] = bf_hi(vu[q]); g[2 * q] = bf_lo(gu[q]); g[2 * q + 1] = bf_hi(gu[q]); }
        float s = 0.f, bs = 0.f;
#pragma unroll
        for (int q = 0; q < 8; ++q) { s += yy[q]; bs += r[q] * k[q] * rk[q >> 2][q & 3]; }
        s = sum8(s); bs = sum8(bs); const float mu = s * (1.f / 64.f); float vs = 0.f;
#pragma unroll
        for (int q = 0; q < 8; ++q) { const float d = yy[q] - mu; vs += d * d; }
        vs = sum8(vs); const float rs = rsqrtf(vs * (1.f / 64.f) + 64e-5f);
        float o8[8];
#pragma unroll
        for (int q = 0; q < 8; ++q) o8[q] = ((yy[q] - mu) * rs * lw[q >> 2][q & 3] + lb[q >> 2][q & 3] + bs * v[q]) * g[q];
        u32x4 w; w.x = pk2(o8[0], o8[1]); w.y = pk2(o8[2], o8[3]); w.z = pk2(o8[4], o8[5]); w.w = pk2(o8[6], o8[7]);
        *(u32x4*)(mix + (size_t)row * D_ + 512 + c) = w; }
}
#define XB_TMO      128
#define XB_XCNT(j)  (256  + 64 * (j))
#define XB_XSUB(j)  (1280 + 64 * (j))
#define XB_XGEN(j)  (2304 + 64 * (j))
#define XB_TOP      3328
#define XB_TOPGEN   3392
#define XCD_BAR_WORDS 3456
#define XB_SPIN_CAP (1u << 18)

__device__ __forceinline__ unsigned xb_ld(unsigned* p)              { return __hip_atomic_load(p, __ATOMIC_RELAXED, __HIP_MEMORY_SCOPE_AGENT); }
__device__ __forceinline__ unsigned xb_add(unsigned* p, unsigned v) { return __hip_atomic_fetch_add(p, v, __ATOMIC_RELAXED, __HIP_MEMORY_SCOPE_AGENT); }
__device__ __forceinline__ unsigned xb_xcc_id() { return (unsigned)__builtin_amdgcn_s_getreg((3 << 11) | 20) & 0xFu; }
#define XB_SPIN(cond, bar) do { unsigned _sp = 0; while (cond) { __builtin_amdgcn_s_sleep(1); \
    if ((++_sp & 255u) == 0u) { if (xb_ld(&(bar)[XB_TMO])) break; if (_sp > XB_SPIN_CAP) { atomicAdd(&(bar)[XB_TMO], 1u); break; } } } } while (0)

struct XcdBarrier {
    unsigned* bar; unsigned x;
    volatile LAS unsigned* st;
};

__device__ __forceinline__ XcdBarrier xcd_barrier_post(unsigned* bar, volatile LAS unsigned* st) {
    XcdBarrier b; b.bar = bar; b.x = xb_xcc_id(); b.st = st;
    if (threadIdx.x == 0) (void)xb_add(&bar[XB_XCNT(b.x)], 1u);
    return b;
}
__device__ __forceinline__ void xcd_barrier_complete(unsigned* bar, unsigned x, unsigned& nloc, unsigned& nx) {
    const unsigned G = gridDim.x * gridDim.y * gridDim.z;
    unsigned sum, cnt, mine, sp = 0u;
    for (;;) {
        sum = 0u; cnt = 0u; mine = 0u;
#pragma unroll
        for (unsigned j = 0; j < 16; ++j) { const unsigned c = xb_ld(&bar[XB_XCNT(j)]); sum += c; cnt += (c > 0u) ? 1u : 0u; mine = (j == x) ? c : mine; }
        if (sum == G) break;
        __builtin_amdgcn_s_sleep(1);
        if ((++sp & 255u) == 0u) { if (xb_ld(&bar[XB_TMO])) break; if (sp > XB_SPIN_CAP) { atomicAdd(&bar[XB_TMO], 1u); break; } }
    }
    nloc = mine > 0u ? mine : 1u; nx = cnt > 0u ? cnt : 1u;
}

__device__ __forceinline__ void xcd_barrier(const XcdBarrier& b) {
    asm volatile("s_waitcnt vmcnt(0)" ::: "memory");
    __syncthreads();
    if (threadIdx.x == 0) {
        unsigned* bar = b.bar;
        __builtin_amdgcn_s_waitcnt(0);
        unsigned nloc = b.st[0], nx = b.st[1];
        if (nloc == 0u) { xcd_barrier_complete(bar, b.x, nloc, nx); b.st[0] = nloc; b.st[1] = nx; }
        const unsigned old = xb_add(&bar[XB_XSUB(b.x)], 1u);
        const unsigned gen = old / nloc;
        if (old + 1u == (gen + 1u) * nloc) {
            __builtin_amdgcn_fence(__ATOMIC_RELEASE, "agent");
            asm volatile("s_waitcnt vmcnt(0)" ::: "memory");
            const unsigned og = xb_add(&bar[XB_TOP], 1u);
            const unsigned tg = og / nx;
            if (og + 1u == (tg + 1u) * nx) xb_add(&bar[XB_TOPGEN], 1u);
            else XB_SPIN(xb_ld(&bar[XB_TOPGEN]) == tg, bar);
            __builtin_amdgcn_fence(__ATOMIC_ACQUIRE, "agent");
            xb_add(&bar[XB_XGEN(b.x)], 1u);
            asm volatile("s_waitcnt vmcnt(0)" ::: "memory");
        } else {
            XB_SPIN(xb_ld(&bar[XB_XGEN(b.x)]) == gen, bar);
            __builtin_amdgcn_fence(__ATOMIC_ACQUIRE, "agent");
            asm volatile("s_waitcnt vmcnt(0)" ::: "memory");
        }
    }
    __syncthreads();
}


DI int next_item(unsigned* c, LAS int* slot, int tid) { __syncthreads(); if (tid == 0) *slot = (int)atomicAdd(c, 1u); __syncthreads(); return *slot; }

template <class Epi> DI void run_gemm(LAS unsigned char* lds, const bf16_t* A, const bf16_t* Bt, int N, int K, const Epi& E) {
    N = launder_s(N); K = launder_s(K);
    pg8::StaticOrder S; S.init(M_, N, (int)gridDim.x, (int)blockIdx.x);
    pg8::gemm_phase<Epi, pg8::StaticOrder>(lds, pg8::Gemm{A, Bt, M_, N, K}, S, E);
    __syncthreads();
}

__global__ void __launch_bounds__(512) fwd_kernel(Params Pk) {
#define P (kparams())
    extern __shared__ __attribute__((aligned(16))) unsigned char smem[];
    LAS unsigned char* lds = (LAS unsigned char*)smem;
    LAS int* slot = (LAS int*)(lds + MISC_OFF + 8064);
#define ws (P.ws)
#define tid (launder_v((int)threadIdx.x))
#define ctr ((unsigned*)(ws + WS_CTR))
#define rope ((float*)(ws + WS_ROPE))
#define mod ((float*)(ws + WS_MOD))
#define XRES (P.out)
#define hb ((bf16_t*)(ws + WS_H))
#define act ((bf16_t*)(ws + A_ACT))
    if (blockIdx.x == 0) { if (threadIdx.x < 16) ctr[threadIdx.x] = 0u; unsigned* bz = (unsigned*)(ws + WS_BAR); for (int i = threadIdx.x; i < XCD_BAR_WORDS; i += 512) bz[i] = 0u; }
    if (blockIdx.x == gridDim.x - 1) for (int e = tid; e < 1024; e += 512) { const int pos = e >> 4, i = e & 15; const float inv = powf(10000.f, -(float)i / 16.f); const float ang = (float)pos * inv; rope[2 * e] = cosf(ang); rope[2 * e + 1] = sinf(ang); }
    { bf16_t* ck = (bf16_t*)(ws + WS_CK); bf16_t* cv = (bf16_t*)(ws + WS_CV); const float* sk = P.in[7]; const float* sv = P.in[8];
      for (int i = blockIdx.x * 512 + threadIdx.x; i < 131072; i += gridDim.x * 512) { const f32x4 a = *(const f32x4*)(sk + 4 * (size_t)i), c = *(const f32x4*)(sv + 4 * (size_t)i); u32x2 w; w.x = pk2(a[0], a[1]); w.y = pk2(a[2], a[3]); *(u32x2*)(ck + 4 * (size_t)i) = w; w.x = pk2(c[0], c[1]); w.y = pk2(c[2], c[3]); *(u32x2*)(cv + 4 * (size_t)i) = w; } }
    mod_phase(P, lds, tid);
    convert_layer(P, 0, lds, tid, 63);
    cg::this_grid().sync();
    { volatile LAS unsigned* st_ = (volatile LAS unsigned*)(lds + MISC_OFF + 8072); if (threadIdx.x < 2) st_[threadIdx.x] = 0u; __syncthreads(); (void)xcd_barrier_post((unsigned*)(ws + WS_BAR), st_); }
#define GBAR() do { XcdBarrier b_; b_.bar = (unsigned*)(ws + WS_BAR); b_.x = xb_xcc_id(); b_.st = (volatile LAS unsigned*)(lds + MISC_OFF + 8072); xcd_barrier(b_); } while (0)
    { constexpr int l = 0;
#define modl (mod + (size_t)launder_s(l) * 9 * 9216)
#define ng (P.in[13] + (size_t)launder_s(l) * 3 * 1024)
        if (l == 1) convert_layer(P, 1, lds, tid, 42);
        norm_phase(l == 0 ? P.in[0] : XRES, l == 0 ? P.in[1] : XRES + (size_t)MP_ * D_, hb, ng, modl, 0, tid);
        GBAR();
        run_gemm(lds, hb, (const bf16_t*)(ws + W_W1A), 2 * DFF_, D_, EpiSwiglu{act});
        GBAR();
        run_gemm(lds, act, (const bf16_t*)(ws + W_W2A), D_, DFF_, EpiResid{l == 0 ? P.in[0] : XRES, l == 0 ? P.in[1] : XRES + (size_t)MP_ * D_, XRES, modl + 2 * 1024, 0.5f});
        GBAR();
        norm_phase(XRES, XRES + (size_t)MP_ * D_, hb, ng + 1024, modl, 3, tid);
        GBAR();
        if (l == 0) {
            run_gemm(lds, hb, (const bf16_t*)(ws + W_WIN), 3328, D_, EpiInEven{ws, rope});
            GBAR();
            for (;;) { const int it = next_item(ctr + 0, slot, tid); if (it >= 640) break;
                if (it < 256) ret_item(P, it + 128, lds, tid); else if (it < 512) ret_state_item(P, it - 256, lds, tid); else ret_item(P, it - 512, lds, tid); }
            rwkv_shift_phase(P, tid);
            GBAR();
            run_gemm(lds, (const bf16_t*)(ws + A_X), (const bf16_t*)(ws + W_WL), 2560, 256,
                     EpiLora{ws, P.in[21], P.in[23]});
            GBAR();
            for (;;) { const int it = next_item(ctr + 1, slot, tid); if (it >= 768 + 2880) break; if (it < 256) rwkv_scan_half_item(P, it, lds, tid); else if (it < 768) rwkv_scan_item(P, it - 128, lds, tid); else conv_l1_early_item(P, it - 768, lds, tid); }
            GBAR();
            rwkv_post_phase(P, tid);
            GBAR();
        } else {
            run_gemm(lds, hb, (const bf16_t*)(ws + W_WIN), 3072, D_, EpiInOdd{ws, rope, P.in[36], P.in[33], P.in[34], P.out});
            GBAR();
            for (;;) { const int it = next_item(ctr + 2, slot, tid); if (it >= 1792) break;
                if (it < 512) attn_item(P, it, lds, tid); else if (it < 1024) mlstm_item(P, it - 256, lds, tid); else if (it < 1280) mlstm_state_item(P, it - 1024, lds, tid);
                else if (it < 1536) mlstm_item(P, it - 1280, lds, tid); else attn_item(P, 512 + it - 1536, lds, tid); }
            GBAR();
        }
        run_gemm(lds, hb, (const bf16_t*)(ws + W_WOUT), D_, D_, EpiResid{XRES, XRES + (size_t)MP_ * D_, XRES, modl + 5 * 1024, 1.0f});
        GBAR();
        norm_phase(XRES, XRES + (size_t)MP_ * D_, hb, ng + 2048, modl, 6, tid);
        GBAR();
        run_gemm(lds, hb, (const bf16_t*)(ws + W_W1B), 2 * DFF_, D_, EpiSwiglu{act});
        GBAR();
        run_gemm(lds, act, (const bf16_t*)(ws + W_W2B), D_, DFF_, EpiResid{XRES, XRES + (size_t)MP_ * D_, XRES, modl + 8 * 1024, 0.5f});
        GBAR();
    }
    { constexpr int l = 1;
#define modl (mod + (size_t)launder_s(l) * 9 * 9216)
#define ng (P.in[13] + (size_t)launder_s(l) * 3 * 1024)
        if (l == 1) convert_layer(P, 1, lds, tid, 42);
        norm_phase(l == 0 ? P.in[0] : XRES, l == 0 ? P.in[1] : XRES + (size_t)MP_ * D_, hb, ng, modl, 0, tid);
        GBAR();
        run_gemm(lds, hb, (const bf16_t*)(ws + W_W1A), 2 * DFF_, D_, EpiSwiglu{act});
        GBAR();
        run_gemm(lds, act, (const bf16_t*)(ws + W_W2A), D_, DFF_, EpiResid{l == 0 ? P.in[0] : XRES, l == 0 ? P.in[1] : XRES + (size_t)MP_ * D_, XRES, modl + 2 * 1024, 0.5f});
        GBAR();
        norm_phase(XRES, XRES + (size_t)MP_ * D_, hb, ng + 1024, modl, 3, tid);
        GBAR();
        if (l == 0) {
            run_gemm(lds, hb, (const bf16_t*)(ws + W_WIN), 3328, D_, EpiInEven{ws, rope});
            GBAR();
            for (;;) { const int it = next_item(ctr + 0, slot, tid); if (it >= 640) break;
                if (it < 256) ret_item(P, it + 128, lds, tid); else if (it < 512) ret_state_item(P, it - 256, lds, tid); else ret_item(P, it - 512, lds, tid); }
            rwkv_shift_phase(P, tid);
            GBAR();
            run_gemm(lds, (const bf16_t*)(ws + A_X), (const bf16_t*)(ws + W_WL), 2560, 256,
                     EpiLora{ws, P.in[21], P.in[23]});
            GBAR();
            for (;;) { const int it = next_item(ctr + 1, slot, tid); if (it >= 768 + 2880) break; if (it < 256) rwkv_scan_half_item(P, it, lds, tid); else if (it < 768) rwkv_scan_item(P, it - 128, lds, tid); else conv_l1_early_item(P, it - 768, lds, tid); }
            GBAR();
            rwkv_post_phase(P, tid);
            GBAR();
        } else {
            run_gemm(lds, hb, (const bf16_t*)(ws + W_WIN), 3072, D_, EpiInOdd{ws, rope, P.in[36], P.in[33], P.in[34], P.out});
            GBAR();
            for (;;) { const int it = next_item(ctr + 2, slot, tid); if (it >= 1792) break;
                if (it < 512) attn_item(P, it, lds, tid); else if (it < 1024) mlstm_item(P, it - 256, lds, tid); else if (it < 1280) mlstm_state_item(P, it - 1024, lds, tid);
                else if (it < 1536) mlstm_item(P, it - 1280, lds, tid); else attn_item(P, 512 + it - 1536, lds, tid); }
            GBAR();
        }
        run_gemm(lds, hb, (const bf16_t*)(ws + W_WOUT), D_, D_, EpiResid{XRES, XRES + (size_t)MP_ * D_, XRES, modl + 5 * 1024, 1.0f});
        GBAR();
        norm_phase(XRES, XRES + (size_t)MP_ * D_, hb, ng + 2048, modl, 6, tid);
        GBAR();
        run_gemm(lds, hb, (const bf16_t*)(ws + W_W1B), 2 * DFF_, D_, EpiSwiglu{act});
        GBAR();
        run_gemm(lds, act, (const bf16_t*)(ws + W_W2B), D_, DFF_, EpiResid{XRES, XRES + (size_t)MP_ * D_, XRES, modl + 8 * 1024, 0.5f});
        GBAR();
    }
    final_norm_phase(XRES, P.in[37], tid);
#undef tid
#undef GBAR
#undef modl
#undef ng
#undef ctr
#undef rope
#undef mod
#undef XRES
#undef hb
#undef act
#undef ws
#undef P
}

extern "C" void kernel_launch(void* const* d_in, const int* in_sizes, int n_in, void* d_out, int out_size, void* d_ws, size_t ws_size, hipStream_t stream) {
    static int grid_blocks = 0;
    if (grid_blocks == 0) {
        if (n_in != 38 || ws_size < WS_NEED) { fprintf(stderr, "kernel_launch: need 38 inputs and %zu bytes of workspace, got %d / %zu\n", (size_t)WS_NEED, n_in, ws_size); grid_blocks = -1; return; }
        int dev = 0, cus = 0, per_cu = 0;
        hipGetDevice(&dev); hipDeviceGetAttribute(&cus, hipDeviceAttributeMultiprocessorCount, dev);
        if (hipFuncSetAttribute((const void*)fwd_kernel, hipFuncAttributeMaxDynamicSharedMemorySize, LDS_BYTES) != hipSuccess) { fprintf(stderr, "kernel_launch: hipFuncSetAttribute failed\n"); grid_blocks = -1; return; }
        if (hipOccupancyMaxActiveBlocksPerMultiprocessor(&per_cu, (const void*)fwd_kernel, 512, LDS_BYTES) != hipSuccess || per_cu < 1) { fprintf(stderr, "kernel_launch: occupancy query failed (%d)\n", per_cu); grid_blocks = -1; return; }
        grid_blocks = cus * per_cu;
    }
    if (grid_blocks < 0) return;
    Params p{};
    for (int i = 0; i < 38; ++i) p.in[i] = (const float*)d_in[i];
    p.out = (float*)d_out; p.ws = (unsigned char*)d_ws;
    void* args[] = {&p};
    hipError_t e = hipLaunchCooperativeKernel((const void*)fwd_kernel, dim3(grid_blocks), dim3(512), args, LDS_BYTES, stream);
    if (e != hipSuccess) fprintf(stderr, "cooperative launch failed: %s (grid %d)\n", hipGetErrorString(e), grid_blocks);
}
```

```cpp
#include <hip/hip_runtime.h>
#include <hip/hip_cooperative_groups.h>
#include <cstdio>
namespace cg = cooperative_groups;

#define DI __device__ __forceinline__
#define LAS __attribute__((address_space(3)))
typedef unsigned short bf16_t;
typedef short s16x4 __attribute__((ext_vector_type(4)));
typedef float f32x2 __attribute__((ext_vector_type(2)));
typedef unsigned u32x2 __attribute__((ext_vector_type(2)));
typedef __bf16 bf2_t __attribute__((ext_vector_type(2)));

constexpr int M_ = 24576, MP_ = 8192, D_ = 1024, DFF_ = 2816;
constexpr int LDS_BYTES = 139264;
constexpr int MISC_OFF = 131072;

DI unsigned pk2(float a, float b) { f32x2 v = {a, b}; bf2_t r = __builtin_convertvector(v, bf2_t); return __builtin_bit_cast(unsigned, r); }
DI float bf_lo(unsigned u) { return __uint_as_float(u << 16); }
DI float bf_hi(unsigned u) { return __uint_as_float(u & 0xffff0000u); }
DI float bf2f(bf16_t h) { return __uint_as_float(((unsigned)h) << 16); }
DI float silu_f(float x) { return x * __builtin_amdgcn_rcpf(1.f + __expf(-x)); }
DI float sigmoid_f(float x) { return __builtin_amdgcn_rcpf(1.f + __expf(-x)); }
DI float softplus_f(float z) { return fmaxf(z, 0.f) + __logf(1.f + __expf(-fabsf(z))); }
DI float wave_sum(float v) { v += __shfl_xor(v, 32); v += __shfl_xor(v, 16); v += __shfl_xor(v, 8); v += __shfl_xor(v, 4); v += __shfl_xor(v, 2); v += __shfl_xor(v, 1); return v; }
DI float fq_sum(float v) { unsigned u = __float_as_uint(v); const auto a = __builtin_amdgcn_permlane16_swap(u, u, false, false); v = __uint_as_float(a[0]) + __uint_as_float(a[1]);
    u = __float_as_uint(v); const auto b = __builtin_amdgcn_permlane32_swap(u, u, false, false); return __uint_as_float(b[0]) + __uint_as_float(b[1]); }
DI float fq_max(float v) { unsigned u = __float_as_uint(v); const auto a = __builtin_amdgcn_permlane16_swap(u, u, false, false); v = fmaxf(__uint_as_float(a[0]), __uint_as_float(a[1]));
    u = __float_as_uint(v); const auto b = __builtin_amdgcn_permlane32_swap(u, u, false, false); return fmaxf(__uint_as_float(b[0]), __uint_as_float(b[1])); }
DI int cond_of_row(int row) { return row < MP_ ? 0 : 1 + ((row - MP_) >> 11); }
DI int seqpos_of_row(int row) { return row < MP_ ? (row & 255) : ((row - MP_) & 2047); }

DI int launder_v(int v) { asm volatile("" : "+v"(v)); return v; }
DI int launder_s(int v) { asm volatile("" : "+s"(v)); return v; }
struct Params { const float* in[38]; float* out; unsigned char* ws; };

typedef __attribute__((address_space(4))) const Params KParams;
DI KParams& kparams() { KParams* p = (KParams*)__builtin_amdgcn_kernarg_segment_ptr(); asm volatile("" : "+s"(p)); return *p; }
constexpr size_t WS_CTR = 0, WS_ROPE = 256, WS_MOD = 16384, WS_BAR = 786432, WS_W = 1048576;
constexpr size_t W_W1A = WS_W, W_W1B = W_W1A + 11534336, W_W2A = W_W1B + 11534336, W_W2B = W_W2A + 5767168, W_WIN = W_W2B + 5767168,
                 W_WOUT = W_WIN + 6815744, W_WL = W_WOUT + 2097152, WS_H = W_WL + 1310720, WS_AR = WS_H + 50331648;
constexpr size_t SZ512 = (size_t)M_ * 512 * 2;
constexpr size_t A_R = WS_AR, A_K = A_R + SZ512, A_V = A_K + SZ512, A_X = A_V + SZ512, A_Z = A_X + (size_t)M_ * 256 * 2;
constexpr size_t A_QA = A_Z, A_KA = A_QA + (size_t)M_ * 256 * 2, A_VA = A_KA + (size_t)M_ * 256 * 2, A_GA = A_VA + SZ512, A_PB = A_GA + SZ512;
constexpr size_t A_U0 = A_Z, A_U1 = A_U0 + SZ512, A_A0 = A_U1 + SZ512, A_A1 = A_A0 + SZ512, A_G = A_A1 + SZ512, A_Y = A_G + SZ512, A_END = A_Y + 2 * SZ512;
constexpr size_t O_QC = WS_AR, O_KC = O_QC + SZ512, O_VC = O_KC + SZ512, O_OC = O_VC + SZ512, O_QD = O_OC + SZ512,
                 O_KD = O_QD + SZ512, O_VD = O_KD + (size_t)M_ * 128 * 2, O_GT = O_VD + (size_t)M_ * 128 * 2;
constexpr size_t A_ACT = WS_AR;
constexpr size_t WS_CK = A_END, WS_CV = WS_CK + 1048576, WS_NEED = WS_CV + 1048576;
constexpr size_t OUT_RET = 25165824, OUT_RWKV = 27262976, OUT_MC = 29360128, OUT_MN = 33554432, OUT_MM = 33587200, OUT_CK = 33587456, OUT_CV = 34636032;
typedef short bf16x8 __attribute__((ext_vector_type(8)));
typedef float f32x4 __attribute__((ext_vector_type(4)));
typedef unsigned u32x4 __attribute__((ext_vector_type(4)));
namespace pg8 {
#define PG8_LAS __attribute__((address_space(3)))
typedef unsigned short bf16_t;
typedef short bf16x8 __attribute__((ext_vector_type(8)));
typedef float f32x4 __attribute__((ext_vector_type(4)));
typedef unsigned u32x4 __attribute__((ext_vector_type(4)));
constexpr int BM = 256, BK = 64, HALF = 128, HTB = HALF * BK * 2  , STAGE_BYTES = 8 * HTB, NXCD = 8, WGM = 8;

__host__ __device__ __forceinline__ int lds_byte(int r, int c) { const int st = (r >> 4) * 2 + (c >> 5), rr = r & 15, cc = c & 31, ob = rr * 64 + cc * 2; return st * 1024 + (ob ^ (((ob >> 9) & 1) << 5)); }
__host__ __device__ __forceinline__ void stage_rc(int b, int& R, int& C) { const int st = b / 1024, sb = b % 1024, swz = sb ^ (((sb >> 9) & 1) << 5); R = (st >> 1) * 16 + swz / 64; C = (st & 1) * 32 + (swz % 64) / 2; }
__host__ __device__ __forceinline__ int perm32(int rho) { const int n = rho >> 4, i = rho & 15; return 8 * (i >> 2) + 4 * n + (i & 3); }

struct Unit { int pm, pn; };
struct Gemm { const bf16_t* A; const bf16_t* Bt; int M, N, K; };

struct StaticOrder {
    int nM, nN, nwg, G, c;
    __host__ __device__ void init(int M, int N, int G_, int c_) { nM = M / BM; nN = N / BM; nwg = nM * nN; G = G_; c = c_; }
    __host__ __device__ bool next(int i, Unit& u) const {
        const long L = (long)i * G + c; if (L >= nwg) return false;
        int wgid = (int)L; { const int q = nwg / NXCD, r = nwg % NXCD, xcd = wgid % NXCD, off = wgid / NXCD; wgid = (xcd < r ? xcd * (q + 1) : r * (q + 1) + (xcd - r) * q) + off; }
        const int nig = WGM * nN, gid = wgid / nig, fm = gid * WGM, gsz = (nM - fm) < WGM ? (nM - fm) : WGM;
        u.pm = fm + ((wgid % nig) % gsz); u.pn = (wgid % nig) / gsz; return true;
    }
    __device__ __forceinline__ void a_ready(const Unit&) const {}
    __device__ __forceinline__ void done(const Unit&) const {}
};
template <int NN> struct FastOrder {
    int G, c;
    __device__ __forceinline__ void init(int, int, int G_, int c_) { G = G_; c = c_; }
    __device__ __forceinline__ bool next(int i, Unit& u) const {
        constexpr int nwg = 96 * NN, q = nwg / NXCD, r = nwg % NXCD, nig = WGM * NN;
        const int L = i * G + c; if (L >= nwg) return false;
        const int xcd = L & 7, off = L >> 3; const int wgid = (xcd < r ? xcd * (q + 1) : r * (q + 1) + (xcd - r) * q) + off;
        const int gid = wgid / nig, rem = wgid - gid * nig;
        u.pm = gid * WGM + (rem & 7); u.pn = rem >> 3; return true;
    }
    __device__ __forceinline__ void a_ready(const Unit&) const {}
    __device__ __forceinline__ void done(const Unit&) const {}
};
template <class Epi, class Sched>
__device__ __forceinline__ void gemm_phase(PG8_LAS unsigned char* lds, const Gemm g, const Sched& S, const Epi& E) {
    const int tid = launder_v((int)threadIdx.x), wid = __builtin_amdgcn_readfirstlane(tid >> 6), lane = tid & 63, wr = wid >> 2, wc = wid & 3, fr = lane & 15, fq = lane >> 4;
    const int K = g.K, nt = K / BK;
    unsigned voffA[2], voffB[2];
#pragma unroll
    for (int i = 0; i < 2; ++i) { int R, C; stage_rc(tid * 16 + i * 8192, R, C); const int Rb = Epi::PERM ? ((R & ~31) + perm32(R & 31)) : R;
        voffA[i] = (unsigned)(R * K + C) * 2u; voffB[i] = (unsigned)(Rb * K + C) * 2u; }
    const size_t kstep = (size_t)(BK * 2);
    const size_t hstep = (size_t)HALF * K * 2;
    const size_t tstep = 2 * hstep;
    const unsigned ldsw = (unsigned)wid * 1024u;
    const int aoff = lds_byte(wr * 64 + fr, fq * 8), boff = lds_byte(wc * 32 + fr, fq * 8);
#define PG8_SA(b, h) (((b) * 2 + (h)) * HTB)
#define PG8_SB(b, h) ((4 + (b) * 2 + (h)) * HTB)
#define PG8_STAGE(bufoff, gbase, voff) do { _Pragma("unroll") for (int _i = 0; _i < 2; ++_i) \
        __builtin_amdgcn_global_load_lds((const unsigned*)((const char*)(gbase) + (voff)[_i]), (PG8_LAS unsigned*)(lds + (bufoff) + ldsw + _i * 8192), 16, 0, 0); } while (0)
#define PG8_LDA(dst, b, h) do { _Pragma("unroll") for (int m = 0; m < 4; ++m) _Pragma("unroll") for (int k = 0; k < 2; ++k) dst[m][k] = *(const PG8_LAS bf16x8*)(lds + PG8_SA(b, h) + aoff + m * 2048 + k * 1024); } while (0)
#define PG8_LDB(dst, b, h) do { _Pragma("unroll") for (int n = 0; n < 2; ++n) _Pragma("unroll") for (int k = 0; k < 2; ++k) dst[n][k] = *(const PG8_LAS bf16x8*)(lds + PG8_SB(b, h) + boff + n * 2048 + k * 1024); } while (0)
#define PG8_MMA(ai, bj, At, Bt) do { __builtin_amdgcn_s_setprio(1); _Pragma("unroll") for (int m = 0; m < 4; ++m) _Pragma("unroll") for (int n = 0; n < 2; ++n) _Pragma("unroll") for (int k = 0; k < 2; ++k) \
        acc[ai][bj][m][n] = __builtin_amdgcn_mfma_f32_16x16x32_bf16(Bt[n][k], At[m][k], acc[ai][bj][m][n], 0, 0, 0); __builtin_amdgcn_s_setprio(0); } while (0)
#define PG8_WAIT_V(n) asm volatile("s_waitcnt vmcnt(" #n ")" ::: "memory")
#define PG8_WAIT_L(n) asm volatile("s_waitcnt lgkmcnt(" #n ")" ::: "memory")
#define PG8_BAR __builtin_amdgcn_s_barrier()
#define PG8_SCHED __builtin_amdgcn_sched_barrier(0)
    Unit cur, nxt; int ui = 0;
    if (!S.next(0, cur)) return;
    f32x4 acc[2][2][4][2];
#pragma unroll
    for (int a = 0; a < 2; ++a)
#pragma unroll
        for (int b = 0; b < 2; ++b)
#pragma unroll
            for (int m = 0; m < 4; ++m)
#pragma unroll
                for (int n = 0; n < 2; ++n) acc[a][b][m][n] = (f32x4){0.f, 0.f, 0.f, 0.f};
    bf16x8 At[4][2], B0[2][2], B1[2][2];
    const char* cA = (const char*)g.A + (size_t)cur.pm * tstep; const char* cB = (const char*)g.Bt + (size_t)cur.pn * tstep;
    S.a_ready(cur);
    PG8_STAGE(PG8_SB(0, 0), cB, voffB); PG8_STAGE(PG8_SA(0, 0), cA, voffA); PG8_STAGE(PG8_SB(0, 1), cB + hstep, voffB); PG8_STAGE(PG8_SA(0, 1), cA + hstep, voffA);
    if (wr == 1) PG8_BAR;
    PG8_WAIT_V(4); PG8_BAR;
    PG8_STAGE(PG8_SB(1, 0), cB + kstep, voffB); PG8_STAGE(PG8_SA(1, 0), cA + kstep, voffA); PG8_STAGE(PG8_SB(1, 1), cB + hstep + kstep, voffB);
    PG8_WAIT_V(6); PG8_BAR;
    for (;;) {
        const bool has_next = S.next(ui + 1, nxt);
        const char* nA = has_next ? (const char*)g.A + (size_t)nxt.pm * tstep : cA; const char* nB = has_next ? (const char*)g.Bt + (size_t)nxt.pn * tstep : cB;
        for (int t = 0; t < nt; t += 2) {
            const bool last = (t == nt - 2);
            const char* a1 = cA + (size_t)(t + 1) * kstep;
            const char* a2 = last ? nA : cA + (size_t)(t + 2) * kstep; const char* b2 = last ? nB : cB + (size_t)(t + 2) * kstep;
            const char* a3 = a2 + kstep; const char* b3 = b2 + kstep;
            if (last && has_next) S.a_ready(nxt);
            PG8_LDB(B0, 0, 0); PG8_SCHED; PG8_LDA(At, 0, 0); PG8_STAGE(PG8_SA(1, 1), a1 + hstep, voffA);
            PG8_WAIT_L(8); PG8_BAR; PG8_WAIT_L(0); PG8_MMA(0, 0, At, B0); PG8_BAR; PG8_SCHED;
            PG8_LDB(B1, 0, 1); PG8_STAGE(PG8_SB(0, 0), b2, voffB);
            PG8_BAR; PG8_WAIT_L(0); PG8_MMA(0, 1, At, B1); PG8_BAR;
            PG8_LDA(At, 0, 1); PG8_STAGE(PG8_SA(0, 0), a2, voffA);
            PG8_BAR; PG8_WAIT_L(0); PG8_MMA(1, 0, At, B0); PG8_BAR; PG8_SCHED;
            PG8_STAGE(PG8_SB(0, 1), b2 + hstep, voffB);
            PG8_WAIT_V(6); PG8_BAR; PG8_MMA(1, 1, At, B1); PG8_BAR;
            PG8_LDB(B0, 1, 0); PG8_SCHED; PG8_LDA(At, 1, 0); PG8_STAGE(PG8_SA(0, 1), a2 + hstep, voffA);
            PG8_WAIT_L(8); PG8_BAR; PG8_WAIT_L(0); PG8_MMA(0, 0, At, B0); PG8_BAR; PG8_SCHED;
            PG8_LDB(B1, 1, 1); PG8_STAGE(PG8_SB(1, 0), b3, voffB);
            PG8_BAR; PG8_WAIT_L(0); PG8_MMA(0, 1, At, B1); PG8_BAR;
            PG8_LDA(At, 1, 1); PG8_STAGE(PG8_SA(1, 0), a3, voffA);
            PG8_BAR; PG8_WAIT_L(0); PG8_MMA(1, 0, At, B0); PG8_BAR; PG8_SCHED;
            PG8_STAGE(PG8_SB(1, 1), b3 + hstep, voffB);
            PG8_WAIT_V(6); PG8_BAR; PG8_MMA(1, 1, At, B1); PG8_BAR;
        }
        if constexpr (!Epi::AFTER_DRAIN) { E(acc, cur, wr, wc, fr, fq); S.done(cur); }
        if (!has_next) break;
#pragma unroll
        for (int a = 0; a < 2; ++a)
#pragma unroll
            for (int b = 0; b < 2; ++b)
#pragma unroll
                for (int m = 0; m < 4; ++m)
#pragma unroll
                    for (int n = 0; n < 2; ++n) acc[a][b][m][n] = (f32x4){0.f, 0.f, 0.f, 0.f};
        cur = nxt; cA = nA; cB = nB; ++ui;
    }
    PG8_WAIT_V(0);
    if (wr == 0) PG8_BAR;
    PG8_BAR;
    if constexpr (Epi::AFTER_DRAIN) { E.fused(acc, cur, wr, wc, fr, fq, lds, wid, lane); S.done(cur); }
#undef PG8_SA
#undef PG8_SB
#undef PG8_STAGE
#undef PG8_LDA
#undef PG8_LDB
#undef PG8_MMA
#undef PG8_WAIT_V
#undef PG8_WAIT_L
#undef PG8_BAR
#undef PG8_SCHED
}
}
using pg8::Unit;
typedef f32x4 Acc[2][2][4][2];

template <class F> DI void store_tile_bf16(const Acc& acc, bf16_t* dst, int ld, int coloff, const Unit& u, int wr, int wc, int fr, int fq, F f) {
    const int row0 = u.pm * 256 + wr * 64 + fr, col0 = coloff + wc * 32 + 4 * fq;
#pragma unroll
    for (int ai = 0; ai < 2; ++ai)
#pragma unroll
        for (int m = 0; m < 4; ++m) { bf16_t* rp = dst + (size_t)(row0 + ai * 128 + m * 16) * ld + col0;
#pragma unroll
            for (int bj = 0; bj < 2; ++bj)
#pragma unroll
                for (int n = 0; n < 2; ++n) { const f32x4 v = acc[ai][bj][m][n]; u32x2 w; w.x = pk2(f(v[0]), f(v[1])); w.y = pk2(f(v[2]), f(v[3])); *(u32x2*)(rp + bj * 128 + n * 16) = w; } }
}

struct EpiSwiglu {
    static constexpr bool PERM = false, AFTER_DRAIN = false;
    bf16_t* act;
    DI void operator()(const Acc& acc, const Unit& u, int wr, int wc, int fr, int fq) const {
        const int row0 = u.pm * 256 + wr * 64 + fr, col0 = u.pn * 128 + wc * 32 + 4 * fq;
#pragma unroll
        for (int ai = 0; ai < 2; ++ai)
#pragma unroll
            for (int m = 0; m < 4; ++m) { bf16_t* rp = act + (size_t)(row0 + ai * 128 + m * 16) * DFF_ + col0;
#pragma unroll
                for (int n = 0; n < 2; ++n) { const f32x4 g = acc[ai][0][m][n], up = acc[ai][1][m][n]; u32x2 w;
                    w.x = pk2(silu_f(g[0]) * up[0], silu_f(g[1]) * up[1]); w.y = pk2(silu_f(g[2]) * up[2], silu_f(g[3]) * up[3]); *(u32x2*)(rp + n * 16) = w; } }
    }
};

struct EpiResid {
    static constexpr bool PERM = false, AFTER_DRAIN = false;
    const float* xin_p; const float* xin_s; float* xout; const float* gate; float scale;
    DI void operator()(const Acc& acc, const Unit& u, int wr, int wc, int fr, int fq) const {
        const int row0 = u.pm * 256 + wr * 64 + fr, col0 = u.pn * 256 + wc * 32 + 4 * fq;
        const int ci = u.pm < 32 ? 0 : 1 + ((u.pm - 32) >> 3);
        const float* gt = gate + (size_t)ci * 9216 + col0;
        f32x4 gv[2][2];
#pragma unroll
        for (int bj = 0; bj < 2; ++bj)
#pragma unroll
            for (int n = 0; n < 2; ++n) gv[bj][n] = *(const f32x4*)(gt + bj * 128 + n * 16) * scale;
#pragma unroll
        for (int ai = 0; ai < 2; ++ai)
#pragma unroll
            for (int m = 0; m < 4; ++m) { const int row = row0 + ai * 128 + m * 16;
                const float* ip = (row < MP_ ? xin_p + (size_t)row * D_ : xin_s + (size_t)(row - MP_) * D_) + col0; float* op = xout + (size_t)row * D_ + col0;
#pragma unroll
                for (int bj = 0; bj < 2; ++bj)
#pragma unroll
                    for (int n = 0; n < 2; ++n) { const f32x4 xv = *(const f32x4*)(ip + bj * 128 + n * 16); *(f32x4*)(op + bj * 128 + n * 16) = xv + gv[bj][n] * acc[ai][bj][m][n]; } }
    }
};

DI void rope_pair(f32x4& x1, f32x4& x2, const float* tab, int pos, int fq) {
    const f32x4 t0 = *(const f32x4*)(tab + (pos * 16 + 4 * fq) * 2), t1 = *(const f32x4*)(tab + (pos * 16 + 4 * fq) * 2 + 4);
    const float c[4] = {t0[0], t0[2], t1[0], t1[2]}, s[4] = {t0[1], t0[3], t1[1], t1[3]};
#pragma unroll
    for (int j = 0; j < 4; ++j) { const float a = x1[j], b = x2[j]; x1[j] = a * c[j] - b * s[j]; x2[j] = a * s[j] + b * c[j]; }
}

struct EpiInEven {
    static constexpr bool PERM = false, AFTER_DRAIN = false;
    unsigned char* wsb; const float* rope;
    DI void operator()(const Acc& acc, const Unit& u, int wr, int wc, int fr, int fq) const {
        const int pn = u.pn;
        if (pn < 2) {
            bf16_t* dst = (bf16_t*)(wsb + (pn == 0 ? A_QA : A_KA)); const float sc = pn == 0 ? 1.f : 0.125f; const bool lat = u.pm >= 32;
            const int row0 = u.pm * 256 + wr * 64 + fr, col0 = wc * 32 + 4 * fq;
#pragma unroll
            for (int ai = 0; ai < 2; ++ai)
#pragma unroll
                for (int m = 0; m < 4; ++m) { const int row = row0 + ai * 128 + m * 16; const int t = (row - MP_) & 2047; const int pos = (wc & 1) ? (t & 63) : (t >> 6);
#pragma unroll
                    for (int bj = 0; bj < 2; ++bj) { f32x4 x1 = acc[ai][bj][m][0], x2 = acc[ai][bj][m][1];
                        if (lat) rope_pair(x1, x2, rope, pos, fq);
                        bf16_t* rp = dst + (size_t)row * 256 + bj * 128 + col0; u32x2 w;
                        w.x = pk2(x1[0] * sc, x1[1] * sc); w.y = pk2(x1[2] * sc, x1[3] * sc); *(u32x2*)rp = w;
                        w.x = pk2(x2[0] * sc, x2[1] * sc); w.y = pk2(x2[2] * sc, x2[3] * sc); *(u32x2*)(rp + 16) = w; } }
        } else if (pn < 4) { store_tile_bf16(acc, (bf16_t*)(wsb + A_VA), 512, (pn - 2) * 256, u, wr, wc, fr, fq, [](float x) { return x; });
        } else if (pn < 6) { store_tile_bf16(acc, (bf16_t*)(wsb + A_GA), 512, (pn - 4) * 256, u, wr, wc, fr, fq, [](float x) { return silu_f(x); });
        } else { store_tile_bf16(acc, (bf16_t*)(wsb + A_PB), 1792, (pn - 6) * 256, u, wr, wc, fr, fq, [](float x) { return x; }); }
    }
};

struct EpiInOdd {
    static constexpr bool PERM = false, AFTER_DRAIN = false;
    unsigned char* wsb; const float* rope; const float* qk_gain; const float* ibias; const float* fbias; float* outb;
    DI void operator()(const Acc& acc, const Unit& u, int wr, int wc, int fr, int fq) const {
        const int pn = u.pn;
        if (pn < 2) { store_tile_bf16(acc, (bf16_t*)(wsb + O_QC), 512, pn * 256, u, wr, wc, fr, fq, [](float x) { return x; });
        } else if (pn < 4) { store_tile_bf16(acc, (bf16_t*)(wsb + O_KC), 512, (pn - 2) * 256, u, wr, wc, fr, fq, [](float x) { return x * 0.08838834764831845f; });
        } else if (pn < 6) { store_tile_bf16(acc, (bf16_t*)(wsb + O_VC), 512, (pn - 4) * 256, u, wr, wc, fr, fq, [](float x) { return x; });
        } else if (pn < 8) { store_tile_bf16(acc, (bf16_t*)(wsb + O_OC), 512, (pn - 6) * 256, u, wr, wc, fr, fq, [](float x) { return sigmoid_f(x); });
        } else if (pn < 11) {
            const bool lat = u.pm >= 32; const bool isv = (pn == 10) && (wc >= 2); const bool isk = (pn == 10) && (wc < 2);
            const float* gain = qk_gain + (isk ? 64 : 0);
            const int row0 = u.pm * 256 + wr * 64 + fr;
#pragma unroll
            for (int ai = 0; ai < 2; ++ai)
#pragma unroll
                for (int m = 0; m < 4; ++m) { const int row = row0 + ai * 128 + m * 16;
                    f32x4 v[2][2];
#pragma unroll
                    for (int bj = 0; bj < 2; ++bj)
#pragma unroll
                        for (int n = 0; n < 2; ++n) v[bj][n] = acc[ai][bj][m][n];
                    if (!isv) {
                        float ss = 0.f;
#pragma unroll
                        for (int bj = 0; bj < 2; ++bj)
#pragma unroll
                            for (int n = 0; n < 2; ++n)
#pragma unroll
                                for (int j = 0; j < 4; ++j) ss += v[bj][n][j] * v[bj][n][j];
                        ss = fq_sum(ss);
                        const float rs = rsqrtf(ss * (1.f / 64.f) + 1e-6f);
#pragma unroll
                        for (int bj = 0; bj < 2; ++bj)
#pragma unroll
                            for (int n = 0; n < 2; ++n) v[bj][n] = v[bj][n] * rs * *(const f32x4*)(gain + 32 * bj + 16 * n + 4 * fq);
                    }
                    if (!lat && pn == 10) {
                        const int b = row >> 8, t = row & 255, hh = wc & 1; float* op = outb + (isk ? OUT_CK : OUT_CV) + ((size_t)(b * 2 + hh) * 256 + t) * 64 + 4 * fq;
#pragma unroll
                        for (int bj = 0; bj < 2; ++bj)
#pragma unroll
                            for (int n = 0; n < 2; ++n) *(f32x4*)(op + 32 * bj + 16 * n) = v[bj][n];
                    }
                    if (lat && !isv) { const int t = (row - MP_) & 2047; rope_pair(v[0][0], v[0][1], rope, t >> 6, fq); rope_pair(v[1][0], v[1][1], rope, t & 63, fq); }
                    bf16_t* rp;
                    if (pn < 10) rp = (bf16_t*)(wsb + O_QD) + (size_t)row * 512 + (4 * (pn - 8) + wc) * 64 + 4 * fq;
                    else rp = (bf16_t*)(wsb + (isk ? O_KD : O_VD)) + (size_t)row * 128 + (wc & 1) * 64 + 4 * fq;
#pragma unroll
                    for (int bj = 0; bj < 2; ++bj)
#pragma unroll
                        for (int n = 0; n < 2; ++n) { u32x2 w; w.x = pk2(v[bj][n][0], v[bj][n][1]); w.y = pk2(v[bj][n][2], v[bj][n][3]); *(u32x2*)(rp + 32 * bj + 16 * n) = w; }
                }
        } else {
            if (wc == 0) {
                const int row0 = u.pm * 256 + wr * 64 + fr; const int c0 = 4 * fq;
                const f32x4 bias = c0 < 8 ? *(const f32x4*)(ibias + c0) : *(const f32x4*)(fbias + c0 - 8);
#pragma unroll
                for (int ai = 0; ai < 2; ++ai)
#pragma unroll
                    for (int m = 0; m < 4; ++m) { const int row = row0 + ai * 128 + m * 16; f32x4 v = acc[ai][0][m][0] + bias;
                        if (c0 >= 8) { v[0] = -softplus_f(-v[0]); v[1] = -softplus_f(-v[1]); v[2] = -softplus_f(-v[2]); v[3] = -softplus_f(-v[3]); }
                        *(f32x4*)((float*)(wsb + O_GT) + (size_t)row * 16 + c0) = v; }
            }
        }
    }
};

struct EpiLora {
    static constexpr bool PERM = false, AFTER_DRAIN = false;
    unsigned char* wsb; const float* w0; const float* a0b;
    DI void operator()(const Acc& acc, const Unit& u, int wr, int wc, int fr, int fq) const {
        const int pn = u.pn;
        if (pn >= 8) { store_tile_bf16(acc, (bf16_t*)(wsb + A_G), 512, (pn - 8) * 256, u, wr, wc, fr, fq, [](float x) { return x; }); return; }
        const int d = (pn >> 1) & 1, cb = (pn & 1) * 256; const bool isw = pn < 4;
        bf16_t* dst = (bf16_t*)(wsb + (isw ? (d ? A_U1 : A_U0) : (d ? A_A1 : A_A0))); const int boff = d * 512 + cb;
        const int row0 = u.pm * 256 + wr * 64 + fr, col0 = wc * 32 + 4 * fq;
#pragma unroll
        for (int ai = 0; ai < 2; ++ai)
#pragma unroll
            for (int m = 0; m < 4; ++m) { bf16_t* rp = dst + (size_t)(row0 + ai * 128 + m * 16) * 512 + cb + col0;
#pragma unroll
                for (int bj = 0; bj < 2; ++bj)
#pragma unroll
                    for (int n = 0; n < 2; ++n) { const float* bp = (isw ? w0 : a0b) + boff + col0 + bj * 128 + n * 16; f32x4 v = acc[ai][bj][m][n] + *(const f32x4*)bp;
#pragma unroll
                        for (int j = 0; j < 4; ++j) { const float ez = __expf(-v[j]); const float sg = __builtin_amdgcn_rcpf(1.f + ez); v[j] = isw ? sg * 0.6065306597f : sg; }
                        u32x2 w; w.x = pk2(v[0], v[1]); w.y = pk2(v[2], v[3]); *(u32x2*)(rp + bj * 128 + n * 16) = w; } }
    }
};
DI int map_col(int kind, int n) {
    if (kind == 0) return n;
    if (kind == 1) { const int pn = n >> 8, bj = (n >> 7) & 1, q = n & 127; return bj * DFF_ + pn * 128 + q; }
    const int pn = n >> 8, tc = n & 255;
    if (pn < 6) return n;
    if (pn < 8) return 1552 + (n - 1536);
    const int hh = (tc & 127) >> 5, bj = tc >> 7, d = 32 * bj + (tc & 31);
    if (pn < 10) return 2064 + (4 * (pn - 8) + hh) * 64 + d;
    if (pn == 10) return hh < 2 ? 2576 + hh * 64 + d : 2704 + (hh - 2) * 64 + d;
    return tc < 16 ? 1536 + tc : -1;
}
DI void conv_load(float (&r)[8], const float* src, int ld, int K, int kind, int tile, int tid) {
    const int tk = K >> 6, n0 = (tile / tk) << 6, k0 = (tile % tk) << 6;
#pragma unroll
    for (int q = 0; q < 8; ++q) { const int e = tid + 512 * q; const int kk = e >> 6, nn = e & 63; const int col = map_col(kind, n0 + nn); r[q] = col >= 0 ? __builtin_nontemporal_load(src + (size_t)(k0 + kk) * ld + col) : 0.f; }
}
DI void conv_finish(const float (&r)[8], bf16_t* dst, int K, int tile, LAS float* T, int tid) {
    const int tk = K >> 6, n0 = (tile / tk) << 6, k0 = (tile % tk) << 6;
    __syncthreads();
#pragma unroll
    for (int q = 0; q < 8; ++q) { const int e = tid + 512 * q; T[(e >> 6) * 65 + (e & 63)] = r[q]; }
    __syncthreads();
    for (int e = tid; e < 2048; e += 512) { const int nn = e >> 5, kp = e & 31; *(unsigned*)(dst + (size_t)(n0 + nn) * K + k0 + 2 * kp) = pk2(T[(2 * kp) * 65 + nn], T[(2 * kp + 1) * 65 + nn]); }
}
DI void conv_tile(const float* src, int ld, bf16_t* dst, int K, int kind, int tile, LAS float* T, int tid) {
    float r[8]; conv_load(r, src, ld, K, kind, tile, tid); conv_finish(r, dst, K, tile, T, tid);
}
struct ConvJob { const float* src; int ld; bf16_t* dst; int K, N, kind; };
DI void convert_layer(KParams& P, int l, LAS unsigned char* lds, int tid, int mask) {
    unsigned char* ws = P.ws;
    ConvJob jobs[6];
    jobs[0] = {P.in[14] + (size_t)(l * 2 + 0) * D_ * 2 * DFF_, 2 * DFF_, (bf16_t*)(ws + W_W1A), D_, 2 * DFF_, 1};
    jobs[1] = {P.in[14] + (size_t)(l * 2 + 1) * D_ * 2 * DFF_, 2 * DFF_, (bf16_t*)(ws + W_W1B), D_, 2 * DFF_, 1};
    jobs[2] = {P.in[15] + (size_t)(l * 2 + 0) * DFF_ * D_, D_, (bf16_t*)(ws + W_W2A), DFF_, D_, 0};
    jobs[3] = {P.in[15] + (size_t)(l * 2 + 1) * DFF_ * D_, D_, (bf16_t*)(ws + W_W2B), DFF_, D_, 0};
    if (l == 0) { jobs[4] = {P.in[16], 3328, (bf16_t*)(ws + W_WIN), D_, 3328, 0}; jobs[5] = {P.in[17], D_, (bf16_t*)(ws + W_WOUT), D_, D_, 0}; }
    else        { jobs[4] = {P.in[31], 2832, (bf16_t*)(ws + W_WIN), D_, 3072, 3}; jobs[5] = {P.in[32], D_, (bf16_t*)(ws + W_WOUT), D_, D_, 0}; }
    LAS float* T = (LAS float*)lds;
#pragma unroll
    for (int j = 0; j < 6; ++j) { if (!((mask >> j) & 1)) continue; const ConvJob J = jobs[j]; const int nt = (J.N >> 6) * (J.K >> 6);
        int t = blockIdx.x; float r0[8], r1[8];
        if (t < nt) conv_load(r0, J.src, J.ld, J.K, J.kind, t, tid);
        for (; t < nt; t += 2 * (int)gridDim.x) {
            const int t1 = t + (int)gridDim.x, t2 = t1 + (int)gridDim.x;
            if (t1 < nt) conv_load(r1, J.src, J.ld, J.K, J.kind, t1, tid);
            conv_finish(r0, J.dst, J.K, t, T, tid);
            if (t2 < nt) conv_load(r0, J.src, J.ld, J.K, J.kind, t2, tid);
            if (t1 < nt) conv_finish(r1, J.dst, J.K, t1, T, tid);
        } }
    if (l == 0) {
        bf16_t* wl = (bf16_t*)(ws + W_WL); const float* w2 = P.in[22]; const float* a2 = P.in[24]; const float* g2 = P.in[25];
        for (int e = blockIdx.x * 512 + tid; e < 2560 * 128; e += gridDim.x * 512) { const int n = e >> 7, k = (e & 127) * 2; const int sel = n >> 9, c = n & 511; float v0 = 0.f, v1 = 0.f;
            if (sel < 2) { if (k < 64) { v0 = w2[(size_t)(sel * 64 + k) * 512 + c]; v1 = w2[(size_t)(sel * 64 + k + 1) * 512 + c]; } }
            else if (sel < 4) { if (k >= 64 && k < 128) { v0 = a2[(size_t)((sel - 2) * 64 + k - 64) * 512 + c]; v1 = a2[(size_t)((sel - 2) * 64 + k - 63) * 512 + c]; } }
            else { if (k >= 128) { v0 = g2[(size_t)(k - 128) * 512 + c]; v1 = g2[(size_t)(k - 127) * 512 + c]; } }
            *(unsigned*)(wl + (size_t)n * 256 + k) = pk2(v0, v1); }
    }
}


DI void conv_l1_early_item(KParams& P, int idx, LAS unsigned char* lds, int tid) {
    LAS float* T = (LAS float*)lds;
    if (idx < 1408) conv_tile(P.in[14] + (size_t)(1 * 2 + 0) * D_ * 2 * DFF_, 2 * DFF_, (bf16_t*)(P.ws + W_W1A), D_, 1, idx, T, tid);
    else if (idx < 2112) conv_tile(P.in[15] + (size_t)(1 * 2 + 0) * DFF_ * D_, D_, (bf16_t*)(P.ws + W_W2A), DFF_, 0, idx - 1408, T, tid);
    else conv_tile(P.in[31], 2832, (bf16_t*)(P.ws + W_WIN), D_, 3, idx - 2112, T, tid);
}
DI void mod_phase(KParams& P, LAS unsigned char* lds, int tid) {
    LAS float* sc = (LAS float*)lds;
    LAS float* red = sc + 9 * 1024;
    const float* c = P.in[9]; const float* cctx = P.in[10];
    for (int e = tid; e < 9 * 1024; e += 512) { const int ci = e >> 10, k = e & 1023; const float v = ci == 0 ? cctx[k] : c[(ci - 1) * 1024 + k]; sc[e] = silu_f(v); }
    __syncthreads();
    float* mod = (float*)(P.ws + WS_MOD);
    const int wid = tid >> 6, lane = tid & 63;
    for (int it = blockIdx.x; it < 288; it += gridDim.x) { const int l = it / 144, n0 = (it % 144) * 64;
        const float* w = P.in[11] + (size_t)l * D_ * 9216 + n0 + lane;
        float acc[9];
#pragma unroll
        for (int i = 0; i < 9; ++i) acc[i] = 0.f;
        for (int k = wid * 128; k < wid * 128 + 128; k += 16) {
            float wv[16];
#pragma unroll
            for (int q = 0; q < 16; ++q) wv[q] = __builtin_nontemporal_load(w + (size_t)(k + q) * 9216);
#pragma unroll
            for (int q = 0; q < 16; ++q)
#pragma unroll
                for (int i = 0; i < 9; ++i) acc[i] += sc[i * 1024 + k + q] * wv[q];
        }
#pragma unroll
        for (int i = 0; i < 9; ++i) red[(wid * 9 + i) * 64 + lane] = acc[i];
        __syncthreads();
        for (int o = tid; o < 576; o += 512) { const int i = o >> 6, ln = o & 63; float s = 0.f;
#pragma unroll
            for (int w8 = 0; w8 < 8; ++w8) s += red[(w8 * 9 + i) * 64 + ln];
            mod[(size_t)(l * 9 + i) * 9216 + n0 + ln] = s + P.in[12][(size_t)l * 9216 + n0 + ln]; }
        __syncthreads();
    }
}

DI void norm_phase(const float* xp, const float* xs, bf16_t* h, const float* g, const float* modl, int qsh, int tid) {
    const int wid = tid >> 6, lane = tid & 63; const int stride = gridDim.x * 8;
    int row = blockIdx.x * 8 + wid;
    f32x4 v[4], nv[4];
    if (row < M_) { const float* xr = row < MP_ ? xp + (size_t)row * D_ : xs + (size_t)(row - MP_) * D_;
#pragma unroll
        for (int i = 0; i < 4; ++i) v[i] = *(const f32x4*)(xr + 4 * lane + 256 * i); }
    for (; row < M_; row += stride) {
        const int nrow = row + stride;
        if (nrow < M_) { const float* xr = nrow < MP_ ? xp + (size_t)nrow * D_ : xs + (size_t)(nrow - MP_) * D_;
#pragma unroll
            for (int i = 0; i < 4; ++i) nv[i] = *(const f32x4*)(xr + 4 * lane + 256 * i); }
        const float* sh = modl + (size_t)cond_of_row(row) * 9216 + qsh * 1024; const float* sc = sh + 1024;
        float ss = 0.f;
#pragma unroll
        for (int i = 0; i < 4; ++i) ss += v[i][0] * v[i][0] + v[i][1] * v[i][1] + v[i][2] * v[i][2] + v[i][3] * v[i][3];
        ss = wave_sum(ss); const float rs = rsqrtf(ss * (1.f / 1024.f) + 1e-6f);
#pragma unroll
        for (int i = 0; i < 4; ++i) { const int c = 4 * lane + 256 * i; const f32x4 gg = *(const f32x4*)(g + c), s1 = *(const f32x4*)(sc + c), s0 = *(const f32x4*)(sh + c);
            const f32x4 y = v[i] * rs * gg * (s1 + 1.f) + s0; u32x2 w; w.x = pk2(y[0], y[1]); w.y = pk2(y[2], y[3]); *(u32x2*)(h + (size_t)row * D_ + c) = w; }
#pragma unroll
        for (int i = 0; i < 4; ++i) v[i] = nv[i];
    }
}
DI void final_norm_phase(float* x, const float* g, int tid) {
    const int wid = tid >> 6, lane = tid & 63; const int stride = gridDim.x * 8;
    int row = blockIdx.x * 8 + wid;
    f32x4 v[4], nv[4];
    if (row < M_) {
#pragma unroll
        for (int i = 0; i < 4; ++i) v[i] = *(const f32x4*)(x + (size_t)row * D_ + 4 * lane + 256 * i); }
    for (; row < M_; row += stride) {
        const int nrow = row + stride;
        if (nrow < M_) {
#pragma unroll
            for (int i = 0; i < 4; ++i) nv[i] = *(const f32x4*)(x + (size_t)nrow * D_ + 4 * lane + 256 * i); }
        float* xr = x + (size_t)row * D_; float ss = 0.f;
#pragma unroll
        for (int i = 0; i < 4; ++i) ss += v[i][0] * v[i][0] + v[i][1] * v[i][1] + v[i][2] * v[i][2] + v[i][3] * v[i][3];
        ss = wave_sum(ss); const float rs = rsqrtf(ss * (1.f / 1024.f) + 1e-6f);
#pragma unroll
        for (int i = 0; i < 4; ++i) { const int c = 4 * lane + 256 * i; *(f32x4*)(xr + c) = v[i] * rs * *(const f32x4*)(g + c); }
#pragma unroll
        for (int i = 0; i < 4; ++i) v[i] = nv[i];
    }
}
#define MFMA16(a, b, c) __builtin_amdgcn_mfma_f32_16x16x32_bf16((a), (b), (c), 0, 0, 0)
template <int COLS> DI void stage_bf16(LAS bf16_t* dst, const bf16_t* src, size_t ldg, int rows, int pitch, int tid) {
    constexpr int PR = COLS / 8;
    for (int p = tid; p < rows * PR; p += 512) { const int r = p / PR, c8 = p % PR; const u32x4 v = *(const u32x4*)(src + (size_t)r * ldg + c8 * 8); *(LAS u32x4*)(dst + r * pitch + c8 * 8) = v; }
}
template <int COLS> DI void stage_f32(LAS bf16_t* dst, const float* src, size_t ldg, int rows, int pitch, int tid) {
    constexpr int PR = COLS / 4;
    for (int p = tid; p < rows * PR; p += 512) { const int r = p / PR, c4 = p % PR; const f32x4 v = *(const f32x4*)(src + (size_t)r * ldg + c4 * 4); u32x2 w; w.x = pk2(v[0], v[1]); w.y = pk2(v[2], v[3]); *(LAS u32x2*)(dst + r * pitch + c4 * 4) = w; }
}

template <int COLS> DI void tile_load(u32x4 (&r)[COLS / 32], const bf16_t* src, size_t ldg, int tid) {
    constexpr int PR = COLS / 8;
#pragma unroll
    for (int i = 0; i < COLS / 32; ++i) { const int p = tid + 512 * i; r[i] = *(const u32x4*)(src + (size_t)(p / PR) * ldg + (p % PR) * 8); }
}
template <int COLS> DI void tile_store(LAS bf16_t* dst, const u32x4 (&r)[COLS / 32], int pitch, int tid) {
    constexpr int PR = COLS / 8;
#pragma unroll
    for (int i = 0; i < COLS / 32; ++i) { const int p = tid + 512 * i; *(LAS u32x4*)(dst + (p / PR) * pitch + (p % PR) * 8) = r[i]; }
}
DI void tile_load_f32x64(f32x4 (&r)[4], const float* src, int tid) {
#pragma unroll
    for (int i = 0; i < 4; ++i) r[i] = *(const f32x4*)(src + (size_t)(tid + 512 * i) * 4);
}
DI void tile_store_f32x64(LAS bf16_t* dst, const f32x4 (&r)[4], int pitch, int tid) {
#pragma unroll
    for (int i = 0; i < 4; ++i) { const int p = tid + 512 * i; u32x2 w; w.x = pk2(r[i][0], r[i][1]); w.y = pk2(r[i][2], r[i][3]); *(LAS u32x2*)(dst + (p >> 4) * pitch + (p & 15) * 4) = w; }
}
template <int DK> DI void qk_tile(const LAS bf16_t* sK, const bf16x8 (&qf)[DK / 32], f32x4 (&sacc)[8], int fr, int fq) {
#pragma unroll
    for (int jt = 0; jt < 8; ++jt) { f32x4 a = {0.f, 0.f, 0.f, 0.f};
#pragma unroll
        for (int s = 0; s < DK / 32; ++s) { const bf16x8 kf = *(const LAS bf16x8*)(sK + (16 * jt + fr) * (DK + 8) + 32 * s + 8 * fq); a = MFMA16(kf, qf[s], a); }
        sacc[jt] = a; }
}
template <int DV, int PITCH = DV + 8> DI void pv_tile(const LAS bf16_t* sV, const bf16x8 (&pf)[4], f32x4 (&oacc)[DV / 16], int fr, int fq) {
#pragma unroll
    for (int et = 0; et < DV / 16; ++et)
#pragma unroll
        for (int s = 0; s < 4; ++s) {
            const LAS bf16_t* p0 = sV + (32 * s + 4 * fq + (fr >> 2)) * PITCH + 16 * et + 4 * (fr & 3);
            const s16x4 lo = __builtin_amdgcn_ds_read_tr16_b64_v4i16((LAS s16x4*)p0), hi = __builtin_amdgcn_ds_read_tr16_b64_v4i16((LAS s16x4*)(p0 + 16 * PITCH));
            const bf16x8 vf = __builtin_shufflevector(lo, hi, 0, 1, 2, 3, 4, 5, 6, 7);
            oacc[et] = MFMA16(vf, pf[s], oacc[et]); }
}
DI void pack_p(const f32x4 (&p)[8], bf16x8 (&pf)[4]) {
#pragma unroll
    for (int s = 0; s < 4; ++s) { u32x4 w; w.x = pk2(p[2 * s][0], p[2 * s][1]); w.y = pk2(p[2 * s][2], p[2 * s][3]); w.z = pk2(p[2 * s + 1][0], p[2 * s + 1][1]); w.w = pk2(p[2 * s + 1][2], p[2 * s + 1][3]); pf[s] = __builtin_bit_cast(bf16x8, w); }
}
template <int DKQ> DI void pack_q_state(const bf16_t* qrow, float f0, float f1, bf16x8 (&pf)[4], f32x4 (&pv)[8], int fq) {
#pragma unroll
    for (int s = 0; s < 4; ++s)
#pragma unroll
        for (int hh = 0; hh < 2; ++hh) { const int key = 32 * s + 16 * hh + 4 * fq; const int d = DKQ == 64 ? (key & 63) : key; const float fac = (DKQ == 64 && key >= 64) ? f1 : f0;
            const u32x2 w = *(const u32x2*)(qrow + d); f32x4 v; v[0] = bf_lo(w.x) * fac; v[1] = bf_hi(w.x) * fac; v[2] = bf_lo(w.y) * fac; v[3] = bf_hi(w.y) * fac; pv[2 * s + hh] = v; }
    pack_p(pv, pf);
}
DI void ln_gate_store(f32x4 (&o)[8], float eps, const float* wgt, const bf16_t* gate, bf16_t* dst, int fq) {
    float s = 0.f;
#pragma unroll
    for (int et = 0; et < 8; ++et) s += o[et][0] + o[et][1] + o[et][2] + o[et][3];
    s = fq_sum(s); const float mu = s * (1.f / 128.f); float vs = 0.f;
#pragma unroll
    for (int et = 0; et < 8; ++et)
#pragma unroll
        for (int j = 0; j < 4; ++j) { const float d = o[et][j] - mu; vs += d * d; }
    vs = fq_sum(vs); const float rs = rsqrtf(vs * (1.f / 128.f) + eps);
#pragma unroll
    for (int et = 0; et < 8; ++et) { const int e = 16 * et + 4 * fq; const f32x4 wv = *(const f32x4*)(wgt + e); const u32x2 gw = *(const u32x2*)(gate + e);
        u32x2 w; w.x = pk2((o[et][0] - mu) * rs * wv[0] * bf_lo(gw.x), (o[et][1] - mu) * rs * wv[1] * bf_hi(gw.x));
        w.y = pk2((o[et][2] - mu) * rs * wv[2] * bf_lo(gw.y), (o[et][3] - mu) * rs * wv[3] * bf_hi(gw.y)); *(u32x2*)(dst + e) = w; }
}


template <int DK> DI void state_mfma(const bf16_t* kg, size_t ldk, const bf16_t* vg, size_t ldv, const LAS float* wj, LAS unsigned char* lds, float* out, float* nout, int tid) {
    constexpr int PK = DK == 128 ? 144 : 72, NE = DK == 128 ? 8 : 4, PR = DK / 8;
    const int wid = tid >> 6, lane = tid & 63, fr = lane & 15, fq = lane >> 4;
    const int dt = DK == 128 ? wid : (wid & 3), e0 = DK == 128 ? 0 : (wid >> 2) * 4;
    LAS bf16_t* sKw = (LAS bf16_t*)lds; LAS bf16_t* sV = (LAS bf16_t*)(lds + 36864);
    f32x4 acc[NE];
#pragma unroll
    for (int i = 0; i < NE; ++i) acc[i] = (f32x4){0.f, 0.f, 0.f, 0.f};
    float nacc = 0.f;
#pragma unroll 1
    for (int hf = 0; hf < 2; ++hf) {
        __syncthreads();
        for (int p = tid; p < 128 * PR; p += 512) { const int r = p / PR, c8 = p % PR; const u32x4 v = *(const u32x4*)(kg + (size_t)(128 * hf + r) * ldk + c8 * 8); const float w = wj[128 * hf + r];
            u32x4 o; o.x = pk2(bf_lo(v.x) * w, bf_hi(v.x) * w); o.y = pk2(bf_lo(v.y) * w, bf_hi(v.y) * w); o.z = pk2(bf_lo(v.z) * w, bf_hi(v.z) * w); o.w = pk2(bf_lo(v.w) * w, bf_hi(v.w) * w);
            *(LAS u32x4*)(sKw + r * PK + c8 * 8) = o; }
        stage_bf16<128>(sV, vg + (size_t)(128 * hf) * ldv, ldv, 128, 144, tid);
        __syncthreads();
#pragma unroll
        for (int s = 0; s < 4; ++s) {
            const LAS bf16_t* pa = sKw + (32 * s + 4 * fq + (fr >> 2)) * PK + 16 * dt + 4 * (fr & 3);
            const s16x4 alo = __builtin_amdgcn_ds_read_tr16_b64_v4i16((LAS s16x4*)pa), ahi = __builtin_amdgcn_ds_read_tr16_b64_v4i16((LAS s16x4*)(pa + 16 * PK));
            const bf16x8 af = __builtin_shufflevector(alo, ahi, 0, 1, 2, 3, 4, 5, 6, 7);
#pragma unroll
            for (int i = 0; i < NE; ++i) {
                const LAS bf16_t* pb = sV + (32 * s + 4 * fq + (fr >> 2)) * 144 + 16 * (e0 + i) + 4 * (fr & 3);
                const s16x4 blo = __builtin_amdgcn_ds_read_tr16_b64_v4i16((LAS s16x4*)pb), bhi = __builtin_amdgcn_ds_read_tr16_b64_v4i16((LAS s16x4*)(pb + 16 * 144));
                const bf16x8 bfv = __builtin_shufflevector(blo, bhi, 0, 1, 2, 3, 4, 5, 6, 7);
                acc[i] = MFMA16(af, bfv, acc[i]); }
        }
        if (nout && tid < DK) { for (int j = 0; j < 128; ++j) nacc += bf2f(sKw[j * PK + tid]); }
    }
#pragma unroll
    for (int i = 0; i < NE; ++i)
#pragma unroll
        for (int r = 0; r < 4; ++r) out[(size_t)(16 * dt + 4 * fq + r) * 128 + 16 * (e0 + i) + fr] = acc[i][r];
    if (nout && tid < DK) nout[tid] = nacc;
}
DI void ret_item(KParams& P, int item, LAS unsigned char* lds, int tid) {
    const int wid = tid >> 6, lane = tid & 63, fr = lane & 15, fq = lane >> 4;
    int b, h, c, L, rowbase, nc; bool lat;
    if (item < 128) { b = item >> 2; h = item & 3; c = 0; L = 256; rowbase = b * 256; nc = 2; lat = false; }
    else { const int it = item - 128; b = it >> 5; h = (it >> 3) & 3; c = it & 7; L = 2048; rowbase = MP_ + b * 2048; nc = 16; lat = true; }
    const bf16_t* qA = (const bf16_t*)(P.ws + A_QA); const bf16_t* kA = (const bf16_t*)(P.ws + A_KA); const bf16_t* vA = (const bf16_t*)(P.ws + A_VA); const bf16_t* gA = (const bf16_t*)(P.ws + A_GA);
    LAS bf16_t* sK = (LAS bf16_t*)lds; LAS bf16_t* sV = (LAS bf16_t*)(lds + 128 * 72 * 2);
    const float lgf = P.in[18][h], lgb = P.in[18][4 + h];
    const float lgf2 = lgf * 1.4426950408889634f, lgb2 = lgb * 1.4426950408889634f;
    const int ti0 = 256 * c + 32 * wid + fr;
    bf16x8 qf[2][2];
#pragma unroll
    for (int it = 0; it < 2; ++it)
#pragma unroll
        for (int s = 0; s < 2; ++s) qf[it][s] = *(const bf16x8*)(qA + (size_t)(rowbase + ti0 + 16 * it) * 256 + h * 64 + 32 * s + 8 * fq);
    f32x4 oacc[2][8];
#pragma unroll
    for (int it = 0; it < 2; ++it)
#pragma unroll
        for (int et = 0; et < 8; ++et) oacc[it][et] = (f32x4){0.f, 0.f, 0.f, 0.f};
    f32x4 sacc[8]; bf16x8 pf[2][4];
    auto pv2 = [&](const LAS bf16_t* cV) {
#pragma unroll
        for (int et = 0; et < 8; ++et)
#pragma unroll
            for (int s = 0; s < 4; ++s) {
                const LAS bf16_t* p0 = cV + (32 * s + 4 * fq + (fr >> 2)) * 144 + 16 * et + 4 * (fr & 3);
                const s16x4 lo = __builtin_amdgcn_ds_read_tr16_b64_v4i16((LAS s16x4*)p0), hi = __builtin_amdgcn_ds_read_tr16_b64_v4i16((LAS s16x4*)(p0 + 16 * 144));
                const bf16x8 vf = __builtin_shufflevector(lo, hi, 0, 1, 2, 3, 4, 5, 6, 7);
                oacc[0][et] = MFMA16(vf, pf[0][s], oacc[0][et]); oacc[1][et] = MFMA16(vf, pf[1][s], oacc[1][et]); if (s == 3 && (et & 1)) __builtin_amdgcn_sched_barrier(0); } };
    {
        u32x4 rk[2], rv[4];
        const bf16_t* kg = kA + (size_t)rowbase * 256 + h * 64; const bf16_t* vg = vA + (size_t)rowbase * 512 + h * 128;
        tile_load<64>(rk, kg, 256, tid); tile_load<128>(rv, vg, 512, tid);
        __syncthreads();
        tile_store<64>(sK, rk, 72, tid); tile_store<128>(sV, rv, 144, tid);
        if (nc > 1) { tile_load<64>(rk, kg + (size_t)128 * 256, 256, tid); tile_load<128>(rv, vg + (size_t)128 * 512, 512, tid); }
        __syncthreads();
        for (int kc = 0; kc < nc; ++kc) {
            const LAS bf16_t* cK = sK + (kc & 1) * 27648; const LAS bf16_t* cV = sV + (kc & 1) * 27648;
#pragma unroll
            for (int it = 0; it < 2; ++it) {
                qk_tile<64>(cK, qf[it], sacc, fr, fq);
#pragma unroll
                for (int jt = 0; jt < 8; ++jt)
#pragma unroll
                    for (int r = 0; r < 4; ++r) { const int tj = 128 * kc + 16 * jt + 4 * fq + r; const int dl = ti0 + 16 * it - tj;
                        const float e = __builtin_amdgcn_exp2f((dl > 0 ? lgf2 : lgb2) * (float)(dl > 0 ? dl : -dl)); sacc[jt][r] *= (dl == 0 ? 2.f : e); }
                pack_p(sacc, pf[it]); }
            pv2(cV);
            { const int tl = launder_v(tid);
            if (kc + 1 < nc) { tile_store<64>(sK + ((kc + 1) & 1) * 27648, rk, 72, tl); tile_store<128>(sV + ((kc + 1) & 1) * 27648, rv, 144, tl); }
            if (kc + 2 < nc) { tile_load<64>(rk, kg + (size_t)128 * (kc + 2) * 256, 256, tl); tile_load<128>(rv, vg + (size_t)128 * (kc + 2) * 512, 512, tl); } }
            __syncthreads();
        }
    }
    if (lat) {
        __syncthreads();
        const float* s0 = P.in[2] + (size_t)b * 2 * 4 * 64 * 128;
        stage_f32<128>(sV, s0 + (size_t)(0 * 4 + h) * 64 * 128, 128, 64, 144, tid);
        stage_f32<128>(sV + 64 * 144, s0 + (size_t)(1 * 4 + h) * 64 * 128, 128, 64, 144, tid);
        __syncthreads();
#pragma unroll
        for (int it = 0; it < 2; ++it) { const int ti = ti0 + 16 * it;
            pack_q_state<64>(qA + (size_t)(rowbase + ti) * 256 + h * 64, __expf(lgf * (float)(ti + 1)), __expf(lgb * (float)(L - ti)), pf[it], sacc, fq); }
        pv2(sV);
    }
#pragma unroll
    for (int it = 0; it < 2; ++it) { const int qrow = launder_v(rowbase + ti0) + 16 * it;
        ln_gate_store(oacc[it], 1e-5f, P.in[19] + h * 128, gA + (size_t)qrow * 512 + h * 128, (bf16_t*)(P.ws + WS_H) + (size_t)qrow * D_ + h * 128, fq); }
}
DI void ret_state_item(KParams& P, int item, LAS unsigned char* lds, int tid) {
    const int b = item >> 3, h = (item >> 1) & 3, dir = item & 1; const int rowbase = b * 256;
    const bf16_t* kA = (const bf16_t*)(P.ws + A_KA); const bf16_t* vA = (const bf16_t*)(P.ws + A_VA);
    LAS float* wj = (LAS float*)(lds + MISC_OFF);
    const float lg = P.in[18][dir * 4 + h];
    __syncthreads();
    if (tid < 256) wj[tid] = __expf(lg * (float)(dir ? tid : 255 - tid));
    state_mfma<64>(kA + (size_t)rowbase * 256 + h * 64, 256, vA + (size_t)rowbase * 512 + h * 128, 512, wj, lds, P.out + OUT_RET + (size_t)((b * 2 + dir) * 4 + h) * 64 * 128, nullptr, tid);
}
DI float wave_incl_sum(float v, int lane) {
#pragma unroll
    for (int o = 1; o < 64; o <<= 1) { const float t = __shfl_up(v, o); if (lane >= o) v += t; }
    return v;
}
DI float wave_incl_max(float v, int lane) {
#pragma unroll
    for (int o = 1; o < 64; o <<= 1) { const float t = __shfl_up(v, o); if (lane >= o) v = fmaxf(v, t); }
    return v;
}
DI void gate_scan(const LAS float* ig, const LAS float* lf, LAS float* cf, LAS float* rowf, LAS float* Fq, int L, int t0, bool rev, float m0, int lane, float& Ftot, float& Mtot) {
    float csum = 0.f, cmax = m0;
    for (int blk = 0; blk < L; blk += 64) { const int pos = blk + lane; const int t = rev ? L - 1 - pos : pos;
        const float F = csum + wave_incl_sum(lf[t], lane); const float c = ig[t] - F; const float pm = fmaxf(cmax, wave_incl_max(c, lane));
        cf[t] = c; if (t >= t0 && t < t0 + 128) { rowf[t - t0] = -pm; Fq[t - t0] = F; }
        csum = __shfl(F, 63); cmax = __shfl(pm, 63); }
    Ftot = csum; Mtot = cmax;
}
DI void mlstm_item(KParams& P, int item, LAS unsigned char* lds, int tid) {
    const int wid = tid >> 6, lane = tid & 63, fr = lane & 15, fq = lane >> 4;
    int b, h, c, L, rowbase, nc; bool lat;
    if (item < 256) { b = item >> 3; h = (item >> 1) & 3; c = item & 1; L = 256; rowbase = b * 256; nc = 2; lat = false; }
    else { const int it = item - 256; b = it >> 6; h = (it >> 4) & 3; c = it & 15; L = 2048; rowbase = MP_ + b * 2048; nc = 16; lat = true; }
    const bf16_t* qC = (const bf16_t*)(P.ws + O_QC); const bf16_t* kC = (const bf16_t*)(P.ws + O_KC); const bf16_t* vC = (const bf16_t*)(P.ws + O_VC); const bf16_t* oC = (const bf16_t*)(P.ws + O_OC);
    const float* gates = (const float*)(P.ws + O_GT); bf16_t* mix = (bf16_t*)(P.ws + WS_H);
    LAS bf16_t* sK = (LAS bf16_t*)lds; LAS bf16_t* sV = (LAS bf16_t*)(lds + 34816);
    LAS float* cfa = (LAS float*)(lds + 73728);
    LAS float* rowfa = (LAS float*)(lds + 90112);
    LAS float* Fqa = rowfa + 256;
    LAS float* tmp = (LAS float*)(lds + 94208);
    __syncthreads();
    for (int t = tid; t < L; t += 512) { const float* g = gates + (size_t)(rowbase + t) * 16; tmp[t] = g[h]; tmp[2048 + t] = g[8 + h]; tmp[4096 + t] = g[4 + h]; tmp[6144 + t] = g[12 + h]; }
    __syncthreads();
    float m0f = 0.f, m0b = 0.f;
    if (lat) { m0f = P.in[6][(b * 2 + 0) * 4 + h]; m0b = P.in[6][(b * 2 + 1) * 4 + h]; }
    {
        LAS float* bs = (LAS float*)(lds + MISC_OFF);
        const int nblk = L >> 6;
        for (int j = wid; j < 2 * nblk; j += 8) { const int dr = j >= nblk, blk = dr ? j - nblk : j; const int pos = 64 * blk + lane; const int t = dr ? L - 1 - pos : pos;
            LAS float* ig = tmp + dr * 4096; LAS float* lf = ig + 2048;
            const float Fl = wave_incl_sum(lf[t], lane); const float cl = ig[t] - Fl; const float pm = wave_incl_max(cl, lane);
            cfa[dr * 2048 + t] = cl; ig[t] = pm; lf[t] = Fl;
            if (lane == 63) { bs[dr * 32 + blk] = Fl; bs[64 + dr * 32 + blk] = pm; } }
        __syncthreads();
        if (wid == 0) { const int dr = lane >> 5, blk = lane & 31;
            if (blk < nblk) { float C = 0.f, cm = dr ? m0b : m0f;
                for (int q = 0; q < blk; ++q) { cm = fmaxf(cm, bs[64 + dr * 32 + q] - C); C += bs[dr * 32 + q]; }
                bs[128 + dr * 32 + blk] = C; bs[192 + dr * 32 + blk] = cm; } }
        __syncthreads();
        for (int e = tid; e < 2 * L; e += 512) { const int dr = e >= L, t = dr ? e - L : e; const int pos = dr ? L - 1 - t : t; const int blk = pos >> 6;
            const float C = bs[128 + dr * 32 + blk], cm = bs[192 + dr * 32 + blk];
            cfa[dr * 2048 + t] -= C;
            if (t >= 128 * c && t < 128 * c + 128) { rowfa[dr * 128 + t - 128 * c] = -fmaxf(cm, tmp[dr * 4096 + t] - C); Fqa[dr * 128 + t - 128 * c] = tmp[dr * 4096 + 2048 + t] + C; } }
    }
    __syncthreads();
    const int ti = 128 * c + 16 * wid + fr; const int qrow = rowbase + ti;
    bf16x8 qf[4];
#pragma unroll
    for (int s = 0; s < 4; ++s) qf[s] = *(const bf16x8*)(qC + (size_t)qrow * 512 + h * 128 + 32 * s + 8 * fq);
    f32x4 hsum[8];
#pragma unroll
    for (int et = 0; et < 8; ++et) hsum[et] = (f32x4){0.f, 0.f, 0.f, 0.f};
    f32x4 sacc[8]; bf16x8 pf[4];
#pragma unroll 1
    for (int dir = 0; dir < 2; ++dir) {
        f32x4 num[8];
#pragma unroll
        for (int et = 0; et < 8; ++et) num[et] = (f32x4){0.f, 0.f, 0.f, 0.f};
        float den = 0.f;
        const float rf = rowfa[dir * 128 + 16 * wid + fr]; const LAS float* cf = cfa + dir * 2048;
        const int k0 = dir ? c : 0, k1 = dir ? nc : c + 1;
        {
            u32x4 rk[4], rv[4];
            const bf16_t* kg = kC + (size_t)rowbase * 512 + h * 128; const bf16_t* vg = vC + (size_t)rowbase * 512 + h * 128;
            tile_load<128>(rk, kg + (size_t)128 * k0 * 512, 512, tid); tile_load<128>(rv, vg + (size_t)128 * k0 * 512, 512, tid);
            for (int kc = k0; kc < k1; ++kc) {
                __syncthreads();
                tile_store<128>(sK, rk, 136, tid); tile_store<128>(sV, rv, 144, tid);
                __syncthreads();
                if (kc + 1 < k1) { tile_load<128>(rk, kg + (size_t)128 * (kc + 1) * 512, 512, tid); tile_load<128>(rv, vg + (size_t)128 * (kc + 1) * 512, 512, tid); }
                qk_tile<128>(sK, qf, sacc, fr, fq);
#pragma unroll
                for (int jt = 0; jt < 8; ++jt) { const f32x4 cv = *(const LAS f32x4*)(cf + 128 * kc + 16 * jt + 4 * fq);
#pragma unroll
                    for (int r = 0; r < 4; ++r) { const int tj = 128 * kc + 16 * jt + 4 * fq + r; const bool ok = dir ? (tj >= ti) : (tj <= ti);
                        const float w = ok ? __expf(rf + cv[r]) : 0.f; const float p = sacc[jt][r] * w; sacc[jt][r] = p; den += p; } }
                pack_p(sacc, pf);
                pv_tile<128, 144>(sV, pf, num, fr, fq);
            }
        }
        if (lat) {
            __syncthreads();
            stage_f32<128>(sV, P.in[4] + (size_t)((b * 2 + dir) * 4 + h) * 128 * 128, 128, 128, 144, tid);
            __syncthreads();
            const float fac = __expf((dir ? m0b : m0f) + rf);
            pack_q_state<128>(qC + (size_t)qrow * 512 + h * 128, fac, fac, pf, sacc, fq);
            const float* n0 = P.in[5] + (size_t)((b * 2 + dir) * 4 + h) * 128;
#pragma unroll
            for (int jt = 0; jt < 8; ++jt) { const f32x4 nv = *(const f32x4*)(n0 + 16 * jt + 4 * fq); den += sacc[jt][0] * nv[0] + sacc[jt][1] * nv[1] + sacc[jt][2] * nv[2] + sacc[jt][3] * nv[3]; }
            pv_tile<128, 144>(sV, pf, num, fr, fq);
        }
        den = fq_sum(den);
        const float thr = __expf(rf - Fqa[dir * 128 + 16 * wid + fr]);
        const float dn = 1.f / fmaxf(fabsf(den), thr);
#pragma unroll
        for (int et = 0; et < 8; ++et) hsum[et] += num[et] * dn;
    }
    ln_gate_store(hsum, 1e-5f, P.in[35] + h * 128, oC + (size_t)qrow * 512 + h * 128, mix + (size_t)qrow * D_ + h * 128, fq);
}
DI void mlstm_state_item(KParams& P, int item, LAS unsigned char* lds, int tid) {
    const int wid = tid >> 6, lane = tid & 63;
    const int b = item >> 3, h = (item >> 1) & 3, dir = item & 1; const int rowbase = b * 256;
    const bf16_t* kC = (const bf16_t*)(P.ws + O_KC); const bf16_t* vC = (const bf16_t*)(P.ws + O_VC); const float* gates = (const float*)(P.ws + O_GT);
    LAS float* mi = (LAS float*)(lds + MISC_OFF);
    __syncthreads();
    if (tid < 256) { const float* g = gates + (size_t)(rowbase + tid) * 16; mi[tid] = g[dir * 4 + h]; mi[256 + tid] = g[8 + dir * 4 + h]; }
    __syncthreads();
    if (wid == 0) { float Ft, Mt; gate_scan(mi, mi + 256, mi + 512, mi + 768, mi + 896, 256, 0, dir == 1, 0.f, lane, Ft, Mt); if (lane == 0) { mi[1024] = Ft; mi[1025] = Mt; } }
    __syncthreads();
    const float Ft = mi[1024], Mt = mi[1025];
    if (tid < 256) mi[512 + tid] = __expf(mi[512 + tid] - Mt);
    const size_t sidx = (size_t)(b * 2 + dir) * 4 + h;
    state_mfma<128>(kC + (size_t)rowbase * 512 + h * 128, 512, vC + (size_t)rowbase * 512 + h * 128, 512, mi + 512, lds, P.out + OUT_MC + sidx * 128 * 128, P.out + OUT_MN + sidx * 128, tid);
    if (tid == 0) P.out[OUT_MM + sidx] = Ft + Mt;
}
DI void attn_item(KParams& P, int item, LAS unsigned char* lds, int tid) {
    const int wid = tid >> 6, lane = tid & 63, fr = lane & 15, fq = lane >> 4;
    int b, qh, qb, rowbase, nkt; bool lat;
    if (item >= 512) { const int it = item - 512; b = it >> 3; qh = it & 7; qb = 0; rowbase = b * 256; nkt = 2; lat = false; }
    else { b = item >> 6; qh = (item >> 3) & 7; qb = item & 7; rowbase = MP_ + b * 2048; nkt = 20; lat = true; }
    const int kvh = qh >> 2;
    const bf16_t* qD = (const bf16_t*)(P.ws + O_QD); const bf16_t* kD = (const bf16_t*)(P.ws + O_KD); const bf16_t* vD = (const bf16_t*)(P.ws + O_VD); bf16_t* mix = (bf16_t*)(P.ws + WS_H);
    LAS bf16_t* sK = (LAS bf16_t*)lds; LAS bf16_t* sV = (LAS bf16_t*)(lds + 128 * 72 * 2);
    const int qrow = rowbase + 256 * qb + 32 * wid + fr;
    bf16x8 qf[2][2];
#pragma unroll
    for (int it = 0; it < 2; ++it)
#pragma unroll
        for (int s = 0; s < 2; ++s) qf[it][s] = *(const bf16x8*)(qD + (size_t)(qrow + 16 * it) * 512 + qh * 64 + 32 * s + 8 * fq);
    f32x4 oacc[2][4];
#pragma unroll
    for (int it = 0; it < 2; ++it)
#pragma unroll
        for (int et = 0; et < 4; ++et) oacc[it][et] = (f32x4){0.f, 0.f, 0.f, 0.f};
    float mrun[2] = {-1e30f, -1e30f}, lpart[2] = {0.f, 0.f};
    f32x4 sacc[2][8]; bf16x8 pf[2][4];
    {
        u32x4 ra[2], rc[2];
        const bf16_t* cKb = (const bf16_t*)(P.ws + WS_CK); const bf16_t* cVb = (const bf16_t*)(P.ws + WS_CV);
        auto t_load = [&](int kt) {
            if (lat && kt < 4) { const size_t off = ((size_t)(b * 2 + kvh) * 512 + 128 * kt) * 64; tile_load<64>(ra, cKb + off, 64, tid); tile_load<64>(rc, cVb + off, 64, tid); }
            else { const size_t r0 = (size_t)rowbase + 128 * (lat ? kt - 4 : kt); tile_load<64>(ra, kD + r0 * 128 + kvh * 64, 128, tid); tile_load<64>(rc, vD + r0 * 128 + kvh * 64, 128, tid); } };
        auto t_store = [&](int kt) { tile_store<64>(sK + (kt & 1) * 18432, ra, 72, tid); tile_store<64>(sV + (kt & 1) * 18432, rc, 72, tid); };
        t_load(0);
        __syncthreads();
        t_store(0);
        if (nkt > 1) t_load(1);
        __syncthreads();
        for (int kt = 0; kt < nkt; ++kt) {
            const LAS bf16_t* cK = sK + (kt & 1) * 18432; const LAS bf16_t* cV = sV + (kt & 1) * 18432;
#pragma unroll
            for (int jt = 0; jt < 8; ++jt) { f32x4 a0 = {0.f, 0.f, 0.f, 0.f}, a1 = {0.f, 0.f, 0.f, 0.f};
#pragma unroll
                for (int s = 0; s < 2; ++s) { const bf16x8 kf = *(const LAS bf16x8*)(cK + (16 * jt + fr) * 72 + 32 * s + 8 * fq); a0 = MFMA16(kf, qf[0][s], a0); a1 = MFMA16(kf, qf[1][s], a1); }
                sacc[0][jt] = a0; sacc[1][jt] = a1; }
#pragma unroll
            for (int it = 0; it < 2; ++it) {
                float tmax = -1e30f;
#pragma unroll
                for (int jt = 0; jt < 8; ++jt)
#pragma unroll
                    for (int r = 0; r < 4; ++r) tmax = fmaxf(tmax, sacc[it][jt][r]);
                tmax = fq_max(tmax) * 0.18033688011112042f;
                const float mnew = fmaxf(mrun[it], tmax), alpha = __builtin_amdgcn_exp2f(mrun[it] - mnew); float ps = 0.f;
#pragma unroll
                for (int jt = 0; jt < 8; ++jt)
#pragma unroll
                    for (int r = 0; r < 4; ++r) { const float p = __builtin_amdgcn_exp2f(sacc[it][jt][r] * 0.18033688011112042f - mnew); sacc[it][jt][r] = p; ps += p; }
                lpart[it] = lpart[it] * alpha + ps; mrun[it] = mnew;
                if (__builtin_amdgcn_ballot_w64(alpha != 1.f)) {
#pragma unroll
                    for (int et = 0; et < 4; ++et) oacc[it][et] *= alpha; }
                pack_p(sacc[it], pf[it]);
            }
#pragma unroll
            for (int et = 0; et < 4; ++et)
#pragma unroll
                for (int s = 0; s < 4; ++s) {
                    const LAS bf16_t* p0 = cV + (32 * s + 4 * fq + (fr >> 2)) * 72 + 16 * et + 4 * (fr & 3);
                    const s16x4 lo = __builtin_amdgcn_ds_read_tr16_b64_v4i16((LAS s16x4*)p0), hi = __builtin_amdgcn_ds_read_tr16_b64_v4i16((LAS s16x4*)(p0 + 16 * 72));
                    const bf16x8 vf = __builtin_shufflevector(lo, hi, 0, 1, 2, 3, 4, 5, 6, 7);
                    oacc[0][et] = MFMA16(vf, pf[0][s], oacc[0][et]); oacc[1][et] = MFMA16(vf, pf[1][s], oacc[1][et]); }
            if (kt + 1 < nkt) t_store(kt + 1);
            if (kt + 2 < nkt) t_load(kt + 2);
            __syncthreads();
        }
    }
#pragma unroll
    for (int it = 0; it < 2; ++it) {
        const float inv = 1.f / fq_sum(lpart[it]);
        bf16_t* dst = (bf16_t*)(P.ws + WS_H) + (size_t)(launder_v(qrow) + 16 * it) * D_ + 512 + qh * 64 + 4 * fq;
#pragma unroll
        for (int et = 0; et < 4; ++et) { u32x2 w; w.x = pk2(oacc[it][et][0] * inv, oacc[it][et][1] * inv); w.y = pk2(oacc[it][et][2] * inv, oacc[it][et][3] * inv); *(u32x2*)(dst + 16 * et) = w; }
    }
}

DI void rwkv_shift_row(const bf16_t* pB, const float* mu, bf16_t* rB, bf16_t* kB, bf16_t* vB, bf16_t* X, int row, int lane) {
    const int t = seqpos_of_row(row), L = row < MP_ ? 256 : 2048; const bool hp = t > 0, hn = t < L - 1;
    const bf16_t* pr = pB + (size_t)row * 1792;
    u32x2 cu[7], pu[7], nu[7];
#pragma unroll
    for (int g = 0; g < 7; ++g) { const int c = 256 * g + 4 * lane; cu[g] = *(const u32x2*)(pr + c); pu[g] = (u32x2){0u, 0u}; nu[g] = (u32x2){0u, 0u};
        if (hp) pu[g] = *(const u32x2*)(pr - 1792 + c); if (hn) nu[g] = *(const u32x2*)(pr + 1792 + c); }
#pragma unroll
    for (int g = 0; g < 7; ++g) { const int c = 256 * g + 4 * lane;
        const f32x4 m4 = *(const f32x4*)(mu + c);
        float x[4] = {bf_lo(cu[g].x), bf_hi(cu[g].x), bf_lo(cu[g].y), bf_hi(cu[g].y)}; const float pv[4] = {bf_lo(pu[g].x), bf_hi(pu[g].x), bf_lo(pu[g].y), bf_hi(pu[g].y)}, nv[4] = {bf_lo(nu[g].x), bf_hi(nu[g].x), bf_lo(nu[g].y), bf_hi(nu[g].y)};
#pragma unroll
        for (int j = 0; j < 4; ++j) x[j] = x[j] + m4[j] * (0.5f * (pv[j] + nv[j]) - x[j]);
        u32x2 w;
        if (g < 6) { w.x = pk2(x[0], x[1]); w.y = pk2(x[2], x[3]); bf16_t* dst = g < 2 ? rB : (g < 4 ? kB : vB); *(u32x2*)(dst + (size_t)row * 512 + (g & 1) * 256 + 4 * lane) = w; }
        else { const int cc = 4 * lane;
#pragma unroll
            for (int j = 0; j < 4; ++j) x[j] = cc < 64 ? tanhf(x[j]) : (cc < 128 ? x[j] : sigmoid_f(x[j]));
            w.x = pk2(x[0], x[1]); w.y = pk2(x[2], x[3]); *(u32x2*)(X + (size_t)row * 256 + cc) = w; }
    }
}
DI void rwkv_shift_phase(KParams& P, int tid) {
    const int wid = tid >> 6, lane = tid & 63;
    const bf16_t* pB = (const bf16_t*)(P.ws + A_PB); const float* mu = P.in[20];
    bf16_t* rB = (bf16_t*)(P.ws + A_R); bf16_t* kB = (bf16_t*)(P.ws + A_K); bf16_t* vB = (bf16_t*)(P.ws + A_V); bf16_t* X = (bf16_t*)(P.ws + A_X);
    for (int row = blockIdx.x * 8 + wid; row < M_; row += gridDim.x * 8) rwkv_shift_row(pB, mu, rB, kB, vB, X, row, lane);
}
DI float dpp_xor1(float v) { return __int_as_float(__builtin_amdgcn_mov_dpp(__float_as_int(v), 0xB1, 0xf, 0xf, true)); }
DI float dpp_xor2(float v) { return __int_as_float(__builtin_amdgcn_mov_dpp(__float_as_int(v), 0x4E, 0xf, 0xf, true)); }
DI float dpp_hmir(float v) { return __int_as_float(__builtin_amdgcn_mov_dpp(__float_as_int(v), 0x141, 0xf, 0xf, true)); }
DI float sum8(float v) { v += dpp_xor1(v); v += dpp_xor2(v); v += dpp_hmir(v); return v; }
DI float dpp_rmir(float v) { return __int_as_float(__builtin_amdgcn_mov_dpp(__float_as_int(v), 0x140, 0xf, 0xf, true)); }
DI float sum16(float v) { v += dpp_xor1(v); v += dpp_xor2(v); v += dpp_hmir(v); v += dpp_rmir(v); return v; }
DI void rwkv_scan_item(KParams& P, int item, LAS unsigned char* lds, int tid) {
    int b, h, dir, L, rowbase; bool lat;
    if (item < 128) { b = item >> 4; h = (item >> 1) & 7; dir = item & 1; L = 2048; rowbase = MP_ + b * 2048; lat = true; }
    else { const int it = item - 128; b = it >> 4; h = (it >> 1) & 7; dir = it & 1; L = 256; rowbase = b * 256; lat = false; }
    const bf16_t* rB = (const bf16_t*)(P.ws + A_R); const bf16_t* kB = (const bf16_t*)(P.ws + A_K); const bf16_t* vB = (const bf16_t*)(P.ws + A_V);
    const bf16_t* uB = (const bf16_t*)(P.ws + (dir ? A_U1 : A_U0)); const bf16_t* aB = (const bf16_t*)(P.ws + (dir ? A_A1 : A_A0)); bf16_t* y = (bf16_t*)(P.ws + A_Y) + (dir ? (size_t)M_ * 512 : 0);
    LAS float* buf = (LAS float*)lds;
    LAS float* ybuf = (LAS float*)(lds + 98304);
    const int i = tid >> 3, cg = tid & 7, tt_s = tid >> 4, jc = (tid & 15) * 4;
    LAS float* ydst = (cg == 0) ? (ybuf + i) : ((LAS float*)(lds + 114688) + tid);
    f32x2 S[4];
    if (lat) { const float* s0 = P.in[3] + ((size_t)((b * 2 + dir) * 8 + h) * 64 + i) * 64 + 8 * cg; const f32x4 a = *(const f32x4*)s0, c = *(const f32x4*)(s0 + 4);
        S[0] = (f32x2){a[0], a[1]}; S[1] = (f32x2){a[2], a[3]}; S[2] = (f32x2){c[0], c[1]}; S[3] = (f32x2){c[2], c[3]}; }
    else {
#pragma unroll
        for (int q = 0; q < 4; ++q) S[q] = (f32x2){0.f, 0.f}; }
    const f32x4 kk4 = *(const f32x4*)(P.in[26] + h * 64 + jc), ka4 = *(const f32x4*)(P.in[27] + h * 64 + jc);
    u32x2 gr, gk, gv, gu, ga;
    auto gload = [&](int ci) { const int pos = 32 * ci + tt_s; const int t = dir ? L - 1 - pos : pos; const size_t o = (size_t)(rowbase + t) * 512 + h * 64 + jc;
        gr = *(const u32x2*)(rB + o); gk = *(const u32x2*)(kB + o); gv = *(const u32x2*)(vB + o); gu = *(const u32x2*)(uB + o); ga = *(const u32x2*)(aB + o); };
    auto pstore = [&](int bi) { LAS float* bb = buf + bi * 12288 + tt_s * 64 + jc;
        const float k[4] = {bf_lo(gk.x), bf_hi(gk.x), bf_lo(gk.y), bf_hi(gk.y)}, a[4] = {bf_lo(ga.x), bf_hi(ga.x), bf_lo(ga.y), bf_hi(ga.y)}, u[4] = {bf_lo(gu.x), bf_hi(gu.x), bf_lo(gu.y), bf_hi(gu.y)};
        float kv[4]; float ss = 0.f;
#pragma unroll
        for (int j = 0; j < 4; ++j) { kv[j] = k[j] * kk4[j]; ss += kv[j] * kv[j]; }
        ss = sum16(ss);
        const float rn = 1.f / fmaxf(sqrtf(ss), 1e-12f);
        f32x4 w4, a4, b4, d4;
#pragma unroll
        for (int j = 0; j < 4; ++j) { const float kkn = kv[j] * rn; w4[j] = __expf(-u[j]); a4[j] = -kkn; b4[j] = kkn * a[j]; d4[j] = k[j] * (1.f + (a[j] - 1.f) * ka4[j]); }
        *(LAS f32x4*)(bb) = w4; *(LAS f32x4*)(bb + 2048) = a4; *(LAS f32x4*)(bb + 4096) = b4; *(LAS f32x4*)(bb + 6144) = d4;
        *(LAS f32x4*)(bb + 8192) = (f32x4){bf_lo(gr.x), bf_hi(gr.x), bf_lo(gr.y), bf_hi(gr.y)}; *(LAS f32x4*)(bb + 10240) = (f32x4){bf_lo(gv.x), bf_hi(gv.x), bf_lo(gv.y), bf_hi(gv.y)}; };
    const int nch = L >> 5;
    __syncthreads();
    gload(0); pstore(0);
    __syncthreads();
    for (int ci = 0; ci < nch; ++ci) {
        if (ci + 1 < nch) gload(ci + 1);
        const LAS float* bb = buf + (ci & 1) * 12288 + 8 * cg; const LAS float* bvv = buf + (ci & 1) * 12288 + 10240 + i;
        struct SV { f32x4 w0, w1, a0, a1, b0, b1, d0, d1, r0, r1; float vi; };
        auto ld = [&](int tt) { SV v; const LAS float* p = bb + tt * 64;
            v.w0 = *(const LAS f32x4*)(p); v.w1 = *(const LAS f32x4*)(p + 4); v.a0 = *(const LAS f32x4*)(p + 2048); v.a1 = *(const LAS f32x4*)(p + 2052);
            v.b0 = *(const LAS f32x4*)(p + 4096); v.b1 = *(const LAS f32x4*)(p + 4100); v.d0 = *(const LAS f32x4*)(p + 6144); v.d1 = *(const LAS f32x4*)(p + 6148);
            v.r0 = *(const LAS f32x4*)(p + 8192); v.r1 = *(const LAS f32x4*)(p + 8196); v.vi = bvv[tt * 64]; return v; };
        LAS float* ydc = ydst + ((cg == 0) ? (ci & 1) * 2048 : 0);
        SV cur = ld(0);
#pragma unroll 4
        for (int tt = 0; tt < 32; ++tt) {
            const SV nx = ld(tt < 31 ? tt + 1 : 31);
            const f32x2 A[4] = {{cur.a0[0], cur.a0[1]}, {cur.a0[2], cur.a0[3]}, {cur.a1[0], cur.a1[1]}, {cur.a1[2], cur.a1[3]}}, W[4] = {{cur.w0[0], cur.w0[1]}, {cur.w0[2], cur.w0[3]}, {cur.w1[0], cur.w1[1]}, {cur.w1[2], cur.w1[3]}};
            const f32x2 B[4] = {{cur.b0[0], cur.b0[1]}, {cur.b0[2], cur.b0[3]}, {cur.b1[0], cur.b1[1]}, {cur.b1[2], cur.b1[3]}}, D[4] = {{cur.d0[0], cur.d0[1]}, {cur.d0[2], cur.d0[3]}, {cur.d1[0], cur.d1[1]}, {cur.d1[2], cur.d1[3]}};
            const f32x2 R[4] = {{cur.r0[0], cur.r0[1]}, {cur.r0[2], cur.r0[3]}, {cur.r1[0], cur.r1[1]}, {cur.r1[2], cur.r1[3]}};
            const f32x2 t2 = (S[1] * A[1] + S[0] * A[0]) + (S[3] * A[3] + S[2] * A[2]);
            const float sa = sum8(t2[0] + t2[1]);
            const f32x2 sv = {sa, sa}, vv = {cur.vi, cur.vi};
#pragma unroll
            for (int q = 0; q < 4; ++q) { const f32x2 T = S[q] * W[q] + vv * D[q]; S[q] = sv * B[q] + T; }
            const f32x2 u2 = (S[1] * R[1] + S[0] * R[0]) + (S[3] * R[3] + S[2] * R[2]);
            const float yv = sum8(u2[0] + u2[1]);
            ydc[tt * 64] = yv;
            cur = nx; }
        if (ci + 1 < nch) pstore((ci + 1) & 1);
        __syncthreads();
        { const int pos = 32 * ci + tt_s; const int t = dir ? L - 1 - pos : pos; const f32x4 yv = *(const LAS f32x4*)(ybuf + (ci & 1) * 2048 + tt_s * 64 + jc);
            u32x2 w; w.x = pk2(yv[0], yv[1]); w.y = pk2(yv[2], yv[3]); *(u32x2*)(y + (size_t)(rowbase + t) * 512 + h * 64 + jc) = w; }
    }
    if (!lat) { float* op = P.out + OUT_RWKV + ((size_t)((b * 2 + dir) * 8 + h) * 64 + i) * 64 + 8 * cg; *(f32x4*)op = (f32x4){S[0][0], S[0][1], S[1][0], S[1][1]}; *(f32x4*)(op + 4) = (f32x4){S[2][0], S[2][1], S[3][0], S[3][1]}; }
}
DI void rwkv_scan_half_item(KParams& P, int item, LAS unsigned char* lds, int tid) {
    const int b = item >> 5, h = (item >> 2) & 7, dir = (item >> 1) & 1, half = item & 1; const int L = 2048, rowbase = MP_ + b * 2048, nch = 64;
    LAS float* buf = (LAS float*)lds;
    LAS float* ybuf = (LAS float*)(lds + 98304);
    __syncthreads();
    if (tid >= 256) {
        const int lt = tid - 256, jc = (lt & 15) * 4;
        const bf16_t* rB = (const bf16_t*)(P.ws + A_R); const bf16_t* kB = (const bf16_t*)(P.ws + A_K); const bf16_t* vB = (const bf16_t*)(P.ws + A_V);
        const bf16_t* uB = (const bf16_t*)(P.ws + (dir ? A_U1 : A_U0)); const bf16_t* aB = (const bf16_t*)(P.ws + (dir ? A_A1 : A_A0)); bf16_t* y = (bf16_t*)(P.ws + A_Y) + (dir ? (size_t)M_ * 512 : 0);
        const f32x4 kk4 = *(const f32x4*)(P.in[26] + h * 64 + jc), ka4 = *(const f32x4*)(P.in[27] + h * 64 + jc);
        auto stage = [&](int ci) {
            u32x2 gr[2], gk[2], gv[2], gu[2], ga[2];
#pragma unroll
            for (int g = 0; g < 2; ++g) { const int pos = 32 * ci + (lt >> 4) + 16 * g; const int t = dir ? L - 1 - pos : pos; const size_t o = (size_t)(rowbase + t) * 512 + h * 64 + jc;
                gr[g] = *(const u32x2*)(rB + o); gk[g] = *(const u32x2*)(kB + o); gv[g] = *(const u32x2*)(vB + o); gu[g] = *(const u32x2*)(uB + o); ga[g] = *(const u32x2*)(aB + o); }
#pragma unroll
            for (int g = 0; g < 2; ++g) { LAS float* bb = buf + (ci & 1) * 12288 + ((lt >> 4) + 16 * g) * 64 + jc;
                const float k[4] = {bf_lo(gk[g].x), bf_hi(gk[g].x), bf_lo(gk[g].y), bf_hi(gk[g].y)}, a[4] = {bf_lo(ga[g].x), bf_hi(ga[g].x), bf_lo(ga[g].y), bf_hi(ga[g].y)}, u[4] = {bf_lo(gu[g].x), bf_hi(gu[g].x), bf_lo(gu[g].y), bf_hi(gu[g].y)};
                float kv[4]; float ss = 0.f;
#pragma unroll
                for (int j = 0; j < 4; ++j) { kv[j] = k[j] * kk4[j]; ss += kv[j] * kv[j]; }
                ss = sum16(ss);
                const float rn = 1.f / fmaxf(sqrtf(ss), 1e-12f);
                f32x4 w4, a4, b4, d4;
#pragma unroll
                for (int j = 0; j < 4; ++j) { const float kkn = kv[j] * rn; w4[j] = __expf(-u[j]); a4[j] = -kkn; b4[j] = kkn * a[j]; d4[j] = k[j] * (1.f + (a[j] - 1.f) * ka4[j]); }
                *(LAS f32x4*)(bb) = w4; *(LAS f32x4*)(bb + 2048) = a4; *(LAS f32x4*)(bb + 4096) = b4; *(LAS f32x4*)(bb + 6144) = d4;
                *(LAS f32x4*)(bb + 8192) = (f32x4){bf_lo(gr[g].x), bf_hi(gr[g].x), bf_lo(gr[g].y), bf_hi(gr[g].y)}; *(LAS f32x4*)(bb + 10240) = (f32x4){bf_lo(gv[g].x), bf_hi(gv[g].x), bf_lo(gv[g].y), bf_hi(gv[g].y)}; } };
        auto flush = [&](int ci) { const int tok = lt >> 3, r4 = (lt & 7) * 4; const int pos = 32 * ci + tok; const int t = dir ? L - 1 - pos : pos;
            const f32x4 yv = *(const LAS f32x4*)(ybuf + (ci & 1) * 1024 + tok * 32 + r4); u32x2 w; w.x = pk2(yv[0], yv[1]); w.y = pk2(yv[2], yv[3]);
            *(u32x2*)(y + (size_t)(rowbase + t) * 512 + h * 64 + 32 * half + r4) = w; };
        stage(0);
        __syncthreads();
        for (int ci = 0; ci < nch; ++ci) {
            if (ci + 1 < nch) stage(ci + 1);
            if (ci >= 1) flush(ci - 1);
            __syncthreads();
        }
        flush(nch - 1);
    } else {
        const int il = tid >> 3, cg = tid & 7, i = 32 * half + il;
        f32x2 S[4];
        { const float* s0 = P.in[3] + ((size_t)((b * 2 + dir) * 8 + h) * 64 + i) * 64 + 8 * cg; const f32x4 a = *(const f32x4*)s0, c = *(const f32x4*)(s0 + 4);
          S[0] = (f32x2){a[0], a[1]}; S[1] = (f32x2){a[2], a[3]}; S[2] = (f32x2){c[0], c[1]}; S[3] = (f32x2){c[2], c[3]}; }
        LAS float* ydst = (cg == 0) ? (ybuf + il) : ((LAS float*)(lds + 106496) + tid);
        __syncthreads();
        for (int ci = 0; ci < nch; ++ci) {
            const LAS float* bb = buf + (ci & 1) * 12288 + 8 * cg; const LAS float* bvv = buf + (ci & 1) * 12288 + 10240 + i;
            LAS float* ydc = ydst + ((cg == 0) ? (ci & 1) * 1024 : 0);
            struct SV { f32x4 w0, w1, a0, a1, b0, b1, d0, d1, r0, r1; float vi; };
            auto ld = [&](int tt) { SV v; const LAS float* p = bb + tt * 64;
                v.w0 = *(const LAS f32x4*)(p); v.w1 = *(const LAS f32x4*)(p + 4); v.a0 = *(const LAS f32x4*)(p + 2048); v.a1 = *(const LAS f32x4*)(p + 2052);
                v.b0 = *(const LAS f32x4*)(p + 4096); v.b1 = *(const LAS f32x4*)(p + 4100); v.d0 = *(const LAS f32x4*)(p + 6144); v.d1 = *(const LAS f32x4*)(p + 6148);
                v.r0 = *(const LAS f32x4*)(p + 8192); v.r1 = *(const LAS f32x4*)(p + 8196); v.vi = bvv[tt * 64]; return v; };
            SV cur = ld(0);
#pragma unroll 4
            for (int tt = 0; tt < 32; ++tt) {
                const SV nx = ld(tt < 31 ? tt + 1 : 31);
                const f32x2 A[4] = {{cur.a0[0], cur.a0[1]}, {cur.a0[2], cur.a0[3]}, {cur.a1[0], cur.a1[1]}, {cur.a1[2], cur.a1[3]}}, W[4] = {{cur.w0[0], cur.w0[1]}, {cur.w0[2], cur.w0[3]}, {cur.w1[0], cur.w1[1]}, {cur.w1[2], cur.w1[3]}};
                const f32x2 B[4] = {{cur.b0[0], cur.b0[1]}, {cur.b0[2], cur.b0[3]}, {cur.b1[0], cur.b1[1]}, {cur.b1[2], cur.b1[3]}}, D[4] = {{cur.d0[0], cur.d0[1]}, {cur.d0[2], cur.d0[3]}, {cur.d1[0], cur.d1[1]}, {cur.d1[2], cur.d1[3]}};
                const f32x2 R[4] = {{cur.r0[0], cur.r0[1]}, {cur.r0[2], cur.r0[3]}, {cur.r1[0], cur.r1[1]}, {cur.r1[2], cur.r1[3]}};
                const f32x2 t2 = (S[1] * A[1] + S[0] * A[0]) + (S[3] * A[3] + S[2] * A[2]);
                const float sa = sum8(t2[0] + t2[1]);
                const f32x2 sv = {sa, sa}, vv = {cur.vi, cur.vi};
#pragma unroll
                for (int q = 0; q < 4; ++q) { const f32x2 T = S[q] * W[q] + vv * D[q]; S[q] = sv * B[q] + T; }
                const f32x2 u2 = (S[1] * R[1] + S[0] * R[0]) + (S[3] * R[3] + S[2] * R[2]);
                const float yv = sum8(u2[0] + u2[1]);
                ydc[tt * 32] = yv;
                cur = nx; }
            __syncthreads();
        }
    }
}
DI void rwkv_post_phase(KParams& P, int tid) {
    const int wid = tid >> 6, lane = tid & 63;
    const bf16_t* rB = (const bf16_t*)(P.ws + A_R); const bf16_t* kB = (const bf16_t*)(P.ws + A_K); const bf16_t* vB = (const bf16_t*)(P.ws + A_V); const bf16_t* gB = (const bf16_t*)(P.ws + A_G);
    const bf16_t* yA = (const bf16_t*)(P.ws + A_Y); const bf16_t* yBk = yA + (size_t)M_ * 512; bf16_t* mix = (bf16_t*)(P.ws + WS_H);
    const int c = 8 * lane;
    f32x4 lw[2], lb[2], rk[2];
#pragma unroll
    for (int q = 0; q < 2; ++q) { lw[q] = *(const f32x4*)(P.in[29] + c + 4 * q); lb[q] = *(const f32x4*)(P.in[30] + c + 4 * q); rk[q] = *(const f32x4*)(P.in[28] + c + 4 * q); }
    for (int row = blockIdx.x * 8 + wid; row < M_; row += gridDim.x * 8) { const size_t o = (size_t)row * 512 + c;
        const u32x4 ya = *(const u32x4*)(yA + o), yb = *(const u32x4*)(yBk + o);
        const u32x4 ru = *(const u32x4*)(rB + o), ku = *(const u32x4*)(kB + o), vu = *(const u32x4*)(vB + o), gu = *(const u32x4*)(gB + o);
        float yy[8]; float r[8], k[8], v[8], g[8];
#pragma unroll
        for (int q = 0; q < 4; ++q) { yy[2 * q] = bf_lo(ya[q]) + bf_lo(yb[q]); yy[2 * q + 1] = bf_hi(ya[q]) + bf_hi(yb[q]); }
#pragma unroll
        for (int q = 0; q < 4; ++q) { r[2 * q] = bf_lo(ru[q]); r[2 * q + 1] = bf_hi(ru[q]); k[2 * q] = bf_lo(ku[q]); k[2 * q + 1] = bf_hi(ku[q]); v[2 * q] = bf_lo(vu[q]); v[2 * q + 1] = bf_hi(vu[q]); g[2 * q] = bf_lo(gu[q]); g[2 * q + 1] = bf_hi(gu[q]); }
        float s = 0.f, bs = 0.f;
#pragma unroll
        for (int q = 0; q < 8; ++q) { s += yy[q]; bs += r[q] * k[q] * rk[q >> 2][q & 3]; }
        s = sum8(s); bs = sum8(bs); const float mu = s * (1.f / 64.f); float vs = 0.f;
#pragma unroll
        for (int q = 0; q < 8; ++q) { const float d = yy[q] - mu; vs += d * d; }
        vs = sum8(vs); const float rs = rsqrtf(vs * (1.f / 64.f) + 64e-5f);
        float o8[8];
#pragma unroll
        for (int q = 0; q < 8; ++q) o8[q] = ((yy[q] - mu) * rs * lw[q >> 2][q & 3] + lb[q >> 2][q & 3] + bs * v[q]) * g[q];
        u32x4 w; w.x = pk2(o8[0], o8[1]); w.y = pk2(o8[2], o8[3]); w.z = pk2(o8[4], o8[5]); w.w = pk2(o8[6], o8[7]);
        *(u32x4*)(mix + (size_t)row * D_ + 512 + c) = w; }
}
#define XB_TMO      128
#define XB_XCNT(j)  (256  + 64 * (j))
#define XB_XSUB(j)  (1280 + 64 * (j))
#define XB_XGEN(j)  (2304 + 64 * (j))
#define XB_TOP      3328
#define XB_TOPGEN   3392
#define XCD_BAR_WORDS 3456
#define XB_SPIN_CAP (1u << 18)

__device__ __forceinline__ unsigned xb_ld(unsigned* p)              { return __hip_atomic_load(p, __ATOMIC_RELAXED, __HIP_MEMORY_SCOPE_AGENT); }
__device__ __forceinline__ unsigned xb_add(unsigned* p, unsigned v) { return __hip_atomic_fetch_add(p, v, __ATOMIC_RELAXED, __HIP_MEMORY_SCOPE_AGENT); }
__device__ __forceinline__ unsigned xb_xcc_id() { return (unsigned)__builtin_amdgcn_s_getreg((3 << 11) | 20) & 0xFu; }
#define XB_SPIN(cond, bar) do { unsigned _sp = 0; while (cond) { __builtin_amdgcn_s_sleep(1); \
    if ((++_sp & 255u) == 0u) { if (xb_ld(&(bar)[XB_TMO])) break; if (_sp > XB_SPIN_CAP) { atomicAdd(&(bar)[XB_TMO], 1u); break; } } } } while (0)

struct XcdBarrier {
    unsigned* bar; unsigned x;
    volatile LAS unsigned* st;
};

__device__ __forceinline__ XcdBarrier xcd_barrier_post(unsigned* bar, volatile LAS unsigned* st) {
    XcdBarrier b; b.bar = bar; b.x = xb_xcc_id(); b.st = st;
    if (threadIdx.x == 0) (void)xb_add(&bar[XB_XCNT(b.x)], 1u);
    return b;
}
__device__ __forceinline__ void xcd_barrier_complete(unsigned* bar, unsigned x, unsigned& nloc, unsigned& nx) {
    const unsigned G = gridDim.x * gridDim.y * gridDim.z;
    unsigned sum, cnt, mine, sp = 0u;
    for (;;) {
        sum = 0u; cnt = 0u; mine = 0u;
#pragma unroll
        for (unsigned j = 0; j < 16; ++j) { const unsigned c = xb_ld(&bar[XB_XCNT(j)]); sum += c; cnt += (c > 0u) ? 1u : 0u; mine = (j == x) ? c : mine; }
        if (sum == G) break;
        __builtin_amdgcn_s_sleep(1);
        if ((++sp & 255u) == 0u) { if (xb_ld(&bar[XB_TMO])) break; if (sp > XB_SPIN_CAP) { atomicAdd(&bar[XB_TMO], 1u); break; } }
    }
    nloc = mine > 0u ? mine : 1u; nx = cnt > 0u ? cnt : 1u;
}

__device__ __forceinline__ void xcd_barrier(const XcdBarrier& b) {
    asm volatile("s_waitcnt vmcnt(0)" ::: "memory");
    __syncthreads();
    if (threadIdx.x == 0) {
        unsigned* bar = b.bar;
        __builtin_amdgcn_s_waitcnt(0);
        unsigned nloc = b.st[0], nx = b.st[1];
        if (nloc == 0u) { xcd_barrier_complete(bar, b.x, nloc, nx); b.st[0] = nloc; b.st[1] = nx; }
        const unsigned old = xb_add(&bar[XB_XSUB(b.x)], 1u);
        const unsigned gen = old / nloc;
        if (old + 1u == (gen + 1u) * nloc) {
            __builtin_amdgcn_fence(__ATOMIC_RELEASE, "agent");
            asm volatile("s_waitcnt vmcnt(0)" ::: "memory");
            const unsigned og = xb_add(&bar[XB_TOP], 1u);
            const unsigned tg = og / nx;
            if (og + 1u == (tg + 1u) * nx) xb_add(&bar[XB_TOPGEN], 1u);
            else XB_SPIN(xb_ld(&bar[XB_TOPGEN]) == tg, bar);
            __builtin_amdgcn_fence(__ATOMIC_ACQUIRE, "agent");
            xb_add(&bar[XB_XGEN(b.x)], 1u);
            asm volatile("s_waitcnt vmcnt(0)" ::: "memory");
        } else {
            XB_SPIN(xb_ld(&bar[XB_XGEN(b.x)]) == gen, bar);
            __builtin_amdgcn_fence(__ATOMIC_ACQUIRE, "agent");
            asm volatile("s_waitcnt vmcnt(0)" ::: "memory");
        }
    }
    __syncthreads();
}


DI int next_item(unsigned* c, LAS int* slot, int tid) { __syncthreads(); if (tid == 0) *slot = (int)atomicAdd(c, 1u); __syncthreads(); return *slot; }

template <int NN, class Epi> DI void run_gemm(LAS unsigned char* lds, const bf16_t* A, const bf16_t* Bt, int N, int K, const Epi& E) {
    N = launder_s(N); K = launder_s(K);
    pg8::FastOrder<NN> S; S.init(M_, N, (int)gridDim.x, (int)blockIdx.x);
    pg8::gemm_phase<Epi, pg8::FastOrder<NN>>(lds, pg8::Gemm{A, Bt, M_, N, K}, S, E);
    __syncthreads();
}

__global__ void __launch_bounds__(512) fwd_kernel(Params Pk) {
#define P (kparams())
    extern __shared__ __attribute__((aligned(16))) unsigned char smem[];
    LAS unsigned char* lds = (LAS unsigned char*)smem;
    LAS int* slot = (LAS int*)(lds + MISC_OFF + 8064);
#define ws (P.ws)
#define tid (launder_v((int)threadIdx.x))
#define ctr ((unsigned*)(ws + WS_CTR))
#define rope ((float*)(ws + WS_ROPE))
#define mod ((float*)(ws + WS_MOD))
#define XRES (P.out)
#define hb ((bf16_t*)(ws + WS_H))
#define act ((bf16_t*)(ws + A_ACT))
    if (blockIdx.x == 0) { if (threadIdx.x < 16) ctr[threadIdx.x] = 0u; unsigned* bz = (unsigned*)(ws + WS_BAR); for (int i = threadIdx.x; i < XCD_BAR_WORDS; i += 512) bz[i] = 0u; }
    if (blockIdx.x == gridDim.x - 1) for (int e = tid; e < 1024; e += 512) { const int pos = e >> 4, i = e & 15; const float inv = powf(10000.f, -(float)i / 16.f); const float ang = (float)pos * inv; rope[2 * e] = cosf(ang); rope[2 * e + 1] = sinf(ang); }
    { bf16_t* ck = (bf16_t*)(ws + WS_CK); bf16_t* cv = (bf16_t*)(ws + WS_CV); const float* sk = P.in[7]; const float* sv = P.in[8];
      for (int i = blockIdx.x * 512 + threadIdx.x; i < 131072; i += gridDim.x * 512) { const f32x4 a = *(const f32x4*)(sk + 4 * (size_t)i), c = *(const f32x4*)(sv + 4 * (size_t)i); u32x2 w; w.x = pk2(a[0], a[1]); w.y = pk2(a[2], a[3]); *(u32x2*)(ck + 4 * (size_t)i) = w; w.x = pk2(c[0], c[1]); w.y = pk2(c[2], c[3]); *(u32x2*)(cv + 4 * (size_t)i) = w; } }
    mod_phase(P, lds, tid);
    convert_layer(P, 0, lds, tid, 63);
    cg::this_grid().sync();
    { volatile LAS unsigned* st_ = (volatile LAS unsigned*)(lds + MISC_OFF + 8072); if (threadIdx.x < 2) st_[threadIdx.x] = 0u; __syncthreads(); (void)xcd_barrier_post((unsigned*)(ws + WS_BAR), st_); }
#define GBAR() do { XcdBarrier b_; b_.bar = (unsigned*)(ws + WS_BAR); b_.x = xb_xcc_id(); b_.st = (volatile LAS unsigned*)(lds + MISC_OFF + 8072); xcd_barrier(b_); } while (0)
    { constexpr int l = 0;
#define modl (mod + (size_t)launder_s(l) * 9 * 9216)
#define ng (P.in[13] + (size_t)launder_s(l) * 3 * 1024)
        if (l == 1) convert_layer(P, 1, lds, tid, 42);
        norm_phase(l == 0 ? P.in[0] : XRES, l == 0 ? P.in[1] : XRES + (size_t)MP_ * D_, hb, ng, modl, 0, tid);
        GBAR();
        run_gemm<22>(lds, hb, (const bf16_t*)(ws + W_W1A), 2 * DFF_, D_, EpiSwiglu{act});
        GBAR();
        run_gemm<4>(lds, act, (const bf16_t*)(ws + W_W2A), D_, DFF_, EpiResid{l == 0 ? P.in[0] : XRES, l == 0 ? P.in[1] : XRES + (size_t)MP_ * D_, XRES, modl + 2 * 1024, 0.5f});
        GBAR();
        norm_phase(XRES, XRES + (size_t)MP_ * D_, hb, ng + 1024, modl, 3, tid);
        GBAR();
        if (l == 0) {
            run_gemm<13>(lds, hb, (const bf16_t*)(ws + W_WIN), 3328, D_, EpiInEven{ws, rope});
            GBAR();
            for (;;) { const int it = next_item(ctr + 0, slot, tid); if (it >= 640) break;
                if (it < 256) ret_item(P, it + 128, lds, tid); else if (it < 512) ret_state_item(P, it - 256, lds, tid); else ret_item(P, it - 512, lds, tid); }
            rwkv_shift_phase(P, tid);
            GBAR();
            run_gemm<10>(lds, (const bf16_t*)(ws + A_X), (const bf16_t*)(ws + W_WL), 2560, 256,
                     EpiLora{ws, P.in[21], P.in[23]});
            GBAR();
            for (;;) { const int it = next_item(ctr + 1, slot, tid); if (it >= 768 + 2880) break; if (it < 256) rwkv_scan_half_item(P, it, lds, tid); else if (it < 768) rwkv_scan_item(P, it - 128, lds, tid); else conv_l1_early_item(P, it - 768, lds, tid); }
            GBAR();
            rwkv_post_phase(P, tid);
            GBAR();
        } else {
            run_gemm<12>(lds, hb, (const bf16_t*)(ws + W_WIN), 3072, D_, EpiInOdd{ws, rope, P.in[36], P.in[33], P.in[34], P.out});
            GBAR();
            for (;;) { const int it = next_item(ctr + 2, slot, tid); if (it >= 1792) break;
                if (it < 512) attn_item(P, it, lds, tid); else if (it < 1024) mlstm_item(P, it - 256, lds, tid); else if (it < 1280) mlstm_state_item(P, it - 1024, lds, tid);
                else if (it < 1536) mlstm_item(P, it - 1280, lds, tid); else attn_item(P, 512 + it - 1536, lds, tid); }
            GBAR();
        }
        run_gemm<4>(lds, hb, (const bf16_t*)(ws + W_WOUT), D_, D_, EpiResid{XRES, XRES + (size_t)MP_ * D_, XRES, modl + 5 * 1024, 1.0f});
        GBAR();
        norm_phase(XRES, XRES + (size_t)MP_ * D_, hb, ng + 2048, modl, 6, tid);
        GBAR();
        run_gemm<22>(lds, hb, (const bf16_t*)(ws + W_W1B), 2 * DFF_, D_, EpiSwiglu{act});
        GBAR();
        run_gemm<4>(lds, act, (const bf16_t*)(ws + W_W2B), D_, DFF_, EpiResid{XRES, XRES + (size_t)MP_ * D_, XRES, modl + 8 * 1024, 0.5f});
        GBAR();
    }
    { constexpr int l = 1;
#define modl (mod + (size_t)launder_s(l) * 9 * 9216)
#define ng (P.in[13] + (size_t)launder_s(l) * 3 * 1024)
        if (l == 1) convert_layer(P, 1, lds, tid, 42);
        norm_phase(l == 0 ? P.in[0] : XRES, l == 0 ? P.in[1] : XRES + (size_t)MP_ * D_, hb, ng, modl, 0, tid);
        GBAR();
        run_gemm<22>(lds, hb, (const bf16_t*)(ws + W_W1A), 2 * DFF_, D_, EpiSwiglu{act});
        GBAR();
        run_gemm<4>(lds, act, (const bf16_t*)(ws + W_W2A), D_, DFF_, EpiResid{l == 0 ? P.in[0] : XRES, l == 0 ? P.in[1] : XRES + (size_t)MP_ * D_, XRES, modl + 2 * 1024, 0.5f});
        GBAR();
        norm_phase(XRES, XRES + (size_t)MP_ * D_, hb, ng + 1024, modl, 3, tid);
        GBAR();
        if (l == 0) {
            run_gemm<13>(lds, hb, (const bf16_t*)(ws + W_WIN), 3328, D_, EpiInEven{ws, rope});
            GBAR();
            for (;;) { const int it = next_item(ctr + 0, slot, tid); if (it >= 640) break;
                if (it < 256) ret_item(P, it + 128, lds, tid); else if (it < 512) ret_state_item(P, it - 256, lds, tid); else ret_item(P, it - 512, lds, tid); }
            rwkv_shift_phase(P, tid);
            GBAR();
            run_gemm<10>(lds, (const bf16_t*)(ws + A_X), (const bf16_t*)(ws + W_WL), 2560, 256,
                     EpiLora{ws, P.in[21], P.in[23]});
            GBAR();
            for (;;) { const int it = next_item(ctr + 1, slot, tid); if (it >= 768 + 2880) break; if (it < 256) rwkv_scan_half_item(P, it, lds, tid); else if (it < 768) rwkv_scan_item(P, it - 128, lds, tid); else conv_l1_early_item(P, it - 768, lds, tid); }
            GBAR();
            rwkv_post_phase(P, tid);
            GBAR();
        } else {
            run_gemm<12>(lds, hb, (const bf16_t*)(ws + W_WIN), 3072, D_, EpiInOdd{ws, rope, P.in[36], P.in[33], P.in[34], P.out});
            GBAR();
            for (;;) { const int it = next_item(ctr + 2, slot, tid); if (it >= 1792) break;
                if (it < 512) attn_item(P, it, lds, tid); else if (it < 1024) mlstm_item(P, it - 256, lds, tid); else if (it < 1280) mlstm_state_item(P, it - 1024, lds, tid);
                else if (it < 1536) mlstm_item(P, it - 1280, lds, tid); else attn_item(P, 512 + it - 1536, lds, tid); }
            GBAR();
        }
        run_gemm<4>(lds, hb, (const bf16_t*)(ws + W_WOUT), D_, D_, EpiResid{XRES, XRES + (size_t)MP_ * D_, XRES, modl + 5 * 1024, 1.0f});
        GBAR();
        norm_phase(XRES, XRES + (size_t)MP_ * D_, hb, ng + 2048, modl, 6, tid);
        GBAR();
        run_gemm<22>(lds, hb, (const bf16_t*)(ws + W_W1B), 2 * DFF_, D_, EpiSwiglu{act});
        GBAR();
        run_gemm<4>(lds, act, (const bf16_t*)(ws + W_W2B), D_, DFF_, EpiResid{XRES, XRES + (size_t)MP_ * D_, XRES, modl + 8 * 1024, 0.5f});
        GBAR();
    }
    final_norm_phase(XRES, P.in[37], tid);
#undef tid
#undef GBAR
#undef modl
#undef ng
#undef ctr
#undef rope
#undef mod
#undef XRES
#undef hb
#undef act
#undef ws
#undef P
}

extern "C" void kernel_launch(void* const* d_in, const int* in_sizes, int n_in, void* d_out, int out_size, void* d_ws, size_t ws_size, hipStream_t stream) {
    static int grid_blocks = 0;
    if (grid_blocks == 0) {
        if (n_in != 38 || ws_size < WS_NEED) { fprintf(stderr, "kernel_launch: need 38 inputs and %zu bytes of workspace, got %d / %zu\n", (size_t)WS_NEED, n_in, ws_size); grid_blocks = -1; return; }
        int dev = 0, cus = 0, per_cu = 0;
        hipGetDevice(&dev); hipDeviceGetAttribute(&cus, hipDeviceAttributeMultiprocessorCount, dev);
        if (hipFuncSetAttribute((const void*)fwd_kernel, hipFuncAttributeMaxDynamicSharedMemorySize, LDS_BYTES) != hipSuccess) { fprintf(stderr, "kernel_launch: hipFuncSetAttribute failed\n"); grid_blocks = -1; return; }
        if (hipOccupancyMaxActiveBlocksPerMultiprocessor(&per_cu, (const void*)fwd_kernel, 512, LDS_BYTES) != hipSuccess || per_cu < 1) { fprintf(stderr, "kernel_launch: occupancy query failed (%d)\n", per_cu); grid_blocks = -1; return; }
        grid_blocks = cus * per_cu;
    }
    if (grid_blocks < 0) return;
    Params p{};
    for (int i = 0; i < 38; ++i) p.in[i] = (const float*)d_in[i];
    p.out = (float*)d_out; p.ws = (unsigned char*)d_ws;
    void* args[] = {&p};
    hipError_t e = hipLaunchCooperativeKernel((const void*)fwd_kernel, dim3(grid_blocks), dim3(512), args, LDS_BYTES, stream);
    if (e != hipSuccess) fprintf(stderr, "cooperative launch failed: %s (grid %d)\n", hipGetErrorString(e), grid_blocks);
}
```

```cpp
#include <hip/hip_runtime.h>
#include <hip/hip_cooperative_groups.h>
#include <cstdio>
namespace cg = cooperative_groups;

#define DI __device__ __forceinline__
#define LAS __attribute__((address_space(3)))
typedef unsigned short bf16_t;
typedef short s16x4 __attribute__((ext_vector_type(4)));
typedef float f32x2 __attribute__((ext_vector_type(2)));
typedef unsigned u32x2 __attribute__((ext_vector_type(2)));
typedef __bf16 bf2_t __attribute__((ext_vector_type(2)));

constexpr int M_ = 24576, MP_ = 8192, D_ = 1024, DFF_ = 2816;
constexpr int LDS_BYTES = 139264;
constexpr int MISC_OFF = 131072;

DI unsigned pk2(float a, float b) { f32x2 v = {a, b}; bf2_t r = __builtin_convertvector(v, bf2_t); return __builtin_bit_cast(unsigned, r); }
DI float bf_lo(unsigned u) { return __uint_as_float(u << 16); }
DI float bf_hi(unsigned u) { return __uint_as_float(u & 0xffff0000u); }
DI float bf2f(bf16_t h) { return __uint_as_float(((unsigned)h) << 16); }
DI float silu_f(float x) { return x * __builtin_amdgcn_rcpf(1.f + __expf(-x)); }
DI float sigmoid_f(float x) { return __builtin_amdgcn_rcpf(1.f + __expf(-x)); }
DI float softplus_f(float z) { return fmaxf(z, 0.f) + __logf(1.f + __expf(-fabsf(z))); }
DI float wave_sum(float v) { v += __shfl_xor(v, 32); v += __shfl_xor(v, 16); v += __shfl_xor(v, 8); v += __shfl_xor(v, 4); v += __shfl_xor(v, 2); v += __shfl_xor(v, 1); return v; }
DI float fq_sum(float v) { unsigned u = __float_as_uint(v); const auto a = __builtin_amdgcn_permlane16_swap(u, u, false, false); v = __uint_as_float(a[0]) + __uint_as_float(a[1]);
    u = __float_as_uint(v); const auto b = __builtin_amdgcn_permlane32_swap(u, u, false, false); return __uint_as_float(b[0]) + __uint_as_float(b[1]); }
DI float fq_max(float v) { unsigned u = __float_as_uint(v); const auto a = __builtin_amdgcn_permlane16_swap(u, u, false, false); v = fmaxf(__uint_as_float(a[0]), __uint_as_float(a[1]));
    u = __float_as_uint(v); const auto b = __builtin_amdgcn_permlane32_swap(u, u, false, false); return fmaxf(__uint_as_float(b[0]), __uint_as_float(b[1])); }
DI int cond_of_row(int row) { return row < MP_ ? 0 : 1 + ((row - MP_) >> 11); }
DI int seqpos_of_row(int row) { return row < MP_ ? (row & 255) : ((row - MP_) & 2047); }

DI int launder_v(int v) { asm volatile("" : "+v"(v)); return v; }
DI int launder_s(int v) { asm volatile("" : "+s"(v)); return v; }
struct Params { const float* in[38]; float* out; unsigned char* ws; };

typedef __attribute__((address_space(4))) const Params KParams;
DI KParams& kparams() { KParams* p = (KParams*)__builtin_amdgcn_kernarg_segment_ptr(); asm volatile("" : "+s"(p)); return *p; }
constexpr size_t WS_CTR = 0, WS_ROPE = 256, WS_MOD = 16384, WS_BAR = 786432, WS_W = 1048576;
constexpr size_t W_W1A = WS_W, W_W1B = W_W1A + 11534336, W_W2A = W_W1B + 11534336, W_W2B = W_W2A + 5767168, W_WIN = W_W2B + 5767168,
                 W_WOUT = W_WIN + 6815744, W_WL = W_WOUT + 2097152, WS_H = W_WL + 1310720, WS_AR = WS_H + 50331648;
constexpr size_t SZ512 = (size_t)M_ * 512 * 2;
constexpr size_t A_R = WS_AR, A_K = A_R + SZ512, A_V = A_K + SZ512, A_X = A_V + SZ512, A_Z = A_X + (size_t)M_ * 256 * 2;
constexpr size_t A_QA = A_Z, A_KA = A_QA + (size_t)M_ * 256 * 2, A_VA = A_KA + (size_t)M_ * 256 * 2, A_GA = A_VA + SZ512, A_PB = A_GA + SZ512;
constexpr size_t A_U0 = A_Z, A_U1 = A_U0 + SZ512, A_A0 = A_U1 + SZ512, A_A1 = A_A0 + SZ512, A_G = A_A1 + SZ512, A_Y = A_G + SZ512, A_END = A_Y + 2 * SZ512;
constexpr size_t O_QC = WS_AR, O_KC = O_QC + SZ512, O_VC = O_KC + SZ512, O_OC = O_VC + SZ512, O_QD = O_OC + SZ512,
                 O_KD = O_QD + SZ512, O_VD = O_KD + (size_t)M_ * 128 * 2, O_GT = O_VD + (size_t)M_ * 128 * 2;
constexpr size_t A_ACT = WS_AR;
constexpr size_t WS_CK = A_END, WS_CV = WS_CK + 1048576, WS_NEED = WS_CV + 1048576;
constexpr size_t OUT_RET = 25165824, OUT_RWKV = 27262976, OUT_MC = 29360128, OUT_MN = 33554432, OUT_MM = 33587200, OUT_CK = 33587456, OUT_CV = 34636032;
typedef short bf16x8 __attribute__((ext_vector_type(8)));
typedef float f32x4 __attribute__((ext_vector_type(4)));
typedef unsigned u32x4 __attribute__((ext_vector_type(4)));
namespace pg8 {
#define PG8_LAS __attribute__((address_space(3)))
typedef unsigned short bf16_t;
typedef short bf16x8 __attribute__((ext_vector_type(8)));
typedef float f32x4 __attribute__((ext_vector_type(4)));
typedef unsigned u32x4 __attribute__((ext_vector_type(4)));
constexpr int BM = 256, BK = 64, HALF = 128, HTB = HALF * BK * 2  , STAGE_BYTES = 8 * HTB, NXCD = 8, WGM = 8;

__host__ __device__ __forceinline__ int lds_byte(int r, int c) { const int st = (r >> 4) * 2 + (c >> 5), rr = r & 15, cc = c & 31, ob = rr * 64 + cc * 2; return st * 1024 + (ob ^ (((ob >> 9) & 1) << 5)); }
__host__ __device__ __forceinline__ void stage_rc(int b, int& R, int& C) { const int st = b / 1024, sb = b % 1024, swz = sb ^ (((sb >> 9) & 1) << 5); R = (st >> 1) * 16 + swz / 64; C = (st & 1) * 32 + (swz % 64) / 2; }
__host__ __device__ __forceinline__ int perm32(int rho) { const int n = rho >> 4, i = rho & 15; return 8 * (i >> 2) + 4 * n + (i & 3); }

struct Unit { int pm, pn; };
struct Gemm { const bf16_t* A; const bf16_t* Bt; int M, N, K; };

struct StaticOrder {
    int nM, nN, nwg, G, c;
    __host__ __device__ void init(int M, int N, int G_, int c_) { nM = M / BM; nN = N / BM; nwg = nM * nN; G = G_; c = c_; }
    __host__ __device__ bool next(int i, Unit& u) const {
        const long L = (long)i * G + c; if (L >= nwg) return false;
        int wgid = (int)L; { const int q = nwg / NXCD, r = nwg % NXCD, xcd = wgid % NXCD, off = wgid / NXCD; wgid = (xcd < r ? xcd * (q + 1) : r * (q + 1) + (xcd - r) * q) + off; }
        const int nig = WGM * nN, gid = wgid / nig, fm = gid * WGM, gsz = (nM - fm) < WGM ? (nM - fm) : WGM;
        u.pm = fm + ((wgid % nig) % gsz); u.pn = (wgid % nig) / gsz; return true;
    }
    __device__ __forceinline__ void a_ready(const Unit&) const {}
    __device__ __forceinline__ void done(const Unit&) const {}
};
template <int NN> struct FastOrder {
    int G, c;
    __device__ __forceinline__ void init(int, int, int G_, int c_) { G = G_; c = c_; }
    __device__ __forceinline__ bool next(int i, Unit& u) const {
        constexpr int nwg = 96 * NN, q = nwg / NXCD, r = nwg % NXCD, nig = WGM * NN;
        const int L = i * G + c; if (L >= nwg) return false;
        const int xcd = L & 7, off = L >> 3; const int wgid = (xcd < r ? xcd * (q + 1) : r * (q + 1) + (xcd - r) * q) + off;
        const int gid = wgid / nig, rem = wgid - gid * nig;
        u.pm = gid * WGM + (rem & 7); u.pn = rem >> 3; return true;
    }
    __device__ __forceinline__ void a_ready(const Unit&) const {}
    __device__ __forceinline__ void done(const Unit&) const {}
};
template <class Epi, class Sched>
__device__ __forceinline__ void gemm_phase(PG8_LAS unsigned char* lds, const Gemm g, const Sched& S, const Epi& E) {
    const int tid = launder_v((int)threadIdx.x), wid = __builtin_amdgcn_readfirstlane(tid >> 6), lane = tid & 63, wr = wid >> 2, wc = wid & 3, fr = lane & 15, fq = lane >> 4;
    const int K = g.K, nt = K / BK;
    unsigned voffA[2], voffB[2];
#pragma unroll
    for (int i = 0; i < 2; ++i) { int R, C; stage_rc(tid * 16 + i * 8192, R, C); const int Rb = Epi::PERM ? ((R & ~31) + perm32(R & 31)) : R;
        voffA[i] = (unsigned)(R * K + C) * 2u; voffB[i] = (unsigned)(Rb * K + C) * 2u; }
    const size_t kstep = (size_t)(BK * 2);
    const size_t hstep = (size_t)HALF * K * 2;
    const size_t tstep = 2 * hstep;
    const unsigned ldsw = (unsigned)wid * 1024u;
    const int aoff = lds_byte(wr * 64 + fr, fq * 8), boff = lds_byte(wc * 32 + fr, fq * 8);
#define PG8_SA(b, h) (((b) * 2 + (h)) * HTB)
#define PG8_SB(b, h) ((4 + (b) * 2 + (h)) * HTB)
#define PG8_STAGE(bufoff, gbase, voff) do { _Pragma("unroll") for (int _i = 0; _i < 2; ++_i) \
        __builtin_amdgcn_global_load_lds((const unsigned*)((const char*)(gbase) + (voff)[_i]), (PG8_LAS unsigned*)(lds + (bufoff) + ldsw + _i * 8192), 16, 0, 0); } while (0)
#define PG8_LDA(dst, b, h) do { _Pragma("unroll") for (int m = 0; m < 4; ++m) _Pragma("unroll") for (int k = 0; k < 2; ++k) dst[m][k] = *(const PG8_LAS bf16x8*)(lds + PG8_SA(b, h) + aoff + m * 2048 + k * 1024); } while (0)
#define PG8_LDB(dst, b, h) do { _Pragma("unroll") for (int n = 0; n < 2; ++n) _Pragma("unroll") for (int k = 0; k < 2; ++k) dst[n][k] = *(const PG8_LAS bf16x8*)(lds + PG8_SB(b, h) + boff + n * 2048 + k * 1024); } while (0)
#define PG8_MMA(ai, bj, At, Bt) do { __builtin_amdgcn_s_setprio(1); _Pragma("unroll") for (int m = 0; m < 4; ++m) _Pragma("unroll") for (int n = 0; n < 2; ++n) _Pragma("unroll") for (int k = 0; k < 2; ++k) \
        acc[ai][bj][m][n] = __builtin_amdgcn_mfma_f32_16x16x32_bf16(Bt[n][k], At[m][k], acc[ai][bj][m][n], 0, 0, 0); __builtin_amdgcn_s_setprio(0); } while (0)
#define PG8_WAIT_V(n) asm volatile("s_waitcnt vmcnt(" #n ")" ::: "memory")
#define PG8_WAIT_L(n) asm volatile("s_waitcnt lgkmcnt(" #n ")" ::: "memory")
#define PG8_BAR __builtin_amdgcn_s_barrier()
#define PG8_SCHED __builtin_amdgcn_sched_barrier(0)
    Unit cur, nxt; int ui = 0;
    if (!S.next(0, cur)) return;
    f32x4 acc[2][2][4][2];
#pragma unroll
    for (int a = 0; a < 2; ++a)
#pragma unroll
        for (int b = 0; b < 2; ++b)
#pragma unroll
            for (int m = 0; m < 4; ++m)
#pragma unroll
                for (int n = 0; n < 2; ++n) acc[a][b][m][n] = (f32x4){0.f, 0.f, 0.f, 0.f};
    bf16x8 At[4][2], B0[2][2], B1[2][2];
    const char* cA = (const char*)g.A + (size_t)cur.pm * tstep; const char* cB = (const char*)g.Bt + (size_t)cur.pn * tstep;
    S.a_ready(cur);
    PG8_STAGE(PG8_SB(0, 0), cB, voffB); PG8_STAGE(PG8_SA(0, 0), cA, voffA); PG8_STAGE(PG8_SB(0, 1), cB + hstep, voffB); PG8_STAGE(PG8_SA(0, 1), cA + hstep, voffA);
    if (wr == 1) PG8_BAR;
    PG8_WAIT_V(4); PG8_BAR;
    PG8_STAGE(PG8_SB(1, 0), cB + kstep, voffB); PG8_STAGE(PG8_SA(1, 0), cA + kstep, voffA); PG8_STAGE(PG8_SB(1, 1), cB + hstep + kstep, voffB);
    PG8_WAIT_V(6); PG8_BAR;
    for (;;) {
        const bool has_next = S.next(ui + 1, nxt);
        const char* nA = has_next ? (const char*)g.A + (size_t)nxt.pm * tstep : cA; const char* nB = has_next ? (const char*)g.Bt + (size_t)nxt.pn * tstep : cB;
        for (int t = 0; t < nt; t += 2) {
            const bool last = (t == nt - 2);
            const char* a1 = cA + (size_t)(t + 1) * kstep;
            const char* a2 = last ? nA : cA + (size_t)(t + 2) * kstep; const char* b2 = last ? nB : cB + (size_t)(t + 2) * kstep;
            const char* a3 = a2 + kstep; const char* b3 = b2 + kstep;
            if (last && has_next) S.a_ready(nxt);
            PG8_LDB(B0, 0, 0); PG8_SCHED; PG8_LDA(At, 0, 0); PG8_STAGE(PG8_SA(1, 1), a1 + hstep, voffA);
            PG8_WAIT_L(8); PG8_BAR; PG8_WAIT_L(0); PG8_MMA(0, 0, At, B0); PG8_BAR; PG8_SCHED;
            PG8_LDB(B1, 0, 1); PG8_STAGE(PG8_SB(0, 0), b2, voffB);
            PG8_BAR; PG8_WAIT_L(0); PG8_MMA(0, 1, At, B1); PG8_BAR;
            PG8_LDA(At, 0, 1); PG8_STAGE(PG8_SA(0, 0), a2, voffA);
            PG8_BAR; PG8_WAIT_L(0); PG8_MMA(1, 0, At, B0); PG8_BAR; PG8_SCHED;
            PG8_STAGE(PG8_SB(0, 1), b2 + hstep, voffB);
            PG8_WAIT_V(6); PG8_BAR; PG8_MMA(1, 1, At, B1); PG8_BAR;
            PG8_LDB(B0, 1, 0); PG8_SCHED; PG8_LDA(At, 1, 0); PG8_STAGE(PG8_SA(0, 1), a2 + hstep, voffA);
            PG8_WAIT_L(8); PG8_BAR; PG8_WAIT_L(0); PG8_MMA(0, 0, At, B0); PG8_BAR; PG8_SCHED;
            PG8_LDB(B1, 1, 1); PG8_STAGE(PG8_SB(1, 0), b3, voffB);
            PG8_BAR; PG8_WAIT_L(0); PG8_MMA(0, 1, At, B1); PG8_BAR;
            PG8_LDA(At, 1, 1); PG8_STAGE(PG8_SA(1, 0), a3, voffA);
            PG8_BAR; PG8_WAIT_L(0); PG8_MMA(1, 0, At, B0); PG8_BAR; PG8_SCHED;
            PG8_STAGE(PG8_SB(1, 1), b3 + hstep, voffB);
            PG8_WAIT_V(6); PG8_BAR; PG8_MMA(1, 1, At, B1); PG8_BAR;
        }
        if constexpr (!Epi::AFTER_DRAIN) { E(acc, cur, wr, wc, fr, fq); S.done(cur); }
        if (!has_next) break;
#pragma unroll
        for (int a = 0; a < 2; ++a)
#pragma unroll
            for (int b = 0; b < 2; ++b)
#pragma unroll
                for (int m = 0; m < 4; ++m)
#pragma unroll
                    for (int n = 0; n < 2; ++n) acc[a][b][m][n] = (f32x4){0.f, 0.f, 0.f, 0.f};
        cur = nxt; cA = nA; cB = nB; ++ui;
    }
    PG8_WAIT_V(0);
    if (wr == 0) PG8_BAR;
    PG8_BAR;
    if constexpr (Epi::AFTER_DRAIN) { E.fused(acc, cur, wr, wc, fr, fq, lds, wid, lane); S.done(cur); }
#undef PG8_SA
#undef PG8_SB
#undef PG8_STAGE
#undef PG8_LDA
#undef PG8_LDB
#undef PG8_MMA
#undef PG8_WAIT_V
#undef PG8_WAIT_L
#undef PG8_BAR
#undef PG8_SCHED
}
}
using pg8::Unit;
typedef f32x4 Acc[2][2][4][2];

template <class F> DI void store_tile_bf16(const Acc& acc, bf16_t* dst, int ld, int coloff, const Unit& u, int wr, int wc, int fr, int fq, F f) {
    const int row0 = u.pm * 256 + wr * 64 + fr, col0 = coloff + wc * 32 + 4 * fq;
#pragma unroll
    for (int ai = 0; ai < 2; ++ai)
#pragma unroll
        for (int m = 0; m < 4; ++m) { bf16_t* rp = dst + (size_t)(row0 + ai * 128 + m * 16) * ld + col0;
#pragma unroll
            for (int bj = 0; bj < 2; ++bj)
#pragma unroll
                for (int n = 0; n < 2; ++n) { const f32x4 v = acc[ai][bj][m][n]; u32x2 w; w.x = pk2(f(v[0]), f(v[1])); w.y = pk2(f(v[2]), f(v[3])); *(u32x2*)(rp + bj * 128 + n * 16) = w; } }
}

struct EpiSwiglu {
    static constexpr bool PERM = false, AFTER_DRAIN = false;
    bf16_t* act;
    DI void operator()(const Acc& acc, const Unit& u, int wr, int wc, int fr, int fq) const {
        const int row0 = u.pm * 256 + wr * 64 + fr, col0 = u.pn * 128 + wc * 32 + 4 * fq;
#pragma unroll
        for (int ai = 0; ai < 2; ++ai)
#pragma unroll
            for (int m = 0; m < 4; ++m) { bf16_t* rp = act + (size_t)(row0 + ai * 128 + m * 16) * DFF_ + col0;
#pragma unroll
                for (int n = 0; n < 2; ++n) { const f32x4 g = acc[ai][0][m][n], up = acc[ai][1][m][n]; u32x2 w;
                    w.x = pk2(silu_f(g[0]) * up[0], silu_f(g[1]) * up[1]); w.y = pk2(silu_f(g[2]) * up[2], silu_f(g[3]) * up[3]); *(u32x2*)(rp + n * 16) = w; } }
    }
};

struct EpiResid {
    static constexpr bool PERM = false, AFTER_DRAIN = false;
    const float* xin_p; const float* xin_s; float* xout; const float* gate; float scale;
    DI void operator()(const Acc& acc, const Unit& u, int wr, int wc, int fr, int fq) const {
        const int row0 = u.pm * 256 + wr * 64 + fr, col0 = u.pn * 256 + wc * 32 + 4 * fq;
        const int ci = u.pm < 32 ? 0 : 1 + ((u.pm - 32) >> 3);
        const float* gt = gate + (size_t)ci * 9216 + col0;
        f32x4 gv[2][2];
#pragma unroll
        for (int bj = 0; bj < 2; ++bj)
#pragma unroll
            for (int n = 0; n < 2; ++n) gv[bj][n] = *(const f32x4*)(gt + bj * 128 + n * 16) * scale;
#pragma unroll
        for (int ai = 0; ai < 2; ++ai)
#pragma unroll
            for (int m = 0; m < 4; ++m) { const int row = row0 + ai * 128 + m * 16;
                const float* ip = (row < MP_ ? xin_p + (size_t)row * D_ : xin_s + (size_t)(row - MP_) * D_) + col0; float* op = xout + (size_t)row * D_ + col0;
#pragma unroll
                for (int bj = 0; bj < 2; ++bj)
#pragma unroll
                    for (int n = 0; n < 2; ++n) { const f32x4 xv = *(const f32x4*)(ip + bj * 128 + n * 16); *(f32x4*)(op + bj * 128 + n * 16) = xv + gv[bj][n] * acc[ai][bj][m][n]; } }
    }
};

DI void rope_pair(f32x4& x1, f32x4& x2, const float* tab, int pos, int fq) {
    const f32x4 t0 = *(const f32x4*)(tab + (pos * 16 + 4 * fq) * 2), t1 = *(const f32x4*)(tab + (pos * 16 + 4 * fq) * 2 + 4);
    const float c[4] = {t0[0], t0[2], t1[0], t1[2]}, s[4] = {t0[1], t0[3], t1[1], t1[3]};
#pragma unroll
    for (int j = 0; j < 4; ++j) { const float a = x1[j], b = x2[j]; x1[j] = a * c[j] - b * s[j]; x2[j] = a * s[j] + b * c[j]; }
}

struct EpiInEven {
    static constexpr bool PERM = false, AFTER_DRAIN = false;
    unsigned char* wsb; const float* rope;
    DI void operator()(const Acc& acc, const Unit& u, int wr, int wc, int fr, int fq) const {
        const int pn = u.pn;
        if (pn < 2) {
            bf16_t* dst = (bf16_t*)(wsb + (pn == 0 ? A_QA : A_KA)); const float sc = pn == 0 ? 1.f : 0.125f; const bool lat = u.pm >= 32;
            const int row0 = u.pm * 256 + wr * 64 + fr, col0 = wc * 32 + 4 * fq;
#pragma unroll
            for (int ai = 0; ai < 2; ++ai)
#pragma unroll
                for (int m = 0; m < 4; ++m) { const int row = row0 + ai * 128 + m * 16; const int t = (row - MP_) & 2047; const int pos = (wc & 1) ? (t & 63) : (t >> 6);
#pragma unroll
                    for (int bj = 0; bj < 2; ++bj) { f32x4 x1 = acc[ai][bj][m][0], x2 = acc[ai][bj][m][1];
                        if (lat) rope_pair(x1, x2, rope, pos, fq);
                        bf16_t* rp = dst + (size_t)row * 256 + bj * 128 + col0; u32x2 w;
                        w.x = pk2(x1[0] * sc, x1[1] * sc); w.y = pk2(x1[2] * sc, x1[3] * sc); *(u32x2*)rp = w;
                        w.x = pk2(x2[0] * sc, x2[1] * sc); w.y = pk2(x2[2] * sc, x2[3] * sc); *(u32x2*)(rp + 16) = w; } }
        } else if (pn < 4) { store_tile_bf16(acc, (bf16_t*)(wsb + A_VA), 512, (pn - 2) * 256, u, wr, wc, fr, fq, [](float x) { return x; });
        } else if (pn < 6) { store_tile_bf16(acc, (bf16_t*)(wsb + A_GA), 512, (pn - 4) * 256, u, wr, wc, fr, fq, [](float x) { return silu_f(x); });
        } else { store_tile_bf16(acc, (bf16_t*)(wsb + A_PB), 1792, (pn - 6) * 256, u, wr, wc, fr, fq, [](float x) { return x; }); }
    }
};

struct EpiInOdd {
    static constexpr bool PERM = false, AFTER_DRAIN = false;
    unsigned char* wsb; const float* rope; const float* qk_gain; const float* ibias; const float* fbias; float* outb;
    DI void operator()(const Acc& acc, const Unit& u, int wr, int wc, int fr, int fq) const {
        const int pn = u.pn;
        if (pn < 2) { store_tile_bf16(acc, (bf16_t*)(wsb + O_QC), 512, pn * 256, u, wr, wc, fr, fq, [](float x) { return x; });
        } else if (pn < 4) { store_tile_bf16(acc, (bf16_t*)(wsb + O_KC), 512, (pn - 2) * 256, u, wr, wc, fr, fq, [](float x) { return x * 0.08838834764831845f; });
        } else if (pn < 6) { store_tile_bf16(acc, (bf16_t*)(wsb + O_VC), 512, (pn - 4) * 256, u, wr, wc, fr, fq, [](float x) { return x; });
        } else if (pn < 8) { store_tile_bf16(acc, (bf16_t*)(wsb + O_OC), 512, (pn - 6) * 256, u, wr, wc, fr, fq, [](float x) { return sigmoid_f(x); });
        } else if (pn < 11) {
            const bool lat = u.pm >= 32; const bool isv = (pn == 10) && (wc >= 2); const bool isk = (pn == 10) && (wc < 2);
            const float* gain = qk_gain + (isk ? 64 : 0);
            const int row0 = u.pm * 256 + wr * 64 + fr;
#pragma unroll
            for (int ai = 0; ai < 2; ++ai)
#pragma unroll
                for (int m = 0; m < 4; ++m) { const int row = row0 + ai * 128 + m * 16;
                    f32x4 v[2][2];
#pragma unroll
                    for (int bj = 0; bj < 2; ++bj)
#pragma unroll
                        for (int n = 0; n < 2; ++n) v[bj][n] = acc[ai][bj][m][n];
                    if (!isv) {
                        float ss = 0.f;
#pragma unroll
                        for (int bj = 0; bj < 2; ++bj)
#pragma unroll
                            for (int n = 0; n < 2; ++n)
#pragma unroll
                                for (int j = 0; j < 4; ++j) ss += v[bj][n][j] * v[bj][n][j];
                        ss = fq_sum(ss);
                        const float rs = rsqrtf(ss * (1.f / 64.f) + 1e-6f);
#pragma unroll
                        for (int bj = 0; bj < 2; ++bj)
#pragma unroll
                            for (int n = 0; n < 2; ++n) v[bj][n] = v[bj][n] * rs * *(const f32x4*)(gain + 32 * bj + 16 * n + 4 * fq);
                    }
                    if (!lat && pn == 10) {
                        const int b = row >> 8, t = row & 255, hh = wc & 1; float* op = outb + (isk ? OUT_CK : OUT_CV) + ((size_t)(b * 2 + hh) * 256 + t) * 64 + 4 * fq;
#pragma unroll
                        for (int bj = 0; bj < 2; ++bj)
#pragma unroll
                            for (int n = 0; n < 2; ++n) *(f32x4*)(op + 32 * bj + 16 * n) = v[bj][n];
                    }
                    if (lat && !isv) { const int t = (row - MP_) & 2047; rope_pair(v[0][0], v[0][1], rope, t >> 6, fq); rope_pair(v[1][0], v[1][1], rope, t & 63, fq); }
                    bf16_t* rp;
                    if (pn < 10) rp = (bf16_t*)(wsb + O_QD) + (size_t)row * 512 + (4 * (pn - 8) + wc) * 64 + 4 * fq;
                    else rp = (bf16_t*)(wsb + (isk ? O_KD : O_VD)) + (size_t)row * 128 + (wc & 1) * 64 + 4 * fq;
#pragma unroll
                    for (int bj = 0; bj < 2; ++bj)
#pragma unroll
                        for (int n = 0; n < 2; ++n) { u32x2 w; w.x = pk2(v[bj][n][0], v[bj][n][1]); w.y = pk2(v[bj][n][2], v[bj][n][3]); *(u32x2*)(rp + 32 * bj + 16 * n) = w; }
                }
        } else {
            if (wc == 0) {
                const int row0 = u.pm * 256 + wr * 64 + fr; const int c0 = 4 * fq;
                const f32x4 bias = c0 < 8 ? *(const f32x4*)(ibias + c0) : *(const f32x4*)(fbias + c0 - 8);
#pragma unroll
                for (int ai = 0; ai < 2; ++ai)
#pragma unroll
                    for (int m = 0; m < 4; ++m) { const int row = row0 + ai * 128 + m * 16; f32x4 v = acc[ai][0][m][0] + bias;
                        if (c0 >= 8) { v[0] = -softplus_f(-v[0]); v[1] = -softplus_f(-v[1]); v[2] = -softplus_f(-v[2]); v[3] = -softplus_f(-v[3]); }
                        *(f32x4*)((float*)(wsb + O_GT) + (size_t)row * 16 + c0) = v; }
            }
        }
    }
};

struct EpiLora {
    static constexpr bool PERM = false, AFTER_DRAIN = false;
    unsigned char* wsb; const float* w0; const float* a0b;
    DI void operator()(const Acc& acc, const Unit& u, int wr, int wc, int fr, int fq) const {
        const int pn = u.pn;
        if (pn >= 8) { store_tile_bf16(acc, (bf16_t*)(wsb + A_G), 512, (pn - 8) * 256, u, wr, wc, fr, fq, [](float x) { return x; }); return; }
        const int d = (pn >> 1) & 1, cb = (pn & 1) * 256; const bool isw = pn < 4;
        bf16_t* dst = (bf16_t*)(wsb + (isw ? (d ? A_U1 : A_U0) : (d ? A_A1 : A_A0))); const int boff = d * 512 + cb;
        const int row0 = u.pm * 256 + wr * 64 + fr, col0 = wc * 32 + 4 * fq;
#pragma unroll
        for (int ai = 0; ai < 2; ++ai)
#pragma unroll
            for (int m = 0; m < 4; ++m) { bf16_t* rp = dst + (size_t)(row0 + ai * 128 + m * 16) * 512 + cb + col0;
#pragma unroll
                for (int bj = 0; bj < 2; ++bj)
#pragma unroll
                    for (int n = 0; n < 2; ++n) { const float* bp = (isw ? w0 : a0b) + boff + col0 + bj * 128 + n * 16; f32x4 v = acc[ai][bj][m][n] + *(const f32x4*)bp;
#pragma unroll
                        for (int j = 0; j < 4; ++j) { const float ez = __expf(-v[j]); const float sg = __builtin_amdgcn_rcpf(1.f + ez); v[j] = isw ? sg * 0.6065306597f : sg; }
                        u32x2 w; w.x = pk2(v[0], v[1]); w.y = pk2(v[2], v[3]); *(u32x2*)(rp + bj * 128 + n * 16) = w; } }
    }
};
DI int map_col(int kind, int n) {
    if (kind == 0) return n;
    if (kind == 1) { const int pn = n >> 8, bj = (n >> 7) & 1, q = n & 127; return bj * DFF_ + pn * 128 + q; }
    const int pn = n >> 8, tc = n & 255;
    if (pn < 6) return n;
    if (pn < 8) return 1552 + (n - 1536);
    const int hh = (tc & 127) >> 5, bj = tc >> 7, d = 32 * bj + (tc & 31);
    if (pn < 10) return 2064 + (4 * (pn - 8) + hh) * 64 + d;
    if (pn == 10) return hh < 2 ? 2576 + hh * 64 + d : 2704 + (hh - 2) * 64 + d;
    return tc < 16 ? 1536 + tc : -1;
}
DI void conv_load(float (&r)[8], const float* src, int ld, int K, int kind, int tile, int tid) {
    const int tk = K >> 6, n0 = (tile / tk) << 6, k0 = (tile % tk) << 6;
#pragma unroll
    for (int q = 0; q < 8; ++q) { const int e = tid + 512 * q; const int kk = e >> 6, nn = e & 63; const int col = map_col(kind, n0 + nn); r[q] = col >= 0 ? __builtin_nontemporal_load(src + (size_t)(k0 + kk) * ld + col) : 0.f; }
}
DI void conv_finish(const float (&r)[8], bf16_t* dst, int K, int tile, LAS float* T, int tid) {
    const int tk = K >> 6, n0 = (tile / tk) << 6, k0 = (tile % tk) << 6;
    __syncthreads();
#pragma unroll
    for (int q = 0; q < 8; ++q) { const int e = tid + 512 * q; T[(e >> 6) * 65 + (e & 63)] = r[q]; }
    __syncthreads();
    for (int e = tid; e < 2048; e += 512) { const int nn = e >> 5, kp = e & 31; *(unsigned*)(dst + (size_t)(n0 + nn) * K + k0 + 2 * kp) = pk2(T[(2 * kp) * 65 + nn], T[(2 * kp + 1) * 65 + nn]); }
}
DI void conv_tile(const float* src, int ld, bf16_t* dst, int K, int kind, int tile, LAS float* T, int tid) {
    float r[8]; conv_load(r, src, ld, K, kind, tile, tid); conv_finish(r, dst, K, tile, T, tid);
}
struct ConvJob { const float* src; int ld; bf16_t* dst; int K, N, kind; };
DI void convert_layer(KParams& P, int l, LAS unsigned char* lds, int tid, int mask) {
    unsigned char* ws = P.ws;
    ConvJob jobs[6];
    jobs[0] = {P.in[14] + (size_t)(l * 2 + 0) * D_ * 2 * DFF_, 2 * DFF_, (bf16_t*)(ws + W_W1A), D_, 2 * DFF_, 1};
    jobs[1] = {P.in[14] + (size_t)(l * 2 + 1) * D_ * 2 * DFF_, 2 * DFF_, (bf16_t*)(ws + W_W1B), D_, 2 * DFF_, 1};
    jobs[2] = {P.in[15] + (size_t)(l * 2 + 0) * DFF_ * D_, D_, (bf16_t*)(ws + W_W2A), DFF_, D_, 0};
    jobs[3] = {P.in[15] + (size_t)(l * 2 + 1) * DFF_ * D_, D_, (bf16_t*)(ws + W_W2B), DFF_, D_, 0};
    if (l == 0) { jobs[4] = {P.in[16], 3328, (bf16_t*)(ws + W_WIN), D_, 3328, 0}; jobs[5] = {P.in[17], D_, (bf16_t*)(ws + W_WOUT), D_, D_, 0}; }
    else        { jobs[4] = {P.in[31], 2832, (bf16_t*)(ws + W_WIN), D_, 3072, 3}; jobs[5] = {P.in[32], D_, (bf16_t*)(ws + W_WOUT), D_, D_, 0}; }
    LAS float* T = (LAS float*)lds;
#pragma unroll
    for (int j = 0; j < 6; ++j) { if (!((mask >> j) & 1)) continue; const ConvJob J = jobs[j]; const int nt = (J.N >> 6) * (J.K >> 6);
        int t = blockIdx.x; float r0[8], r1[8];
        if (t < nt) conv_load(r0, J.src, J.ld, J.K, J.kind, t, tid);
        for (; t < nt; t += 2 * (int)gridDim.x) {
            const int t1 = t + (int)gridDim.x, t2 = t1 + (int)gridDim.x;
            if (t1 < nt) conv_load(r1, J.src, J.ld, J.K, J.kind, t1, tid);
            conv_finish(r0, J.dst, J.K, t, T, tid);
            if (t2 < nt) conv_load(r0, J.src, J.ld, J.K, J.kind, t2, tid);
            if (t1 < nt) conv_finish(r1, J.dst, J.K, t1, T, tid);
        } }
    if (l == 0) {
        bf16_t* wl = (bf16_t*)(ws + W_WL); const float* w2 = P.in[22]; const float* a2 = P.in[24]; const float* g2 = P.in[25];
        for (int e = blockIdx.x * 512 + tid; e < 2560 * 128; e += gridDim.x * 512) { const int n = e >> 7, k = (e & 127) * 2; const int sel = n >> 9, c = n & 511; float v0 = 0.f, v1 = 0.f;
            if (sel < 2) { if (k < 64) { v0 = w2[(size_t)(sel * 64 + k) * 512 + c]; v1 = w2[(size_t)(sel * 64 + k + 1) * 512 + c]; } }
            else if (sel < 4) { if (k >= 64 && k < 128) { v0 = a2[(size_t)((sel - 2) * 64 + k - 64) * 512 + c]; v1 = a2[(size_t)((sel - 2) * 64 + k - 63) * 512 + c]; } }
            else { if (k >= 128) { v0 = g2[(size_t)(k - 128) * 512 + c]; v1 = g2[(size_t)(k - 127) * 512 + c]; } }
            *(unsigned*)(wl + (size_t)n * 256 + k) = pk2(v0, v1); }
    }
}


DI void conv_l1_early_item(KParams& P, int idx, LAS unsigned char* lds, int tid) {
    LAS float* T = (LAS float*)lds;
    const float* src; int ld, K, kind, t0; bf16_t* dst;
    if (idx < 352) { src = P.in[14] + (size_t)(1 * 2 + 0) * D_ * 2 * DFF_; ld = 2 * DFF_; dst = (bf16_t*)(P.ws + W_W1A); K = D_; kind = 1; t0 = 4 * idx; }
    else if (idx < 528) { src = P.in[15] + (size_t)(1 * 2 + 0) * DFF_ * D_; ld = D_; dst = (bf16_t*)(P.ws + W_W2A); K = DFF_; kind = 0; t0 = 4 * (idx - 352); }
    else { src = P.in[31]; ld = 2832; dst = (bf16_t*)(P.ws + W_WIN); K = D_; kind = 3; t0 = 4 * (idx - 528); }
    float r0[8], r1[8];
    conv_load(r0, src, ld, K, kind, t0, tid); conv_load(r1, src, ld, K, kind, t0 + 1, tid);
    conv_finish(r0, dst, K, t0, T, tid); conv_load(r0, src, ld, K, kind, t0 + 2, tid);
    conv_finish(r1, dst, K, t0 + 1, T, tid); conv_load(r1, src, ld, K, kind, t0 + 3, tid);
    conv_finish(r0, dst, K, t0 + 2, T, tid);
    conv_finish(r1, dst, K, t0 + 3, T, tid);
}

DI void mod_phase(KParams& P, LAS unsigned char* lds, int tid) {
    LAS float* sc = (LAS float*)lds;
    LAS float* red = sc + 9 * 1024;
    const float* c = P.in[9]; const float* cctx = P.in[10];
    for (int e = tid; e < 9 * 1024; e += 512) { const int ci = e >> 10, k = e & 1023; const float v = ci == 0 ? cctx[k] : c[(ci - 1) * 1024 + k]; sc[e] = silu_f(v); }
    __syncthreads();
    float* mod = (float*)(P.ws + WS_MOD);
    const int wid = tid >> 6, lane = tid & 63;
    for (int it = blockIdx.x; it < 288; it += gridDim.x) { const int l = it / 144, n0 = (it % 144) * 64;
        const float* w = P.in[11] + (size_t)l * D_ * 9216 + n0 + lane;
        float acc[9];
#pragma unroll
        for (int i = 0; i < 9; ++i) acc[i] = 0.f;
        for (int k = wid * 128; k < wid * 128 + 128; k += 16) {
            float wv[16];
#pragma unroll
            for (int q = 0; q < 16; ++q) wv[q] = __builtin_nontemporal_load(w + (size_t)(k + q) * 9216);
#pragma unroll
            for (int q = 0; q < 16; ++q)
#pragma unroll
                for (int i = 0; i < 9; ++i) acc[i] += sc[i * 1024 + k + q] * wv[q];
        }
#pragma unroll
        for (int i = 0; i < 9; ++i) red[(wid * 9 + i) * 64 + lane] = acc[i];
        __syncthreads();
        for (int o = tid; o < 576; o += 512) { const int i = o >> 6, ln = o & 63; float s = 0.f;
#pragma unroll
            for (int w8 = 0; w8 < 8; ++w8) s += red[(w8 * 9 + i) * 64 + ln];
            mod[(size_t)(l * 9 + i) * 9216 + n0 + ln] = s + P.in[12][(size_t)l * 9216 + n0 + ln]; }
        __syncthreads();
    }
}

DI void norm_phase(const float* xp, const float* xs, bf16_t* h, const float* g, const float* modl, int qsh, int tid) {
    const int wid = tid >> 6, lane = tid & 63; const int stride = gridDim.x * 8;
    int row = blockIdx.x * 8 + wid;
    f32x4 v[4], nv[4];
    if (row < M_) { const float* xr = row < MP_ ? xp + (size_t)row * D_ : xs + (size_t)(row - MP_) * D_;
#pragma unroll
        for (int i = 0; i < 4; ++i) v[i] = *(const f32x4*)(xr + 4 * lane + 256 * i); }
    for (; row < M_; row += stride) {
        const int nrow = row + stride;
        if (nrow < M_) { const float* xr = nrow < MP_ ? xp + (size_t)nrow * D_ : xs + (size_t)(nrow - MP_) * D_;
#pragma unroll
            for (int i = 0; i < 4; ++i) nv[i] = *(const f32x4*)(xr + 4 * lane + 256 * i); }
        const float* sh = modl + (size_t)cond_of_row(row) * 9216 + qsh * 1024; const float* sc = sh + 1024;
        float ss = 0.f;
#pragma unroll
        for (int i = 0; i < 4; ++i) ss += v[i][0] * v[i][0] + v[i][1] * v[i][1] + v[i][2] * v[i][2] + v[i][3] * v[i][3];
        ss = wave_sum(ss); const float rs = rsqrtf(ss * (1.f / 1024.f) + 1e-6f);
#pragma unroll
        for (int i = 0; i < 4; ++i) { const int c = 4 * lane + 256 * i; const f32x4 gg = *(const f32x4*)(g + c), s1 = *(const f32x4*)(sc + c), s0 = *(const f32x4*)(sh + c);
            const f32x4 y = v[i] * rs * gg * (s1 + 1.f) + s0; u32x2 w; w.x = pk2(y[0], y[1]); w.y = pk2(y[2], y[3]); *(u32x2*)(h + (size_t)row * D_ + c) = w; }
#pragma unroll
        for (int i = 0; i < 4; ++i) v[i] = nv[i];
    }
}
DI void final_norm_phase(float* x, const float* g, int tid) {
    const int wid = tid >> 6, lane = tid & 63; const int stride = gridDim.x * 8;
    int row = blockIdx.x * 8 + wid;
    f32x4 v[4], nv[4];
    if (row < M_) {
#pragma unroll
        for (int i = 0; i < 4; ++i) v[i] = *(const f32x4*)(x + (size_t)row * D_ + 4 * lane + 256 * i); }
    for (; row < M_; row += stride) {
        const int nrow = row + stride;
        if (nrow < M_) {
#pragma unroll
            for (int i = 0; i < 4; ++i) nv[i] = *(const f32x4*)(x + (size_t)nrow * D_ + 4 * lane + 256 * i); }
        float* xr = x + (size_t)row * D_; float ss = 0.f;
#pragma unroll
        for (int i = 0; i < 4; ++i) ss += v[i][0] * v[i][0] + v[i][1] * v[i][1] + v[i][2] * v[i][2] + v[i][3] * v[i][3];
        ss = wave_sum(ss); const float rs = rsqrtf(ss * (1.f / 1024.f) + 1e-6f);
#pragma unroll
        for (int i = 0; i < 4; ++i) { const int c = 4 * lane + 256 * i; *(f32x4*)(xr + c) = v[i] * rs * *(const f32x4*)(g + c); }
#pragma unroll
        for (int i = 0; i < 4; ++i) v[i] = nv[i];
    }
}
#define MFMA16(a, b, c) __builtin_amdgcn_mfma_f32_16x16x32_bf16((a), (b), (c), 0, 0, 0)
template <int COLS> DI void stage_bf16(LAS bf16_t* dst, const bf16_t* src, size_t ldg, int rows, int pitch, int tid) {
    constexpr int PR = COLS / 8;
    for (int p = tid; p < rows * PR; p += 512) { const int r = p / PR, c8 = p % PR; const u32x4 v = *(const u32x4*)(src + (size_t)r * ldg + c8 * 8); *(LAS u32x4*)(dst + r * pitch + c8 * 8) = v; }
}
template <int COLS> DI void stage_f32(LAS bf16_t* dst, const float* src, size_t ldg, int rows, int pitch, int tid) {
    constexpr int PR = COLS / 4;
    for (int p = tid; p < rows * PR; p += 512) { const int r = p / PR, c4 = p % PR; const f32x4 v = *(const f32x4*)(src + (size_t)r * ldg + c4 * 4); u32x2 w; w.x = pk2(v[0], v[1]); w.y = pk2(v[2], v[3]); *(LAS u32x2*)(dst + r * pitch + c4 * 4) = w; }
}

template <int COLS> DI void tile_load(u32x4 (&r)[COLS / 32], const bf16_t* src, size_t ldg, int tid) {
    constexpr int PR = COLS / 8;
#pragma unroll
    for (int i = 0; i < COLS / 32; ++i) { const int p = tid + 512 * i; r[i] = *(const u32x4*)(src + (size_t)(p / PR) * ldg + (p % PR) * 8); }
}
template <int COLS> DI void tile_store(LAS bf16_t* dst, const u32x4 (&r)[COLS / 32], int pitch, int tid) {
    constexpr int PR = COLS / 8;
#pragma unroll
    for (int i = 0; i < COLS / 32; ++i) { const int p = tid + 512 * i; *(LAS u32x4*)(dst + (p / PR) * pitch + (p % PR) * 8) = r[i]; }
}
DI void tile_load_f32x64(f32x4 (&r)[4], const float* src, int tid) {
#pragma unroll
    for (int i = 0; i < 4; ++i) r[i] = *(const f32x4*)(src + (size_t)(tid + 512 * i) * 4);
}
DI void tile_store_f32x64(LAS bf16_t* dst, const f32x4 (&r)[4], int pitch, int tid) {
#pragma unroll
    for (int i = 0; i < 4; ++i) { const int p = tid + 512 * i; u32x2 w; w.x = pk2(r[i][0], r[i][1]); w.y = pk2(r[i][2], r[i][3]); *(LAS u32x2*)(dst + (p >> 4) * pitch + (p & 15) * 4) = w; }
}
template <int DK> DI void qk_tile(const LAS bf16_t* sK, const bf16x8 (&qf)[DK / 32], f32x4 (&sacc)[8], int fr, int fq) {
#pragma unroll
    for (int jt = 0; jt < 8; ++jt) { f32x4 a = {0.f, 0.f, 0.f, 0.f};
#pragma unroll
        for (int s = 0; s < DK / 32; ++s) { const bf16x8 kf = *(const LAS bf16x8*)(sK + (16 * jt + fr) * (DK + 8) + 32 * s + 8 * fq); a = MFMA16(kf, qf[s], a); }
        sacc[jt] = a; }
}
template <int DV, int PITCH = DV + 8> DI void pv_tile(const LAS bf16_t* sV, const bf16x8 (&pf)[4], f32x4 (&oacc)[DV / 16], int fr, int fq) {
#pragma unroll
    for (int et = 0; et < DV / 16; ++et)
#pragma unroll
        for (int s = 0; s < 4; ++s) {
            const LAS bf16_t* p0 = sV + (32 * s + 4 * fq + (fr >> 2)) * PITCH + 16 * et + 4 * (fr & 3);
            const s16x4 lo = __builtin_amdgcn_ds_read_tr16_b64_v4i16((LAS s16x4*)p0), hi = __builtin_amdgcn_ds_read_tr16_b64_v4i16((LAS s16x4*)(p0 + 16 * PITCH));
            const bf16x8 vf = __builtin_shufflevector(lo, hi, 0, 1, 2, 3, 4, 5, 6, 7);
            oacc[et] = MFMA16(vf, pf[s], oacc[et]); }
}
DI void pack_p(const f32x4 (&p)[8], bf16x8 (&pf)[4]) {
#pragma unroll
    for (int s = 0; s < 4; ++s) { u32x4 w; w.x = pk2(p[2 * s][0], p[2 * s][1]); w.y = pk2(p[2 * s][2], p[2 * s][3]); w.z = pk2(p[2 * s + 1][0], p[2 * s + 1][1]); w.w = pk2(p[2 * s + 1][2], p[2 * s + 1][3]); pf[s] = __builtin_bit_cast(bf16x8, w); }
}
template <int DKQ> DI void pack_q_state(const bf16_t* qrow, float f0, float f1, bf16x8 (&pf)[4], f32x4 (&pv)[8], int fq) {
#pragma unroll
    for (int s = 0; s < 4; ++s)
#pragma unroll
        for (int hh = 0; hh < 2; ++hh) { const int key = 32 * s + 16 * hh + 4 * fq; const int d = DKQ == 64 ? (key & 63) : key; const float fac = (DKQ == 64 && key >= 64) ? f1 : f0;
            const u32x2 w = *(const u32x2*)(qrow + d); f32x4 v; v[0] = bf_lo(w.x) * fac; v[1] = bf_hi(w.x) * fac; v[2] = bf_lo(w.y) * fac; v[3] = bf_hi(w.y) * fac; pv[2 * s + hh] = v; }
    pack_p(pv, pf);
}
DI void ln_gate_store(f32x4 (&o)[8], float eps, const float* wgt, const bf16_t* gate, bf16_t* dst, int fq) {
    float s = 0.f;
#pragma unroll
    for (int et = 0; et < 8; ++et) s += o[et][0] + o[et][1] + o[et][2] + o[et][3];
    s = fq_sum(s); const float mu = s * (1.f / 128.f); float vs = 0.f;
#pragma unroll
    for (int et = 0; et < 8; ++et)
#pragma unroll
        for (int j = 0; j < 4; ++j) { const float d = o[et][j] - mu; vs += d * d; }
    vs = fq_sum(vs); const float rs = rsqrtf(vs * (1.f / 128.f) + eps);
#pragma unroll
    for (int et = 0; et < 8; ++et) { const int e = 16 * et + 4 * fq; const f32x4 wv = *(const f32x4*)(wgt + e); const u32x2 gw = *(const u32x2*)(gate + e);
        u32x2 w; w.x = pk2((o[et][0] - mu) * rs * wv[0] * bf_lo(gw.x), (o[et][1] - mu) * rs * wv[1] * bf_hi(gw.x));
        w.y = pk2((o[et][2] - mu) * rs * wv[2] * bf_lo(gw.y), (o[et][3] - mu) * rs * wv[3] * bf_hi(gw.y)); *(u32x2*)(dst + e) = w; }
}


template <int DK> DI void state_mfma(const bf16_t* kg, size_t ldk, const bf16_t* vg, size_t ldv, const LAS float* wj, LAS unsigned char* lds, float* out, float* nout, int tid) {
    constexpr int PK = DK == 128 ? 144 : 72, NE = DK == 128 ? 8 : 4, PR = DK / 8;
    const int wid = tid >> 6, lane = tid & 63, fr = lane & 15, fq = lane >> 4;
    const int dt = DK == 128 ? wid : (wid & 3), e0 = DK == 128 ? 0 : (wid >> 2) * 4;
    LAS bf16_t* sKw = (LAS bf16_t*)lds; LAS bf16_t* sV = (LAS bf16_t*)(lds + 36864);
    f32x4 acc[NE];
#pragma unroll
    for (int i = 0; i < NE; ++i) acc[i] = (f32x4){0.f, 0.f, 0.f, 0.f};
    float nacc = 0.f;
#pragma unroll 1
    for (int hf = 0; hf < 2; ++hf) {
        __syncthreads();
        for (int p = tid; p < 128 * PR; p += 512) { const int r = p / PR, c8 = p % PR; const u32x4 v = *(const u32x4*)(kg + (size_t)(128 * hf + r) * ldk + c8 * 8); const float w = wj[128 * hf + r];
            u32x4 o; o.x = pk2(bf_lo(v.x) * w, bf_hi(v.x) * w); o.y = pk2(bf_lo(v.y) * w, bf_hi(v.y) * w); o.z = pk2(bf_lo(v.z) * w, bf_hi(v.z) * w); o.w = pk2(bf_lo(v.w) * w, bf_hi(v.w) * w);
            *(LAS u32x4*)(sKw + r * PK + c8 * 8) = o; }
        stage_bf16<128>(sV, vg + (size_t)(128 * hf) * ldv, ldv, 128, 144, tid);
        __syncthreads();
#pragma unroll
        for (int s = 0; s < 4; ++s) {
            const LAS bf16_t* pa = sKw + (32 * s + 4 * fq + (fr >> 2)) * PK + 16 * dt + 4 * (fr & 3);
            const s16x4 alo = __builtin_amdgcn_ds_read_tr16_b64_v4i16((LAS s16x4*)pa), ahi = __builtin_amdgcn_ds_read_tr16_b64_v4i16((LAS s16x4*)(pa + 16 * PK));
            const bf16x8 af = __builtin_shufflevector(alo, ahi, 0, 1, 2, 3, 4, 5, 6, 7);
#pragma unroll
            for (int i = 0; i < NE; ++i) {
                const LAS bf16_t* pb = sV + (32 * s + 4 * fq + (fr >> 2)) * 144 + 16 * (e0 + i) + 4 * (fr & 3);
                const s16x4 blo = __builtin_amdgcn_ds_read_tr16_b64_v4i16((LAS s16x4*)pb), bhi = __builtin_amdgcn_ds_read_tr16_b64_v4i16((LAS s16x4*)(pb + 16 * 144));
                const bf16x8 bfv = __builtin_shufflevector(blo, bhi, 0, 1, 2, 3, 4, 5, 6, 7);
                acc[i] = MFMA16(af, bfv, acc[i]); }
        }
        if (nout && tid < DK) { for (int j = 0; j < 128; ++j) nacc += bf2f(sKw[j * PK + tid]); }
    }
#pragma unroll
    for (int i = 0; i < NE; ++i)
#pragma unroll
        for (int r = 0; r < 4; ++r) out[(size_t)(16 * dt + 4 * fq + r) * 128 + 16 * (e0 + i) + fr] = acc[i][r];
    if (nout && tid < DK) nout[tid] = nacc;
}
DI void ret_item(KParams& P, int item, LAS unsigned char* lds, int tid) {
    const int wid = tid >> 6, lane = tid & 63, fr = lane & 15, fq = lane >> 4;
    int b, h, c, L, rowbase, nc; bool lat;
    if (item < 128) { b = item >> 2; h = item & 3; c = 0; L = 256; rowbase = b * 256; nc = 2; lat = false; }
    else { const int it = item - 128; b = it >> 5; h = (it >> 3) & 3; c = it & 7; L = 2048; rowbase = MP_ + b * 2048; nc = 16; lat = true; }
    const bf16_t* qA = (const bf16_t*)(P.ws + A_QA); const bf16_t* kA = (const bf16_t*)(P.ws + A_KA); const bf16_t* vA = (const bf16_t*)(P.ws + A_VA); const bf16_t* gA = (const bf16_t*)(P.ws + A_GA);
    LAS bf16_t* sK = (LAS bf16_t*)lds; LAS bf16_t* sV = (LAS bf16_t*)(lds + 128 * 72 * 2);
    const float lgf = P.in[18][h], lgb = P.in[18][4 + h];
    const float lgf2 = lgf * 1.4426950408889634f, lgb2 = lgb * 1.4426950408889634f;
    const int ti0 = 256 * c + 32 * wid + fr;
    bf16x8 qf[2][2];
#pragma unroll
    for (int it = 0; it < 2; ++it)
#pragma unroll
        for (int s = 0; s < 2; ++s) qf[it][s] = *(const bf16x8*)(qA + (size_t)(rowbase + ti0 + 16 * it) * 256 + h * 64 + 32 * s + 8 * fq);
    f32x4 oacc[2][8];
#pragma unroll
    for (int it = 0; it < 2; ++it)
#pragma unroll
        for (int et = 0; et < 8; ++et) oacc[it][et] = (f32x4){0.f, 0.f, 0.f, 0.f};
    f32x4 sacc[8]; bf16x8 pf[2][4];
    auto pv2 = [&](const LAS bf16_t* cV) {
#pragma unroll
        for (int et = 0; et < 8; ++et)
#pragma unroll
            for (int s = 0; s < 4; ++s) {
                const LAS bf16_t* p0 = cV + (32 * s + 4 * fq + (fr >> 2)) * 144 + 16 * et + 4 * (fr & 3);
                const s16x4 lo = __builtin_amdgcn_ds_read_tr16_b64_v4i16((LAS s16x4*)p0), hi = __builtin_amdgcn_ds_read_tr16_b64_v4i16((LAS s16x4*)(p0 + 16 * 144));
                const bf16x8 vf = __builtin_shufflevector(lo, hi, 0, 1, 2, 3, 4, 5, 6, 7);
                oacc[0][et] = MFMA16(vf, pf[0][s], oacc[0][et]); oacc[1][et] = MFMA16(vf, pf[1][s], oacc[1][et]); if (s == 3 && (et & 1)) __builtin_amdgcn_sched_barrier(0); } };
    {
        u32x4 rk[2], rv[4];
        const bf16_t* kg = kA + (size_t)rowbase * 256 + h * 64; const bf16_t* vg = vA + (size_t)rowbase * 512 + h * 128;
        tile_load<64>(rk, kg, 256, tid); tile_load<128>(rv, vg, 512, tid);
        __syncthreads();
        tile_store<64>(sK, rk, 72, tid); tile_store<128>(sV, rv, 144, tid);
        if (nc > 1) { tile_load<64>(rk, kg + (size_t)128 * 256, 256, tid); tile_load<128>(rv, vg + (size_t)128 * 512, 512, tid); }
        __syncthreads();
        for (int kc = 0; kc < nc; ++kc) {
            const LAS bf16_t* cK = sK + (kc & 1) * 27648; const LAS bf16_t* cV = sV + (kc & 1) * 27648;
#pragma unroll
            for (int it = 0; it < 2; ++it) {
                qk_tile<64>(cK, qf[it], sacc, fr, fq);
#pragma unroll
                for (int jt = 0; jt < 8; ++jt)
#pragma unroll
                    for (int r = 0; r < 4; ++r) { const int tj = 128 * kc + 16 * jt + 4 * fq + r; const int dl = ti0 + 16 * it - tj;
                        const float e = __builtin_amdgcn_exp2f((dl > 0 ? lgf2 : lgb2) * (float)(dl > 0 ? dl : -dl)); sacc[jt][r] *= (dl == 0 ? 2.f : e); }
                pack_p(sacc, pf[it]); }
            pv2(cV);
            { const int tl = launder_v(tid);
            if (kc + 1 < nc) { tile_store<64>(sK + ((kc + 1) & 1) * 27648, rk, 72, tl); tile_store<128>(sV + ((kc + 1) & 1) * 27648, rv, 144, tl); }
            if (kc + 2 < nc) { tile_load<64>(rk, kg + (size_t)128 * (kc + 2) * 256, 256, tl); tile_load<128>(rv, vg + (size_t)128 * (kc + 2) * 512, 512, tl); } }
            __syncthreads();
        }
    }
    if (lat) {
        __syncthreads();
        const float* s0 = P.in[2] + (size_t)b * 2 * 4 * 64 * 128;
        stage_f32<128>(sV, s0 + (size_t)(0 * 4 + h) * 64 * 128, 128, 64, 144, tid);
        stage_f32<128>(sV + 64 * 144, s0 + (size_t)(1 * 4 + h) * 64 * 128, 128, 64, 144, tid);
        __syncthreads();
#pragma unroll
        for (int it = 0; it < 2; ++it) { const int ti = ti0 + 16 * it;
            pack_q_state<64>(qA + (size_t)(rowbase + ti) * 256 + h * 64, __expf(lgf * (float)(ti + 1)), __expf(lgb * (float)(L - ti)), pf[it], sacc, fq); }
        pv2(sV);
    }
#pragma unroll
    for (int it = 0; it < 2; ++it) { const int qrow = launder_v(rowbase + ti0) + 16 * it;
        ln_gate_store(oacc[it], 1e-5f, P.in[19] + h * 128, gA + (size_t)qrow * 512 + h * 128, (bf16_t*)(P.ws + WS_H) + (size_t)qrow * D_ + h * 128, fq); }
}
DI void ret_state_item(KParams& P, int item, LAS unsigned char* lds, int tid) {
    const int b = item >> 3, h = (item >> 1) & 3, dir = item & 1; const int rowbase = b * 256;
    const bf16_t* kA = (const bf16_t*)(P.ws + A_KA); const bf16_t* vA = (const bf16_t*)(P.ws + A_VA);
    LAS float* wj = (LAS float*)(lds + MISC_OFF);
    const float lg = P.in[18][dir * 4 + h];
    __syncthreads();
    if (tid < 256) wj[tid] = __expf(lg * (float)(dir ? tid : 255 - tid));
    state_mfma<64>(kA + (size_t)rowbase * 256 + h * 64, 256, vA + (size_t)rowbase * 512 + h * 128, 512, wj, lds, P.out + OUT_RET + (size_t)((b * 2 + dir) * 4 + h) * 64 * 128, nullptr, tid);
}
DI float wave_incl_sum(float v, int lane) {
#pragma unroll
    for (int o = 1; o < 64; o <<= 1) { const float t = __shfl_up(v, o); if (lane >= o) v += t; }
    return v;
}
DI float wave_incl_max(float v, int lane) {
#pragma unroll
    for (int o = 1; o < 64; o <<= 1) { const float t = __shfl_up(v, o); if (lane >= o) v = fmaxf(v, t); }
    return v;
}
DI void gate_scan(const LAS float* ig, const LAS float* lf, LAS float* cf, LAS float* rowf, LAS float* Fq, int L, int t0, bool rev, float m0, int lane, float& Ftot, float& Mtot) {
    float csum = 0.f, cmax = m0;
    for (int blk = 0; blk < L; blk += 64) { const int pos = blk + lane; const int t = rev ? L - 1 - pos : pos;
        const float F = csum + wave_incl_sum(lf[t], lane); const float c = ig[t] - F; const float pm = fmaxf(cmax, wave_incl_max(c, lane));
        cf[t] = c; if (t >= t0 && t < t0 + 128) { rowf[t - t0] = -pm; Fq[t - t0] = F; }
        csum = __shfl(F, 63); cmax = __shfl(pm, 63); }
    Ftot = csum; Mtot = cmax;
}
DI void mlstm_item(KParams& P, int item, LAS unsigned char* lds, int tid) {
    const int wid = tid >> 6, lane = tid & 63, fr = lane & 15, fq = lane >> 4;
    int b, h, c, L, rowbase, nc; bool lat;
    if (item < 256) { b = item >> 3; h = (item >> 1) & 3; c = item & 1; L = 256; rowbase = b * 256; nc = 2; lat = false; }
    else { const int it = item - 256; b = it >> 6; h = (it >> 4) & 3; c = it & 15; L = 2048; rowbase = MP_ + b * 2048; nc = 16; lat = true; }
    const bf16_t* qC = (const bf16_t*)(P.ws + O_QC); const bf16_t* kC = (const bf16_t*)(P.ws + O_KC); const bf16_t* vC = (const bf16_t*)(P.ws + O_VC); const bf16_t* oC = (const bf16_t*)(P.ws + O_OC);
    const float* gates = (const float*)(P.ws + O_GT); bf16_t* mix = (bf16_t*)(P.ws + WS_H);
    LAS bf16_t* sK = (LAS bf16_t*)lds; LAS bf16_t* sV = (LAS bf16_t*)(lds + 34816);
    LAS float* cfa = (LAS float*)(lds + 73728);
    LAS float* rowfa = (LAS float*)(lds + 90112);
    LAS float* Fqa = rowfa + 256;
    LAS float* tmp = (LAS float*)(lds + 94208);
    __syncthreads();
    for (int t = tid; t < L; t += 512) { const float* g = gates + (size_t)(rowbase + t) * 16; tmp[t] = g[h]; tmp[2048 + t] = g[8 + h]; tmp[4096 + t] = g[4 + h]; tmp[6144 + t] = g[12 + h]; }
    __syncthreads();
    float m0f = 0.f, m0b = 0.f;
    if (lat) { m0f = P.in[6][(b * 2 + 0) * 4 + h]; m0b = P.in[6][(b * 2 + 1) * 4 + h]; }
    {
        LAS float* bs = (LAS float*)(lds + MISC_OFF);
        const int nblk = L >> 6;
        for (int j = wid; j < 2 * nblk; j += 8) { const int dr = j >= nblk, blk = dr ? j - nblk : j; const int pos = 64 * blk + lane; const int t = dr ? L - 1 - pos : pos;
            LAS float* ig = tmp + dr * 4096; LAS float* lf = ig + 2048;
            const float Fl = wave_incl_sum(lf[t], lane); const float cl = ig[t] - Fl; const float pm = wave_incl_max(cl, lane);
            cfa[dr * 2048 + t] = cl; ig[t] = pm; lf[t] = Fl;
            if (lane == 63) { bs[dr * 32 + blk] = Fl; bs[64 + dr * 32 + blk] = pm; } }
        __syncthreads();
        if (wid == 0) { const int dr = lane >> 5, blk = lane & 31;
            if (blk < nblk) { float C = 0.f, cm = dr ? m0b : m0f;
                for (int q = 0; q < blk; ++q) { cm = fmaxf(cm, bs[64 + dr * 32 + q] - C); C += bs[dr * 32 + q]; }
                bs[128 + dr * 32 + blk] = C; bs[192 + dr * 32 + blk] = cm; } }
        __syncthreads();
        for (int e = tid; e < 2 * L; e += 512) { const int dr = e >= L, t = dr ? e - L : e; const int pos = dr ? L - 1 - t : t; const int blk = pos >> 6;
            const float C = bs[128 + dr * 32 + blk], cm = bs[192 + dr * 32 + blk];
            cfa[dr * 2048 + t] -= C;
            if (t >= 128 * c && t < 128 * c + 128) { rowfa[dr * 128 + t - 128 * c] = -fmaxf(cm, tmp[dr * 4096 + t] - C); Fqa[dr * 128 + t - 128 * c] = tmp[dr * 4096 + 2048 + t] + C; } }
    }
    __syncthreads();
    const int ti = 128 * c + 16 * wid + fr; const int qrow = rowbase + ti;
    bf16x8 qf[4];
#pragma unroll
    for (int s = 0; s < 4; ++s) qf[s] = *(const bf16x8*)(qC + (size_t)qrow * 512 + h * 128 + 32 * s + 8 * fq);
    f32x4 hsum[8];
#pragma unroll
    for (int et = 0; et < 8; ++et) hsum[et] = (f32x4){0.f, 0.f, 0.f, 0.f};
    f32x4 sacc[8]; bf16x8 pf[4];
#pragma unroll 1
    for (int dir = 0; dir < 2; ++dir) {
        f32x4 num[8];
#pragma unroll
        for (int et = 0; et < 8; ++et) num[et] = (f32x4){0.f, 0.f, 0.f, 0.f};
        float den = 0.f;
        const float rf = rowfa[dir * 128 + 16 * wid + fr]; const LAS float* cf = cfa + dir * 2048;
        const int k0 = dir ? c : 0, k1 = dir ? nc : c + 1;
        {
            u32x4 rk[4], rv[4];
            const bf16_t* kg = kC + (size_t)rowbase * 512 + h * 128; const bf16_t* vg = vC + (size_t)rowbase * 512 + h * 128;
            tile_load<128>(rk, kg + (size_t)128 * k0 * 512, 512, tid); tile_load<128>(rv, vg + (size_t)128 * k0 * 512, 512, tid);
            for (int kc = k0; kc < k1; ++kc) {
                __syncthreads();
                tile_store<128>(sK, rk, 136, tid); tile_store<128>(sV, rv, 144, tid);
                __syncthreads();
                if (kc + 1 < k1) { tile_load<128>(rk, kg + (size_t)128 * (kc + 1) * 512, 512, tid); tile_load<128>(rv, vg + (size_t)128 * (kc + 1) * 512, 512, tid); }
                qk_tile<128>(sK, qf, sacc, fr, fq);
#pragma unroll
                for (int jt = 0; jt < 8; ++jt) { const f32x4 cv = *(const LAS f32x4*)(cf + 128 * kc + 16 * jt + 4 * fq);
#pragma unroll
                    for (int r = 0; r < 4; ++r) { const int tj = 128 * kc + 16 * jt + 4 * fq + r; const bool ok = dir ? (tj >= ti) : (tj <= ti);
                        const float w = ok ? __expf(rf + cv[r]) : 0.f; const float p = sacc[jt][r] * w; sacc[jt][r] = p; den += p; } }
                pack_p(sacc, pf);
                pv_tile<128, 144>(sV, pf, num, fr, fq);
            }
        }
        if (lat) {
            __syncthreads();
            stage_f32<128>(sV, P.in[4] + (size_t)((b * 2 + dir) * 4 + h) * 128 * 128, 128, 128, 144, tid);
            __syncthreads();
            const float fac = __expf((dir ? m0b : m0f) + rf);
            pack_q_state<128>(qC + (size_t)qrow * 512 + h * 128, fac, fac, pf, sacc, fq);
            const float* n0 = P.in[5] + (size_t)((b * 2 + dir) * 4 + h) * 128;
#pragma unroll
            for (int jt = 0; jt < 8; ++jt) { const f32x4 nv = *(const f32x4*)(n0 + 16 * jt + 4 * fq); den += sacc[jt][0] * nv[0] + sacc[jt][1] * nv[1] + sacc[jt][2] * nv[2] + sacc[jt][3] * nv[3]; }
            pv_tile<128, 144>(sV, pf, num, fr, fq);
        }
        den = fq_sum(den);
        const float thr = __expf(rf - Fqa[dir * 128 + 16 * wid + fr]);
        const float dn = 1.f / fmaxf(fabsf(den), thr);
#pragma unroll
        for (int et = 0; et < 8; ++et) hsum[et] += num[et] * dn;
    }
    ln_gate_store(hsum, 1e-5f, P.in[35] + h * 128, oC + (size_t)qrow * 512 + h * 128, mix + (size_t)qrow * D_ + h * 128, fq);
}
DI void mlstm_state_item(KParams& P, int item, LAS unsigned char* lds, int tid) {
    const int wid = tid >> 6, lane = tid & 63;
    const int b = item >> 3, h = (item >> 1) & 3, dir = item & 1; const int rowbase = b * 256;
    const bf16_t* kC = (const bf16_t*)(P.ws + O_KC); const bf16_t* vC = (const bf16_t*)(P.ws + O_VC); const float* gates = (const float*)(P.ws + O_GT);
    LAS float* mi = (LAS float*)(lds + MISC_OFF);
    __syncthreads();
    if (tid < 256) { const float* g = gates + (size_t)(rowbase + tid) * 16; mi[tid] = g[dir * 4 + h]; mi[256 + tid] = g[8 + dir * 4 + h]; }
    __syncthreads();
    if (wid == 0) { float Ft, Mt; gate_scan(mi, mi + 256, mi + 512, mi + 768, mi + 896, 256, 0, dir == 1, 0.f, lane, Ft, Mt); if (lane == 0) { mi[1024] = Ft; mi[1025] = Mt; } }
    __syncthreads();
    const float Ft = mi[1024], Mt = mi[1025];
    if (tid < 256) mi[512 + tid] = __expf(mi[512 + tid] - Mt);
    const size_t sidx = (size_t)(b * 2 + dir) * 4 + h;
    state_mfma<128>(kC + (size_t)rowbase * 512 + h * 128, 512, vC + (size_t)rowbase * 512 + h * 128, 512, mi + 512, lds, P.out + OUT_MC + sidx * 128 * 128, P.out + OUT_MN + sidx * 128, tid);
    if (tid == 0) P.out[OUT_MM + sidx] = Ft + Mt;
}
DI void attn_item(KParams& P, int item, LAS unsigned char* lds, int tid) {
    const int wid = tid >> 6, lane = tid & 63, fr = lane & 15, fq = lane >> 4;
    int b, qh, qb, rowbase, nkt; bool lat;
    if (item >= 512) { const int it = item - 512; b = it >> 3; qh = it & 7; qb = 0; rowbase = b * 256; nkt = 2; lat = false; }
    else { b = item >> 6; qh = (item >> 3) & 7; qb = item & 7; rowbase = MP_ + b * 2048; nkt = 20; lat = true; }
    const int kvh = qh >> 2;
    const bf16_t* qD = (const bf16_t*)(P.ws + O_QD); const bf16_t* kD = (const bf16_t*)(P.ws + O_KD); const bf16_t* vD = (const bf16_t*)(P.ws + O_VD); bf16_t* mix = (bf16_t*)(P.ws + WS_H);
    LAS bf16_t* sK = (LAS bf16_t*)lds; LAS bf16_t* sV = (LAS bf16_t*)(lds + 128 * 72 * 2);
    const int qrow = rowbase + 256 * qb + 32 * wid + fr;
    bf16x8 qf[2][2];
#pragma unroll
    for (int it = 0; it < 2; ++it)
#pragma unroll
        for (int s = 0; s < 2; ++s) qf[it][s] = *(const bf16x8*)(qD + (size_t)(qrow + 16 * it) * 512 + qh * 64 + 32 * s + 8 * fq);
    f32x4 oacc[2][4];
#pragma unroll
    for (int it = 0; it < 2; ++it)
#pragma unroll
        for (int et = 0; et < 4; ++et) oacc[it][et] = (f32x4){0.f, 0.f, 0.f, 0.f};
    float mrun[2] = {-1e30f, -1e30f}, lpart[2] = {0.f, 0.f};
    f32x4 sacc[2][8]; bf16x8 pf[2][4];
    {
        u32x4 ra[2], rc[2];
        const bf16_t* cKb = (const bf16_t*)(P.ws + WS_CK); const bf16_t* cVb = (const bf16_t*)(P.ws + WS_CV);
        auto t_load = [&](int kt) {
            if (lat && kt < 4) { const size_t off = ((size_t)(b * 2 + kvh) * 512 + 128 * kt) * 64; tile_load<64>(ra, cKb + off, 64, tid); tile_load<64>(rc, cVb + off, 64, tid); }
            else { const size_t r0 = (size_t)rowbase + 128 * (lat ? kt - 4 : kt); tile_load<64>(ra, kD + r0 * 128 + kvh * 64, 128, tid); tile_load<64>(rc, vD + r0 * 128 + kvh * 64, 128, tid); } };
        auto t_store = [&](int kt) { tile_store<64>(sK + (kt & 1) * 18432, ra, 72, tid); tile_store<64>(sV + (kt & 1) * 18432, rc, 72, tid); };
        t_load(0);
        __syncthreads();
        t_store(0);
        if (nkt > 1) t_load(1);
        __syncthreads();
        for (int kt = 0; kt < nkt; ++kt) {
            const LAS bf16_t* cK = sK + (kt & 1) * 18432; const LAS bf16_t* cV = sV + (kt & 1) * 18432;
#pragma unroll
            for (int jt = 0; jt < 8; ++jt) { f32x4 a0 = {0.f, 0.f, 0.f, 0.f}, a1 = {0.f, 0.f, 0.f, 0.f};
#pragma unroll
                for (int s = 0; s < 2; ++s) { const bf16x8 kf = *(const LAS bf16x8*)(cK + (16 * jt + fr) * 72 + 32 * s + 8 * fq); a0 = MFMA16(kf, qf[0][s], a0); a1 = MFMA16(kf, qf[1][s], a1); }
                sacc[0][jt] = a0; sacc[1][jt] = a1; }
#pragma unroll
            for (int it = 0; it < 2; ++it) {
                float tmax = -1e30f;
#pragma unroll
                for (int jt = 0; jt < 8; ++jt)
#pragma unroll
                    for (int r = 0; r < 4; ++r) tmax = fmaxf(tmax, sacc[it][jt][r]);
                tmax = fq_max(tmax) * 0.18033688011112042f;
                const float mnew = fmaxf(mrun[it], tmax), alpha = __builtin_amdgcn_exp2f(mrun[it] - mnew); float ps = 0.f;
#pragma unroll
                for (int jt = 0; jt < 8; ++jt)
#pragma unroll
                    for (int r = 0; r < 4; ++r) { const float p = __builtin_amdgcn_exp2f(sacc[it][jt][r] * 0.18033688011112042f - mnew); sacc[it][jt][r] = p; ps += p; }
                lpart[it] = lpart[it] * alpha + ps; mrun[it] = mnew;
                if (__builtin_amdgcn_ballot_w64(alpha != 1.f)) {
#pragma unroll
                    for (int et = 0; et < 4; ++et) oacc[it][et] *= alpha; }
                pack_p(sacc[it], pf[it]);
            }
#pragma unroll
            for (int et = 0; et < 4; ++et)
#pragma unroll
                for (int s = 0; s < 4; ++s) {
                    const LAS bf16_t* p0 = cV + (32 * s + 4 * fq + (fr >> 2)) * 72 + 16 * et + 4 * (fr & 3);
                    const s16x4 lo = __builtin_amdgcn_ds_read_tr16_b64_v4i16((LAS s16x4*)p0), hi = __builtin_amdgcn_ds_read_tr16_b64_v4i16((LAS s16x4*)(p0 + 16 * 72));
                    const bf16x8 vf = __builtin_shufflevector(lo, hi, 0, 1, 2, 3, 4, 5, 6, 7);
                    oacc[0][et] = MFMA16(vf, pf[0][s], oacc[0][et]); oacc[1][et] = MFMA16(vf, pf[1][s], oacc[1][et]); }
            if (kt + 1 < nkt) t_store(kt + 1);
            if (kt + 2 < nkt) t_load(kt + 2);
            __syncthreads();
        }
    }
#pragma unroll
    for (int it = 0; it < 2; ++it) {
        const float inv = 1.f / fq_sum(lpart[it]);
        bf16_t* dst = (bf16_t*)(P.ws + WS_H) + (size_t)(launder_v(qrow) + 16 * it) * D_ + 512 + qh * 64 + 4 * fq;
#pragma unroll
        for (int et = 0; et < 4; ++et) { u32x2 w; w.x = pk2(oacc[it][et][0] * inv, oacc[it][et][1] * inv); w.y = pk2(oacc[it][et][2] * inv, oacc[it][et][3] * inv); *(u32x2*)(dst + 16 * et) = w; }
    }
}

DI void rwkv_shift_row(const bf16_t* pB, const float* mu, bf16_t* rB, bf16_t* kB, bf16_t* vB, bf16_t* X, int row, int lane) {
    const int t = seqpos_of_row(row), L = row < MP_ ? 256 : 2048; const bool hp = t > 0, hn = t < L - 1;
    const bf16_t* pr = pB + (size_t)row * 1792;
    u32x2 cu[7], pu[7], nu[7];
#pragma unroll
    for (int g = 0; g < 7; ++g) { const int c = 256 * g + 4 * lane; cu[g] = *(const u32x2*)(pr + c); pu[g] = (u32x2){0u, 0u}; nu[g] = (u32x2){0u, 0u};
        if (hp) pu[g] = *(const u32x2*)(pr - 1792 + c); if (hn) nu[g] = *(const u32x2*)(pr + 1792 + c); }
#pragma unroll
    for (int g = 0; g < 7; ++g) { const int c = 256 * g + 4 * lane;
        const f32x4 m4 = *(const f32x4*)(mu + c);
        float x[4] = {bf_lo(cu[g].x), bf_hi(cu[g].x), bf_lo(cu[g].y), bf_hi(cu[g].y)}; const float pv[4] = {bf_lo(pu[g].x), bf_hi(pu[g].x), bf_lo(pu[g].y), bf_hi(pu[g].y)}, nv[4] = {bf_lo(nu[g].x), bf_hi(nu[g].x), bf_lo(nu[g].y), bf_hi(nu[g].y)};
#pragma unroll
        for (int j = 0; j < 4; ++j) x[j] = x[j] + m4[j] * (0.5f * (pv[j] + nv[j]) - x[j]);
        u32x2 w;
        if (g < 6) { w.x = pk2(x[0], x[1]); w.y = pk2(x[2], x[3]); bf16_t* dst = g < 2 ? rB : (g < 4 ? kB : vB); *(u32x2*)(dst + (size_t)row * 512 + (g & 1) * 256 + 4 * lane) = w; }
        else { const int cc = 4 * lane;
#pragma unroll
            for (int j = 0; j < 4; ++j) x[j] = cc < 64 ? tanhf(x[j]) : (cc < 128 ? x[j] : sigmoid_f(x[j]));
            w.x = pk2(x[0], x[1]); w.y = pk2(x[2], x[3]); *(u32x2*)(X + (size_t)row * 256 + cc) = w; }
    }
}
DI void rwkv_shift_phase(KParams& P, int tid) {
    const int wid = tid >> 6, lane = tid & 63;
    const bf16_t* pB = (const bf16_t*)(P.ws + A_PB); const float* mu = P.in[20];
    bf16_t* rB = (bf16_t*)(P.ws + A_R); bf16_t* kB = (bf16_t*)(P.ws + A_K); bf16_t* vB = (bf16_t*)(P.ws + A_V); bf16_t* X = (bf16_t*)(P.ws + A_X);
    for (int row = blockIdx.x * 8 + wid; row < M_; row += gridDim.x * 8) rwkv_shift_row(pB, mu, rB, kB, vB, X, row, lane);
}
DI float dpp_xor1(float v) { return __int_as_float(__builtin_amdgcn_mov_dpp(__float_as_int(v), 0xB1, 0xf, 0xf, true)); }
DI float dpp_xor2(float v) { return __int_as_float(__builtin_amdgcn_mov_dpp(__float_as_int(v), 0x4E, 0xf, 0xf, true)); }
DI float dpp_hmir(float v) { return __int_as_float(__builtin_amdgcn_mov_dpp(__float_as_int(v), 0x141, 0xf, 0xf, true)); }
DI float sum8(float v) { v += dpp_xor1(v); v += dpp_xor2(v); v += dpp_hmir(v); return v; }
DI float dpp_rmir(float v) { return __int_as_float(__builtin_amdgcn_mov_dpp(__float_as_int(v), 0x140, 0xf, 0xf, true)); }
DI float sum16(float v) { v += dpp_xor1(v); v += dpp_xor2(v); v += dpp_hmir(v); v += dpp_rmir(v); return v; }
DI void rwkv_scan_item(KParams& P, int item, LAS unsigned char* lds, int tid) {
    int b, h, dir, L, rowbase; bool lat;
    if (item < 128) { b = item >> 4; h = (item >> 1) & 7; dir = item & 1; L = 2048; rowbase = MP_ + b * 2048; lat = true; }
    else { const int it = item - 128; b = it >> 4; h = (it >> 1) & 7; dir = it & 1; L = 256; rowbase = b * 256; lat = false; }
    const bf16_t* rB = (const bf16_t*)(P.ws + A_R); const bf16_t* kB = (const bf16_t*)(P.ws + A_K); const bf16_t* vB = (const bf16_t*)(P.ws + A_V);
    const bf16_t* uB = (const bf16_t*)(P.ws + (dir ? A_U1 : A_U0)); const bf16_t* aB = (const bf16_t*)(P.ws + (dir ? A_A1 : A_A0)); bf16_t* y = (bf16_t*)(P.ws + A_Y) + (dir ? (size_t)M_ * 512 : 0);
    LAS float* buf = (LAS float*)lds;
    LAS float* ybuf = (LAS float*)(lds + 98304);
    const int i = tid >> 3, cg = tid & 7, tt_s = tid >> 4, jc = (tid & 15) * 4;
    LAS float* ydst = (cg == 0) ? (ybuf + i) : ((LAS float*)(lds + 114688) + tid);
    f32x2 S[4];
    if (lat) { const float* s0 = P.in[3] + ((size_t)((b * 2 + dir) * 8 + h) * 64 + i) * 64 + 8 * cg; const f32x4 a = *(const f32x4*)s0, c = *(const f32x4*)(s0 + 4);
        S[0] = (f32x2){a[0], a[1]}; S[1] = (f32x2){a[2], a[3]}; S[2] = (f32x2){c[0], c[1]}; S[3] = (f32x2){c[2], c[3]}; }
    else {
#pragma unroll
        for (int q = 0; q < 4; ++q) S[q] = (f32x2){0.f, 0.f}; }
    const f32x4 kk4 = *(const f32x4*)(P.in[26] + h * 64 + jc), ka4 = *(const f32x4*)(P.in[27] + h * 64 + jc);
    u32x2 gr, gk, gv, gu, ga;
    auto gload = [&](int ci) { const int pos = 32 * ci + tt_s; const int t = dir ? L - 1 - pos : pos; const size_t o = (size_t)(rowbase + t) * 512 + h * 64 + jc;
        gr = *(const u32x2*)(rB + o); gk = *(const u32x2*)(kB + o); gv = *(const u32x2*)(vB + o); gu = *(const u32x2*)(uB + o); ga = *(const u32x2*)(aB + o); };
    auto pstore = [&](int bi) { LAS float* bb = buf + bi * 12288 + tt_s * 64 + jc;
        const float k[4] = {bf_lo(gk.x), bf_hi(gk.x), bf_lo(gk.y), bf_hi(gk.y)}, a[4] = {bf_lo(ga.x), bf_hi(ga.x), bf_lo(ga.y), bf_hi(ga.y)}, u[4] = {bf_lo(gu.x), bf_hi(gu.x), bf_lo(gu.y), bf_hi(gu.y)};
        float kv[4]; float ss = 0.f;
#pragma unroll
        for (int j = 0; j < 4; ++j) { kv[j] = k[j] * kk4[j]; ss += kv[j] * kv[j]; }
        ss = sum16(ss);
        const float rn = 1.f / fmaxf(sqrtf(ss), 1e-12f);
        f32x4 w4, a4, b4, d4;
#pragma unroll
        for (int j = 0; j < 4; ++j) { const float kkn = kv[j] * rn; w4[j] = __expf(-u[j]); a4[j] = -kkn; b4[j] = kkn * a[j]; d4[j] = k[j] * (1.f + (a[j] - 1.f) * ka4[j]); }
        *(LAS f32x4*)(bb) = w4; *(LAS f32x4*)(bb + 2048) = a4; *(LAS f32x4*)(bb + 4096) = b4; *(LAS f32x4*)(bb + 6144) = d4;
        *(LAS f32x4*)(bb + 8192) = (f32x4){bf_lo(gr.x), bf_hi(gr.x), bf_lo(gr.y), bf_hi(gr.y)}; *(LAS f32x4*)(bb + 10240) = (f32x4){bf_lo(gv.x), bf_hi(gv.x), bf_lo(gv.y), bf_hi(gv.y)}; };
    const int nch = L >> 5;
    __syncthreads();
    gload(0); pstore(0);
    __syncthreads();
    for (int ci = 0; ci < nch; ++ci) {
        if (ci + 1 < nch) gload(ci + 1);
        const LAS float* bb = buf + (ci & 1) * 12288 + 8 * cg; const LAS float* bvv = buf + (ci & 1) * 12288 + 10240 + i;
        struct SV { f32x4 w0, w1, a0, a1, b0, b1, d0, d1, r0, r1; float vi; };
        auto ld = [&](int tt) { SV v; const LAS float* p = bb + tt * 64;
            v.w0 = *(const LAS f32x4*)(p); v.w1 = *(const LAS f32x4*)(p + 4); v.a0 = *(const LAS f32x4*)(p + 2048); v.a1 = *(const LAS f32x4*)(p + 2052);
            v.b0 = *(const LAS f32x4*)(p + 4096); v.b1 = *(const LAS f32x4*)(p + 4100); v.d0 = *(const LAS f32x4*)(p + 6144); v.d1 = *(const LAS f32x4*)(p + 6148);
            v.r0 = *(const LAS f32x4*)(p + 8192); v.r1 = *(const LAS f32x4*)(p + 8196); v.vi = bvv[tt * 64]; return v; };
        LAS float* ydc = ydst + ((cg == 0) ? (ci & 1) * 2048 : 0);
        SV cur = ld(0);
#pragma unroll 4
        for (int tt = 0; tt < 32; ++tt) {
            const SV nx = ld(tt < 31 ? tt + 1 : 31);
            const f32x2 A[4] = {{cur.a0[0], cur.a0[1]}, {cur.a0[2], cur.a0[3]}, {cur.a1[0], cur.a1[1]}, {cur.a1[2], cur.a1[3]}}, W[4] = {{cur.w0[0], cur.w0[1]}, {cur.w0[2], cur.w0[3]}, {cur.w1[0], cur.w1[1]}, {cur.w1[2], cur.w1[3]}};
            const f32x2 B[4] = {{cur.b0[0], cur.b0[1]}, {cur.b0[2], cur.b0[3]}, {cur.b1[0], cur.b1[1]}, {cur.b1[2], cur.b1[3]}}, D[4] = {{cur.d0[0], cur.d0[1]}, {cur.d0[2], cur.d0[3]}, {cur.d1[0], cur.d1[1]}, {cur.d1[2], cur.d1[3]}};
            const f32x2 R[4] = {{cur.r0[0], cur.r0[1]}, {cur.r0[2], cur.r0[3]}, {cur.r1[0], cur.r1[1]}, {cur.r1[2], cur.r1[3]}};
            const f32x2 t2 = (S[1] * A[1] + S[0] * A[0]) + (S[3] * A[3] + S[2] * A[2]);
            const float sa = sum8(t2[0] + t2[1]);
            const f32x2 sv = {sa, sa}, vv = {cur.vi, cur.vi};
#pragma unroll
            for (int q = 0; q < 4; ++q) { const f32x2 T = S[q] * W[q] + vv * D[q]; S[q] = sv * B[q] + T; }
            const f32x2 u2 = (S[1] * R[1] + S[0] * R[0]) + (S[3] * R[3] + S[2] * R[2]);
            const float yv = sum8(u2[0] + u2[1]);
            ydc[tt * 64] = yv;
            cur = nx; }
        if (ci + 1 < nch) pstore((ci + 1) & 1);
        __syncthreads();
        { const int pos = 32 * ci + tt_s; const int t = dir ? L - 1 - pos : pos; const f32x4 yv = *(const LAS f32x4*)(ybuf + (ci & 1) * 2048 + tt_s * 64 + jc);
            u32x2 w; w.x = pk2(yv[0], yv[1]); w.y = pk2(yv[2], yv[3]); *(u32x2*)(y + (size_t)(rowbase + t) * 512 + h * 64 + jc) = w; }
    }
    if (!lat) { float* op = P.out + OUT_RWKV + ((size_t)((b * 2 + dir) * 8 + h) * 64 + i) * 64 + 8 * cg; *(f32x4*)op = (f32x4){S[0][0], S[0][1], S[1][0], S[1][1]}; *(f32x4*)(op + 4) = (f32x4){S[2][0], S[2][1], S[3][0], S[3][1]}; }
}
DI void rwkv_scan_half_item(KParams& P, int item, LAS unsigned char* lds, int tid) {
    const int b = item >> 5, h = (item >> 2) & 7, dir = (item >> 1) & 1, half = item & 1; const int L = 2048, rowbase = MP_ + b * 2048, nch = 64;
    LAS float* buf = (LAS float*)lds;
    LAS float* ybuf = (LAS float*)(lds + 98304);
    __syncthreads();
    if (tid >= 256) {
        const int lt = tid - 256, jc = (lt & 15) * 4;
        const bf16_t* rB = (const bf16_t*)(P.ws + A_R); const bf16_t* kB = (const bf16_t*)(P.ws + A_K); const bf16_t* vB = (const bf16_t*)(P.ws + A_V);
        const bf16_t* uB = (const bf16_t*)(P.ws + (dir ? A_U1 : A_U0)); const bf16_t* aB = (const bf16_t*)(P.ws + (dir ? A_A1 : A_A0)); bf16_t* y = (bf16_t*)(P.ws + A_Y) + (dir ? (size_t)M_ * 512 : 0);
        const f32x4 kk4 = *(const f32x4*)(P.in[26] + h * 64 + jc), ka4 = *(const f32x4*)(P.in[27] + h * 64 + jc);
        auto stage = [&](int ci) {
            u32x2 gr[2], gk[2], gv[2], gu[2], ga[2];
#pragma unroll
            for (int g = 0; g < 2; ++g) { const int pos = 32 * ci + (lt >> 4) + 16 * g; const int t = dir ? L - 1 - pos : pos; const size_t o = (size_t)(rowbase + t) * 512 + h * 64 + jc;
                gr[g] = *(const u32x2*)(rB + o); gk[g] = *(const u32x2*)(kB + o); gv[g] = *(const u32x2*)(vB + o); gu[g] = *(const u32x2*)(uB + o); ga[g] = *(const u32x2*)(aB + o); }
#pragma unroll
            for (int g = 0; g < 2; ++g) { LAS float* bb = buf + (ci & 1) * 12288 + ((lt >> 4) + 16 * g) * 64 + jc;
                const float k[4] = {bf_lo(gk[g].x), bf_hi(gk[g].x), bf_lo(gk[g].y), bf_hi(gk[g].y)}, a[4] = {bf_lo(ga[g].x), bf_hi(ga[g].x), bf_lo(ga[g].y), bf_hi(ga[g].y)}, u[4] = {bf_lo(gu[g].x), bf_hi(gu[g].x), bf_lo(gu[g].y), bf_hi(gu[g].y)};
                float kv[4]; float ss = 0.f;
#pragma unroll
                for (int j = 0; j < 4; ++j) { kv[j] = k[j] * kk4[j]; ss += kv[j] * kv[j]; }
                ss = sum16(ss);
                const float rn = 1.f / fmaxf(sqrtf(ss), 1e-12f);
                f32x4 w4, a4, b4, d4;
#pragma unroll
                for (int j = 0; j < 4; ++j) { const float kkn = kv[j] * rn; w4[j] = __expf(-u[j]); a4[j] = -kkn; b4[j] = kkn * a[j]; d4[j] = k[j] * (1.f + (a[j] - 1.f) * ka4[j]); }
                *(LAS f32x4*)(bb) = w4; *(LAS f32x4*)(bb + 2048) = a4; *(LAS f32x4*)(bb + 4096) = b4; *(LAS f32x4*)(bb + 6144) = d4;
                *(LAS f32x4*)(bb + 8192) = (f32x4){bf_lo(gr[g].x), bf_hi(gr[g].x), bf_lo(gr[g].y), bf_hi(gr[g].y)}; *(LAS f32x4*)(bb + 10240) = (f32x4){bf_lo(gv[g].x), bf_hi(gv[g].x), bf_lo(gv[g].y), bf_hi(gv[g].y)}; } };
        auto flush = [&](int ci) { const int tok = lt >> 3, r4 = (lt & 7) * 4; const int pos = 32 * ci + tok; const int t = dir ? L - 1 - pos : pos;
            const f32x4 yv = *(const LAS f32x4*)(ybuf + (ci & 1) * 1024 + tok * 32 + r4); u32x2 w; w.x = pk2(yv[0], yv[1]); w.y = pk2(yv[2], yv[3]);
            *(u32x2*)(y + (size_t)(rowbase + t) * 512 + h * 64 + 32 * half + r4) = w; };
        stage(0);
        __syncthreads();
        for (int ci = 0; ci < nch; ++ci) {
            if (ci + 1 < nch) stage(ci + 1);
            if (ci >= 1) flush(ci - 1);
            __syncthreads();
        }
        flush(nch - 1);
    } else {
        const int il = tid >> 3, cg = tid & 7, i = 32 * half + il;
        f32x2 S[4];
        { const float* s0 = P.in[3] + ((size_t)((b * 2 + dir) * 8 + h) * 64 + i) * 64 + 8 * cg; const f32x4 a = *(const f32x4*)s0, c = *(const f32x4*)(s0 + 4);
          S[0] = (f32x2){a[0], a[1]}; S[1] = (f32x2){a[2], a[3]}; S[2] = (f32x2){c[0], c[1]}; S[3] = (f32x2){c[2], c[3]}; }
        LAS float* ydst = (cg == 0) ? (ybuf + il) : ((LAS float*)(lds + 106496) + tid);
        __syncthreads();
        for (int ci = 0; ci < nch; ++ci) {
            const LAS float* bb = buf + (ci & 1) * 12288 + 8 * cg; const LAS float* bvv = buf + (ci & 1) * 12288 + 10240 + i;
            LAS float* ydc = ydst + ((cg == 0) ? (ci & 1) * 1024 : 0);
            struct SV { f32x4 w0, w1, a0, a1, b0, b1, d0, d1, r0, r1; float vi; };
            auto ld = [&](int tt) { SV v; const LAS float* p = bb + tt * 64;
                v.w0 = *(const LAS f32x4*)(p); v.w1 = *(const LAS f32x4*)(p + 4); v.a0 = *(const LAS f32x4*)(p + 2048); v.a1 = *(const LAS f32x4*)(p + 2052);
                v.b0 = *(const LAS f32x4*)(p + 4096); v.b1 = *(const LAS f32x4*)(p + 4100); v.d0 = *(const LAS f32x4*)(p + 6144); v.d1 = *(const LAS f32x4*)(p + 6148);
                v.r0 = *(const LAS f32x4*)(p + 8192); v.r1 = *(const LAS f32x4*)(p + 8196); v.vi = bvv[tt * 64]; return v; };
            SV cur = ld(0);
#pragma unroll 4
            for (int tt = 0; tt < 32; ++tt) {
                const SV nx = ld(tt < 31 ? tt + 1 : 31);
                const f32x2 A[4] = {{cur.a0[0], cur.a0[1]}, {cur.a0[2], cur.a0[3]}, {cur.a1[0], cur.a1[1]}, {cur.a1[2], cur.a1[3]}}, W[4] = {{cur.w0[0], cur.w0[1]}, {cur.w0[2], cur.w0[3]}, {cur.w1[0], cur.w1[1]}, {cur.w1[2], cur.w1[3]}};
                const f32x2 B[4] = {{cur.b0[0], cur.b0[1]}, {cur.b0[2], cur.b0[3]}, {cur.b1[0], cur.b1[1]}, {cur.b1[2], cur.b1[3]}}, D[4] = {{cur.d0[0], cur.d0[1]}, {cur.d0[2], cur.d0[3]}, {cur.d1[0], cur.d1[1]}, {cur.d1[2], cur.d1[3]}};
                const f32x2 R[4] = {{cur.r0[0], cur.r0[1]}, {cur.r0[2], cur.r0[3]}, {cur.r1[0], cur.r1[1]}, {cur.r1[2], cur.r1[3]}};
                const f32x2 t2 = (S[1] * A[1] + S[0] * A[0]) + (S[3] * A[3] + S[2] * A[2]);
                const float sa = sum8(t2[0] + t2[1]);
                const f32x2 sv = {sa, sa}, vv = {cur.vi, cur.vi};
#pragma unroll
                for (int q = 0; q < 4; ++q) { const f32x2 T = S[q] * W[q] + vv * D[q]; S[q] = sv * B[q] + T; }
                const f32x2 u2 = (S[1] * R[1] + S[0] * R[0]) + (S[3] * R[3] + S[2] * R[2]);
                const float yv = sum8(u2[0] + u2[1]);
                ydc[tt * 32] = yv;
                cur = nx; }
            __syncthreads();
        }
    }
}
DI void rwkv_post_phase(KParams& P, int tid) {
    const int wid = tid >> 6, lane = tid & 63;
    const bf16_t* rB = (const bf16_t*)(P.ws + A_R); const bf16_t* kB = (const bf16_t*)(P.ws + A_K); const bf16_t* vB = (const bf16_t*)(P.ws + A_V); const bf16_t* gB = (const bf16_t*)(P.ws + A_G);
    const bf16_t* yA = (const bf16_t*)(P.ws + A_Y); const bf16_t* yBk = yA + (size_t)M_ * 512; bf16_t* mix = (bf16_t*)(P.ws + WS_H);
    const int c = 8 * lane;
    f32x4 lw[2], lb[2], rk[2];
#pragma unroll
    for (int q = 0; q < 2; ++q) { lw[q] = *(const f32x4*)(P.in[29] + c + 4 * q); lb[q] = *(const f32x4*)(P.in[30] + c + 4 * q); rk[q] = *(const f32x4*)(P.in[28] + c + 4 * q); }
    for (int row = blockIdx.x * 8 + wid; row < M_; row += gridDim.x * 8) { const size_t o = (size_t)row * 512 + c;
        const u32x4 ya = *(const u32x4*)(yA + o), yb = *(const u32x4*)(yBk + o);
        const u32x4 ru = *(const u32x4*)(rB + o), ku = *(const u32x4*)(kB + o), vu = *(const u32x4*)(vB + o), gu = *(const u32x4*)(gB + o);
        float yy[8]; float r[8], k[8], v[8], g[8];
#pragma unroll
        for (int q = 0; q < 4; ++q) { yy[2 * q] = bf_lo(ya[q]) + bf_lo(yb[q]); yy[2 * q + 1] = bf_hi(ya[q]) + bf_hi(yb[q]); }
#pragma unroll
        for (int q = 0; q < 4; ++q) { r[2 * q] = bf_lo(ru[q]); r[2 * q + 1] = bf_hi(ru[q]); k[2 * q] = bf_lo(ku[q]); k[2 * q + 1] = bf_hi(ku[q]); v[2 * q] = bf_lo(vu[q]); v[2 * q + 1] = bf_hi(vu[q]); g[2 * q] = bf_lo(gu[q]); g[2 * q + 1] = bf_hi(gu[q]); }
        float s = 0.f, bs = 0.f;
#pragma unroll
        for (int q = 0; q < 8; ++q) { s += yy[q]; bs += r[q] * k[q] * rk[q >> 2][q & 3]; }
        s = sum8(s); bs = sum8(bs); const float mu = s * (1.f / 64.f); float vs = 0.f;
#pragma unroll
        for (int q = 0; q < 8; ++q) { const float d = yy[q] - mu; vs += d * d; }
        vs = sum8(vs); const float rs = rsqrtf(vs * (1.f / 64.f) + 64e-5f);
        float o8[8];
#pragma unroll
        for (int q = 0; q < 8; ++q) o8[q] = ((yy[q] - mu) * rs * lw[q >> 2][q & 3] + lb[q >> 2][q & 3] + bs * v[q]) * g[q];
        u32x4 w; w.x = pk2(o8[0], o8[1]); w.y = pk2(o8[2], o8[3]); w.z = pk2(o8[4], o8[5]); w.w = pk2(o8[6], o8[7]);
        *(u32x4*)(mix + (size_t)row * D_ + 512 + c) = w; }
}
#define XB_TMO      128
#define XB_XCNT(j)  (256  + 64 * (j))
#define XB_XSUB(j)  (1280 + 64 * (j))
#define XB_XGEN(j)  (2304 + 64 * (j))
#define XB_TOP      3328
#define XB_TOPGEN   3392
#define XCD_BAR_WORDS 3456
#define XB_SPIN_CAP (1u << 18)

__device__ __forceinline__ unsigned xb_ld(unsigned* p)              { return __hip_atomic_load(p, __ATOMIC_RELAXED, __HIP_MEMORY_SCOPE_AGENT); }
__device__ __forceinline__ unsigned xb_add(unsigned* p, unsigned v) { return __hip_atomic_fetch_add(p, v, __ATOMIC_RELAXED, __HIP_MEMORY_SCOPE_AGENT); }
__device__ __forceinline__ unsigned xb_xcc_id() { return (unsigned)__builtin_amdgcn_s_getreg((3 << 11) | 20) & 0xFu; }
#define XB_SPIN(cond, bar) do { unsigned _sp = 0; while (cond) { __builtin_amdgcn_s_sleep(1); \
    if ((++_sp & 255u) == 0u) { if (xb_ld(&(bar)[XB_TMO])) break; if (_sp > XB_SPIN_CAP) { atomicAdd(&(bar)[XB_TMO], 1u); break; } } } } while (0)

struct XcdBarrier {
    unsigned* bar; unsigned x;
    volatile LAS unsigned* st;
};

__device__ __forceinline__ XcdBarrier xcd_barrier_post(unsigned* bar, volatile LAS unsigned* st) {
    XcdBarrier b; b.bar = bar; b.x = xb_xcc_id(); b.st = st;
    if (threadIdx.x == 0) (void)xb_add(&bar[XB_XCNT(b.x)], 1u);
    return b;
}
__device__ __forceinline__ void xcd_barrier_complete(unsigned* bar, unsigned x, unsigned& nloc, unsigned& nx) {
    const unsigned G = gridDim.x * gridDim.y * gridDim.z;
    unsigned sum, cnt, mine, sp = 0u;
    for (;;) {
        sum = 0u; cnt = 0u; mine = 0u;
#pragma unroll
        for (unsigned j = 0; j < 16; ++j) { const unsigned c = xb_ld(&bar[XB_XCNT(j)]); sum += c; cnt += (c > 0u) ? 1u : 0u; mine = (j == x) ? c : mine; }
        if (sum == G) break;
        __builtin_amdgcn_s_sleep(1);
        if ((++sp & 255u) == 0u) { if (xb_ld(&bar[XB_TMO])) break; if (sp > XB_SPIN_CAP) { atomicAdd(&bar[XB_TMO], 1u); break; } }
    }
    nloc = mine > 0u ? mine : 1u; nx = cnt > 0u ? cnt : 1u;
}

__device__ __forceinline__ void xcd_barrier(const XcdBarrier& b) {
    asm volatile("s_waitcnt vmcnt(0)" ::: "memory");
    __syncthreads();
    if (threadIdx.x == 0) {
        unsigned* bar = b.bar;
        __builtin_amdgcn_s_waitcnt(0);
        unsigned nloc = b.st[0], nx = b.st[1];
        if (nloc == 0u) { xcd_barrier_complete(bar, b.x, nloc, nx); b.st[0] = nloc; b.st[1] = nx; }
        const unsigned old = xb_add(&bar[XB_XSUB(b.x)], 1u);
        const unsigned gen = old / nloc;
        if (old + 1u == (gen + 1u) * nloc) {
            __builtin_amdgcn_fence(__ATOMIC_RELEASE, "agent");
            asm volatile("s_waitcnt vmcnt(0)" ::: "memory");
            const unsigned og = xb_add(&bar[XB_TOP], 1u);
            const unsigned tg = og / nx;
            if (og + 1u == (tg + 1u) * nx) xb_add(&bar[XB_TOPGEN], 1u);
            else XB_SPIN(xb_ld(&bar[XB_TOPGEN]) == tg, bar);
            __builtin_amdgcn_fence(__ATOMIC_ACQUIRE, "agent");
            xb_add(&bar[XB_XGEN(b.x)], 1u);
            asm volatile("s_waitcnt vmcnt(0)" ::: "memory");
        } else {
            XB_SPIN(xb_ld(&bar[XB_XGEN(b.x)]) == gen, bar);
            __builtin_amdgcn_fence(__ATOMIC_ACQUIRE, "agent");
            asm volatile("s_waitcnt vmcnt(0)" ::: "memory");
        }
    }
    __syncthreads();
}


DI int next_item(unsigned* c, LAS int* slot, int tid) { __syncthreads(); if (tid == 0) *slot = (int)atomicAdd(c, 1u); __syncthreads(); return *slot; }

template <int NN, class Epi> DI void run_gemm(LAS unsigned char* lds, const bf16_t* A, const bf16_t* Bt, int N, int K, const Epi& E) {
    N = launder_s(N); K = launder_s(K);
    pg8::FastOrder<NN> S; S.init(M_, N, (int)gridDim.x, (int)blockIdx.x);
    pg8::gemm_phase<Epi, pg8::FastOrder<NN>>(lds, pg8::Gemm{A, Bt, M_, N, K}, S, E);
    __syncthreads();
}

__global__ void __launch_bounds__(512) fwd_kernel(Params Pk) {
#define P (kparams())
    extern __shared__ __attribute__((aligned(16))) unsigned char smem[];
    LAS unsigned char* lds = (LAS unsigned char*)smem;
    LAS int* slot = (LAS int*)(lds + MISC_OFF + 8064);
#define ws (P.ws)
#define tid (launder_v((int)threadIdx.x))
#define ctr ((unsigned*)(ws + WS_CTR))
#define rope ((float*)(ws + WS_ROPE))
#define mod ((float*)(ws + WS_MOD))
#define XRES (P.out)
#define hb ((bf16_t*)(ws + WS_H))
#define act ((bf16_t*)(ws + A_ACT))
    if (blockIdx.x == 0) { if (threadIdx.x < 16) ctr[threadIdx.x] = 0u; unsigned* bz = (unsigned*)(ws + WS_BAR); for (int i = threadIdx.x; i < XCD_BAR_WORDS; i += 512) bz[i] = 0u; }
    if (blockIdx.x == gridDim.x - 1) for (int e = tid; e < 1024; e += 512) { const int pos = e >> 4, i = e & 15; const float inv = powf(10000.f, -(float)i / 16.f); const float ang = (float)pos * inv; rope[2 * e] = cosf(ang); rope[2 * e + 1] = sinf(ang); }
    { bf16_t* ck = (bf16_t*)(ws + WS_CK); bf16_t* cv = (bf16_t*)(ws + WS_CV); const float* sk = P.in[7]; const float* sv = P.in[8];
      for (int i = blockIdx.x * 512 + threadIdx.x; i < 131072; i += gridDim.x * 512) { const f32x4 a = *(const f32x4*)(sk + 4 * (size_t)i), c = *(const f32x4*)(sv + 4 * (size_t)i); u32x2 w; w.x = pk2(a[0], a[1]); w.y = pk2(a[2], a[3]); *(u32x2*)(ck + 4 * (size_t)i) = w; w.x = pk2(c[0], c[1]); w.y = pk2(c[2], c[3]); *(u32x2*)(cv + 4 * (size_t)i) = w; } }
    mod_phase(P, lds, tid);
    convert_layer(P, 0, lds, tid, 63);
    cg::this_grid().sync();
    { volatile LAS unsigned* st_ = (volatile LAS unsigned*)(lds + MISC_OFF + 8072); if (threadIdx.x < 2) st_[threadIdx.x] = 0u; __syncthreads(); (void)xcd_barrier_post((unsigned*)(ws + WS_BAR), st_); }
#define GBAR() do { XcdBarrier b_; b_.bar = (unsigned*)(ws + WS_BAR); b_.x = xb_xcc_id(); b_.st = (volatile LAS unsigned*)(lds + MISC_OFF + 8072); xcd_barrier(b_); } while (0)
    { constexpr int l = 0;
#define modl (mod + (size_t)launder_s(l) * 9 * 9216)
#define ng (P.in[13] + (size_t)launder_s(l) * 3 * 1024)
        if (l == 1) convert_layer(P, 1, lds, tid, 42);
        norm_phase(l == 0 ? P.in[0] : XRES, l == 0 ? P.in[1] : XRES + (size_t)MP_ * D_, hb, ng, modl, 0, tid);
        GBAR();
        run_gemm<22>(lds, hb, (const bf16_t*)(ws + W_W1A), 2 * DFF_, D_, EpiSwiglu{act});
        GBAR();
        run_gemm<4>(lds, act, (const bf16_t*)(ws + W_W2A), D_, DFF_, EpiResid{l == 0 ? P.in[0] : XRES, l == 0 ? P.in[1] : XRES + (size_t)MP_ * D_, XRES, modl + 2 * 1024, 0.5f});
        GBAR();
        norm_phase(XRES, XRES + (size_t)MP_ * D_, hb, ng + 1024, modl, 3, tid);
        GBAR();
        if (l == 0) {
            run_gemm<13>(lds, hb, (const bf16_t*)(ws + W_WIN), 3328, D_, EpiInEven{ws, rope});
            GBAR();
            for (;;) { const int it = next_item(ctr + 0, slot, tid); if (it >= 640) break;
                if (it < 256) ret_item(P, it + 128, lds, tid); else if (it < 512) ret_state_item(P, it - 256, lds, tid); else ret_item(P, it - 512, lds, tid); }
            rwkv_shift_phase(P, tid);
            GBAR();
            run_gemm<10>(lds, (const bf16_t*)(ws + A_X), (const bf16_t*)(ws + W_WL), 2560, 256,
                     EpiLora{ws, P.in[21], P.in[23]});
            GBAR();
            for (;;) { const int it = next_item(ctr + 1, slot, tid); if (it >= 768 + 720) break; if (it < 256) rwkv_scan_half_item(P, it, lds, tid); else if (it < 768) rwkv_scan_item(P, it - 128, lds, tid); else conv_l1_early_item(P, it - 768, lds, tid); }
            GBAR();
            rwkv_post_phase(P, tid);
            GBAR();
        } else {
            run_gemm<12>(lds, hb, (const bf16_t*)(ws + W_WIN), 3072, D_, EpiInOdd{ws, rope, P.in[36], P.in[33], P.in[34], P.out});
            GBAR();
            for (;;) { const int it = next_item(ctr + 2, slot, tid); if (it >= 1792) break;
                if (it < 512) attn_item(P, it, lds, tid); else if (it < 1024) mlstm_item(P, it - 256, lds, tid); else if (it < 1280) mlstm_state_item(P, it - 1024, lds, tid);
                else if (it < 1536) mlstm_item(P, it - 1280, lds, tid); else attn_item(P, 512 + it - 1536, lds, tid); }
            GBAR();
        }
        run_gemm<4>(lds, hb, (const bf16_t*)(ws + W_WOUT), D_, D_, EpiResid{XRES, XRES + (size_t)MP_ * D_, XRES, modl + 5 * 1024, 1.0f});
        GBAR();
        norm_phase(XRES, XRES + (size_t)MP_ * D_, hb, ng + 2048, modl, 6, tid);
        GBAR();
        run_gemm<22>(lds, hb, (const bf16_t*)(ws + W_W1B), 2 * DFF_, D_, EpiSwiglu{act});
        GBAR();
        run_gemm<4>(lds, act, (const bf16_t*)(ws + W_W2B), D_, DFF_, EpiResid{XRES, XRES + (size_t)MP_ * D_, XRES, modl + 8 * 1024, 0.5f});
        GBAR();
    }
    { constexpr int l = 1;
#define modl (mod + (size_t)launder_s(l) * 9 * 9216)
#define ng (P.in[13] + (size_t)launder_s(l) * 3 * 1024)
        if (l == 1) convert_layer(P, 1, lds, tid, 42);
        norm_phase(l == 0 ? P.in[0] : XRES, l == 0 ? P.in[1] : XRES + (size_t)MP_ * D_, hb, ng, modl, 0, tid);
        GBAR();
        run_gemm<22>(lds, hb, (const bf16_t*)(ws + W_W1A), 2 * DFF_, D_, EpiSwiglu{act});
        GBAR();
        run_gemm<4>(lds, act, (const bf16_t*)(ws + W_W2A), D_, DFF_, EpiResid{l == 0 ? P.in[0] : XRES, l == 0 ? P.in[1] : XRES + (size_t)MP_ * D_, XRES, modl + 2 * 1024, 0.5f});
        GBAR();
        norm_phase(XRES, XRES + (size_t)MP_ * D_, hb, ng + 1024, modl, 3, tid);
        GBAR();
        if (l == 0) {
            run_gemm<13>(lds, hb, (const bf16_t*)(ws + W_WIN), 3328, D_, EpiInEven{ws, rope});
            GBAR();
            for (;;) { const int it = next_item(ctr + 0, slot, tid); if (it >= 640) break;
                if (it < 256) ret_item(P, it + 128, lds, tid); else if (it < 512) ret_state_item(P, it - 256, lds, tid); else ret_item(P, it - 512, lds, tid); }
            rwkv_shift_phase(P, tid);
            GBAR();
            run_gemm<10>(lds, (const bf16_t*)(ws + A_X), (const bf16_t*)(ws + W_WL), 2560, 256,
                     EpiLora{ws, P.in[21], P.in[23]});
            GBAR();
            for (;;) { const int it = next_item(ctr + 1, slot, tid); if (it >= 768 + 720) break; if (it < 256) rwkv_scan_half_item(P, it, lds, tid); else if (it < 768) rwkv_scan_item(P, it - 128, lds, tid); else conv_l1_early_item(P, it - 768, lds, tid); }
            GBAR();
            rwkv_post_phase(P, tid);
            GBAR();
        } else {
            run_gemm<12>(lds, hb, (const bf16_t*)(ws + W_WIN), 3072, D_, EpiInOdd{ws, rope, P.in[36], P.in[33], P.in[34], P.out});
            GBAR();
            for (;;) { const int it = next_item(ctr + 2, slot, tid); if (it >= 1792) break;
                if (it < 512) attn_item(P, it, lds, tid); else if (it < 1024) mlstm_item(P, it - 256, lds, tid); else if (it < 1280) mlstm_state_item(P, it - 1024, lds, tid);
                else if (it < 1536) mlstm_item(P, it - 1280, lds, tid); else attn_item(P, 512 + it - 1536, lds, tid); }
            GBAR();
        }
        run_gemm<4>(lds, hb, (const bf16_t*)(ws + W_WOUT), D_, D_, EpiResid{XRES, XRES + (size_t)MP_ * D_, XRES, modl + 5 * 1024, 1.0f});
        GBAR();
        norm_phase(XRES, XRES + (size_t)MP_ * D_, hb, ng + 2048, modl, 6, tid);
        GBAR();
        run_gemm<22>(lds, hb, (const bf16_t*)(ws + W_W1B), 2 * DFF_, D_, EpiSwiglu{act});
        GBAR();
        run_gemm<4>(lds, act, (const bf16_t*)(ws + W_W2B), D_, DFF_, EpiResid{XRES, XRES + (size_t)MP_ * D_, XRES, modl + 8 * 1024, 0.5f});
        GBAR();
    }
    final_norm_phase(XRES, P.in[37], tid);
#undef tid
#undef GBAR
#undef modl
#undef ng
#undef ctr
#undef rope
#undef mod
#undef XRES
#undef hb
#undef act
#undef ws
#undef P
}

extern "C" void kernel_launch(void* const* d_in, const int* in_sizes, int n_in, void* d_out, int out_size, void* d_ws, size_t ws_size, hipStream_t stream) {
    static int grid_blocks = 0;
    if (grid_blocks == 0) {
        if (n_in != 38 || ws_size < WS_NEED) { fprintf(stderr, "kernel_launch: need 38 inputs and %zu bytes of workspace, got %d / %zu\n", (size_t)WS_NEED, n_in, ws_size); grid_blocks = -1; return; }
        int dev = 0, cus = 0, per_cu = 0;
        hipGetDevice(&dev); hipDeviceGetAttribute(&cus, hipDeviceAttributeMultiprocessorCount, dev);
        if (hipFuncSetAttribute((const void*)fwd_kernel, hipFuncAttributeMaxDynamicSharedMemorySize, LDS_BYTES) != hipSuccess) { fprintf(stderr, "kernel_launch: hipFuncSetAttribute failed\n"); grid_blocks = -1; return; }
        if (hipOccupancyMaxActiveBlocksPerMultiprocessor(&per_cu, (const void*)fwd_kernel, 512, LDS_BYTES) != hipSuccess || per_cu < 1) { fprintf(stderr, "kernel_launch: occupancy query failed (%d)\n", per_cu); grid_blocks = -1; return; }
        grid_blocks = cus * per_cu;
    }
    if (grid_blocks < 0) return;
    Params p{};
    for (int i = 0; i < 38; ++i) p.in[i] = (const float*)d_in[i];
    p.out = (float*)d_out; p.ws = (unsigned char*)d_ws;
    void* args[] = {&p};
    hipError_t e = hipLaunchCooperativeKernel((const void*)fwd_kernel, dim3(grid_blocks), dim3(512), args, LDS_BYTES, stream);
    if (e != hipSuccess) fprintf(stderr, "cooperative launch failed: %s (grid %d)\n", hipGetErrorString(e), grid_blocks);
}
```

```cpp
#include <hip/hip_runtime.h>
#include <hip/hip_cooperative_groups.h>
#include <cstdio>
namespace cg = cooperative_groups;

#define DI __device__ __forceinline__
#define LAS __attribute__((address_space(3)))
typedef unsigned short bf16_t;
typedef short s16x4 __attribute__((ext_vector_type(4)));
typedef float f32x2 __attribute__((ext_vector_type(2)));
typedef unsigned u32x2 __attribute__((ext_vector_type(2)));
typedef __bf16 bf2_t __attribute__((ext_vector_type(2)));

constexpr int M_ = 24576, MP_ = 8192, D_ = 1024, DFF_ = 2816;
constexpr int LDS_BYTES = 139264;
constexpr int MISC_OFF = 131072;

DI unsigned pk2(float a, float b) { f32x2 v = {a, b}; bf2_t r = __builtin_convertvector(v, bf2_t); return __builtin_bit_cast(unsigned, r); }
DI float bf_lo(unsigned u) { return __uint_as_float(u << 16); }
DI float bf_hi(unsigned u) { return __uint_as_float(u & 0xffff0000u); }
DI float bf2f(bf16_t h) { return __uint_as_float(((unsigned)h) << 16); }
DI float silu_f(float x) { return x * __builtin_amdgcn_rcpf(1.f + __expf(-x)); }
DI float sigmoid_f(float x) { return __builtin_amdgcn_rcpf(1.f + __expf(-x)); }
DI float softplus_f(float z) { return fmaxf(z, 0.f) + __logf(1.f + __expf(-fabsf(z))); }
DI float wave_sum(float v) { v += __shfl_xor(v, 32); v += __shfl_xor(v, 16); v += __shfl_xor(v, 8); v += __shfl_xor(v, 4); v += __shfl_xor(v, 2); v += __shfl_xor(v, 1); return v; }
DI float fq_sum(float v) { unsigned u = __float_as_uint(v); const auto a = __builtin_amdgcn_permlane16_swap(u, u, false, false); v = __uint_as_float(a[0]) + __uint_as_float(a[1]);
    u = __float_as_uint(v); const auto b = __builtin_amdgcn_permlane32_swap(u, u, false, false); return __uint_as_float(b[0]) + __uint_as_float(b[1]); }
DI float fq_max(float v) { unsigned u = __float_as_uint(v); const auto a = __builtin_amdgcn_permlane16_swap(u, u, false, false); v = fmaxf(__uint_as_float(a[0]), __uint_as_float(a[1]));
    u = __float_as_uint(v); const auto b = __builtin_amdgcn_permlane32_swap(u, u, false, false); return fmaxf(__uint_as_float(b[0]), __uint_as_float(b[1])); }
DI int cond_of_row(int row) { return row < MP_ ? 0 : 1 + ((row - MP_) >> 11); }
DI int seqpos_of_row(int row) { return row < MP_ ? (row & 255) : ((row - MP_) & 2047); }

DI int launder_v(int v) { asm volatile("" : "+v"(v)); return v; }
DI int launder_s(int v) { asm volatile("" : "+s"(v)); return v; }
struct Params { const float* in[38]; float* out; unsigned char* ws; };

typedef __attribute__((address_space(4))) const Params KParams;
DI KParams& kparams() { KParams* p = (KParams*)__builtin_amdgcn_kernarg_segment_ptr(); asm volatile("" : "+s"(p)); return *p; }
constexpr size_t WS_CTR = 0, WS_ROPE = 256, WS_MOD = 16384, WS_BAR = 786432, WS_W = 1048576;
constexpr size_t W_W1A = WS_W, W_W1B = W_W1A + 11534336, W_W2A = W_W1B + 11534336, W_W2B = W_W2A + 5767168, W_WIN = W_W2B + 5767168,
                 W_WOUT = W_WIN + 6815744, W_WL = W_WOUT + 2097152, WS_H = W_WL + 1310720, WS_AR = WS_H + 50331648;
constexpr size_t SZ512 = (size_t)M_ * 512 * 2;
constexpr size_t A_R = WS_AR, A_K = A_R + SZ512, A_V = A_K + SZ512, A_X = A_V + SZ512, A_Z = A_X + (size_t)M_ * 256 * 2;
constexpr size_t A_QA = A_Z, A_KA = A_QA + (size_t)M_ * 256 * 2, A_VA = A_KA + (size_t)M_ * 256 * 2, A_GA = A_VA + SZ512, A_PB = A_GA + SZ512;
constexpr size_t A_U0 = A_Z, A_U1 = A_U0 + SZ512, A_A0 = A_U1 + SZ512, A_A1 = A_A0 + SZ512, A_G = A_A1 + SZ512, A_Y = A_G + SZ512, A_END = A_Y + 2 * SZ512;
constexpr size_t O_QC = WS_AR, O_KC = O_QC + SZ512, O_VC = O_KC + SZ512, O_OC = O_VC + SZ512, O_QD = O_OC + SZ512,
                 O_KD = O_QD + SZ512, O_VD = O_KD + (size_t)M_ * 128 * 2, O_GT = O_VD + (size_t)M_ * 128 * 2;
constexpr size_t A_ACT = WS_AR;
constexpr size_t WS_CK = A_END, WS_CV = WS_CK + 1048576, WS_NEED = WS_CV + 1048576;
constexpr size_t OUT_RET = 25165824, OUT_RWKV = 27262976, OUT_MC = 29360128, OUT_MN = 33554432, OUT_MM = 33587200, OUT_CK = 33587456, OUT_CV = 34636032;
typedef short bf16x8 __attribute__((ext_vector_type(8)));
typedef float f32x4 __attribute__((ext_vector_type(4)));
typedef unsigned u32x4 __attribute__((ext_vector_type(4)));
namespace pg8 {
#define PG8_LAS __attribute__((address_space(3)))
typedef unsigned short bf16_t;
typedef short bf16x8 __attribute__((ext_vector_type(8)));
typedef float f32x4 __attribute__((ext_vector_type(4)));
typedef unsigned u32x4 __attribute__((ext_vector_type(4)));
constexpr int BM = 256, BK = 64, HALF = 128, HTB = HALF * BK * 2  , STAGE_BYTES = 8 * HTB, NXCD = 8, WGM = 8;

__host__ __device__ __forceinline__ int lds_byte(int r, int c) { const int st = (r >> 4) * 2 + (c >> 5), rr = r & 15, cc = c & 31, ob = rr * 64 + cc * 2; return st * 1024 + (ob ^ (((ob >> 9) & 1) << 5)); }
__host__ __device__ __forceinline__ void stage_rc(int b, int& R, int& C) { const int st = b / 1024, sb = b % 1024, swz = sb ^ (((sb >> 9) & 1) << 5); R = (st >> 1) * 16 + swz / 64; C = (st & 1) * 32 + (swz % 64) / 2; }
__host__ __device__ __forceinline__ int perm32(int rho) { const int n = rho >> 4, i = rho & 15; return 8 * (i >> 2) + 4 * n + (i & 3); }

struct Unit { int pm, pn; };
struct Gemm { const bf16_t* A; const bf16_t* Bt; int M, N, K; };

struct StaticOrder {
    int nM, nN, nwg, G, c;
    __host__ __device__ void init(int M, int N, int G_, int c_) { nM = M / BM; nN = N / BM; nwg = nM * nN; G = G_; c = c_; }
    __host__ __device__ bool next(int i, Unit& u) const {
        const long L = (long)i * G + c; if (L >= nwg) return false;
        int wgid = (int)L; { const int q = nwg / NXCD, r = nwg % NXCD, xcd = wgid % NXCD, off = wgid / NXCD; wgid = (xcd < r ? xcd * (q + 1) : r * (q + 1) + (xcd - r) * q) + off; }
        const int nig = WGM * nN, gid = wgid / nig, fm = gid * WGM, gsz = (nM - fm) < WGM ? (nM - fm) : WGM;
        u.pm = fm + ((wgid % nig) % gsz); u.pn = (wgid % nig) / gsz; return true;
    }
    __device__ __forceinline__ void a_ready(const Unit&) const {}
    __device__ __forceinline__ void done(const Unit&) const {}
};
template <int NN> struct FastOrder {
    int G, c;
    __device__ __forceinline__ void init(int, int, int G_, int c_) { G = G_; c = c_; }
    __device__ __forceinline__ bool next(int i, Unit& u) const {
        constexpr int nwg = 96 * NN, q = nwg / NXCD, r = nwg % NXCD, nig = WGM * NN;
        const int L = i * G + c; if (L >= nwg) return false;
        const int xcd = L & 7, off = L >> 3; const int wgid = (xcd < r ? xcd * (q + 1) : r * (q + 1) + (xcd - r) * q) + off;
        const int gid = wgid / nig, rem = wgid - gid * nig;
        u.pm = gid * WGM + (rem & 7); u.pn = rem >> 3; return true;
    }
    __device__ __forceinline__ void a_ready(const Unit&) const {}
    __device__ __forceinline__ void done(const Unit&) const {}
};
template <class Epi, class Sched>
__device__ __forceinline__ void gemm_phase(PG8_LAS unsigned char* lds, const Gemm g, const Sched& S, const Epi& E) {
    const int tid = launder_v((int)threadIdx.x), wid = __builtin_amdgcn_readfirstlane(tid >> 6), lane = tid & 63, wr = wid >> 2, wc = wid & 3, fr = lane & 15, fq = lane >> 4;
    const int K = g.K, nt = K / BK;
    unsigned voffA[2], voffB[2];
#pragma unroll
    for (int i = 0; i < 2; ++i) { int R, C; stage_rc(tid * 16 + i * 8192, R, C); const int Rb = Epi::PERM ? ((R & ~31) + perm32(R & 31)) : R;
        voffA[i] = (unsigned)(R * K + C) * 2u; voffB[i] = (unsigned)(Rb * K + C) * 2u; }
    const size_t kstep = (size_t)(BK * 2);
    const size_t hstep = (size_t)HALF * K * 2;
    const size_t tstep = 2 * hstep;
    const unsigned ldsw = (unsigned)wid * 1024u;
    const int aoff = lds_byte(wr * 64 + fr, fq * 8), boff = lds_byte(wc * 32 + fr, fq * 8);
#define PG8_SA(b, h) (((b) * 2 + (h)) * HTB)
#define PG8_SB(b, h) ((4 + (b) * 2 + (h)) * HTB)
#define PG8_STAGE(bufoff, gbase, voff) do { _Pragma("unroll") for (int _i = 0; _i < 2; ++_i) \
        __builtin_amdgcn_global_load_lds((const unsigned*)((const char*)(gbase) + (voff)[_i]), (PG8_LAS unsigned*)(lds + (bufoff) + ldsw + _i * 8192), 16, 0, 0); } while (0)
#define PG8_LDA(dst, b, h) do { _Pragma("unroll") for (int m = 0; m < 4; ++m) _Pragma("unroll") for (int k = 0; k < 2; ++k) dst[m][k] = *(const PG8_LAS bf16x8*)(lds + PG8_SA(b, h) + aoff + m * 2048 + k * 1024); } while (0)
#define PG8_LDB(dst, b, h) do { _Pragma("unroll") for (int n = 0; n < 2; ++n) _Pragma("unroll") for (int k = 0; k < 2; ++k) dst[n][k] = *(const PG8_LAS bf16x8*)(lds + PG8_SB(b, h) + boff + n * 2048 + k * 1024); } while (0)
#define PG8_MMA(ai, bj, At, Bt) do { __builtin_amdgcn_s_setprio(1); _Pragma("unroll") for (int m = 0; m < 4; ++m) _Pragma("unroll") for (int n = 0; n < 2; ++n) _Pragma("unroll") for (int k = 0; k < 2; ++k) \
        acc[ai][bj][m][n] = __builtin_amdgcn_mfma_f32_16x16x32_bf16(Bt[n][k], At[m][k], acc[ai][bj][m][n], 0, 0, 0); __builtin_amdgcn_s_setprio(0); } while (0)
#define PG8_WAIT_V(n) asm volatile("s_waitcnt vmcnt(" #n ")" ::: "memory")
#define PG8_WAIT_L(n) asm volatile("s_waitcnt lgkmcnt(" #n ")" ::: "memory")
#define PG8_BAR __builtin_amdgcn_s_barrier()
#define PG8_SCHED __builtin_amdgcn_sched_barrier(0)
    Unit cur, nxt; int ui = 0;
    if (!S.next(0, cur)) return;
    f32x4 acc[2][2][4][2];
#pragma unroll
    for (int a = 0; a < 2; ++a)
#pragma unroll
        for (int b = 0; b < 2; ++b)
#pragma unroll
            for (int m = 0; m < 4; ++m)
#pragma unroll
                for (int n = 0; n < 2; ++n) acc[a][b][m][n] = (f32x4){0.f, 0.f, 0.f, 0.f};
    bf16x8 At[4][2], B0[2][2], B1[2][2];
    const char* cA = (const char*)g.A + (size_t)cur.pm * tstep; const char* cB = (const char*)g.Bt + (size_t)cur.pn * tstep;
    S.a_ready(cur);
    PG8_STAGE(PG8_SB(0, 0), cB, voffB); PG8_STAGE(PG8_SA(0, 0), cA, voffA); PG8_STAGE(PG8_SB(0, 1), cB + hstep, voffB); PG8_STAGE(PG8_SA(0, 1), cA + hstep, voffA);
    if (wr == 1) PG8_BAR;
    PG8_WAIT_V(4); PG8_BAR;
    PG8_STAGE(PG8_SB(1, 0), cB + kstep, voffB); PG8_STAGE(PG8_SA(1, 0), cA + kstep, voffA); PG8_STAGE(PG8_SB(1, 1), cB + hstep + kstep, voffB);
    PG8_WAIT_V(6); PG8_BAR;
    for (;;) {
        const bool has_next = S.next(ui + 1, nxt);
        const char* nA = has_next ? (const char*)g.A + (size_t)nxt.pm * tstep : cA; const char* nB = has_next ? (const char*)g.Bt + (size_t)nxt.pn * tstep : cB;
        for (int t = 0; t < nt; t += 2) {
            const bool last = (t == nt - 2);
            const char* a1 = cA + (size_t)(t + 1) * kstep;
            const char* a2 = last ? nA : cA + (size_t)(t + 2) * kstep; const char* b2 = last ? nB : cB + (size_t)(t + 2) * kstep;
            const char* a3 = a2 + kstep; const char* b3 = b2 + kstep;
            if (last && has_next) S.a_ready(nxt);
            PG8_LDB(B0, 0, 0); PG8_SCHED; PG8_LDA(At, 0, 0); PG8_STAGE(PG8_SA(1, 1), a1 + hstep, voffA);
            PG8_WAIT_L(8); PG8_BAR; PG8_WAIT_L(0); PG8_MMA(0, 0, At, B0); PG8_BAR; PG8_SCHED;
            PG8_LDB(B1, 0, 1); PG8_STAGE(PG8_SB(0, 0), b2, voffB);
            PG8_BAR; PG8_WAIT_L(0); PG8_MMA(0, 1, At, B1); PG8_BAR;
            PG8_LDA(At, 0, 1); PG8_STAGE(PG8_SA(0, 0), a2, voffA);
            PG8_BAR; PG8_WAIT_L(0); PG8_MMA(1, 0, At, B0); PG8_BAR; PG8_SCHED;
            PG8_STAGE(PG8_SB(0, 1), b2 + hstep, voffB);
            PG8_WAIT_V(6); PG8_BAR; PG8_MMA(1, 1, At, B1); PG8_BAR;
            PG8_LDB(B0, 1, 0); PG8_SCHED; PG8_LDA(At, 1, 0); PG8_STAGE(PG8_SA(0, 1), a2 + hstep, voffA);
            PG8_WAIT_L(8); PG8_BAR; PG8_WAIT_L(0); PG8_MMA(0, 0, At, B0); PG8_BAR; PG8_SCHED;
            PG8_LDB(B1, 1, 1); PG8_STAGE(PG8_SB(1, 0), b3, voffB);
            PG8_BAR; PG8_WAIT_L(0); PG8_MMA(0, 1, At, B1); PG8_BAR;
            PG8_LDA(At, 1, 1); PG8_STAGE(PG8_SA(1, 0), a3, voffA);
            PG8_BAR; PG8_WAIT_L(0); PG8_MMA(1, 0, At, B0); PG8_BAR; PG8_SCHED;
            PG8_STAGE(PG8_SB(1, 1), b3 + hstep, voffB);
            PG8_WAIT_V(6); PG8_BAR; PG8_MMA(1, 1, At, B1); PG8_BAR;
        }
        if constexpr (!Epi::AFTER_DRAIN) { E(acc, cur, wr, wc, fr, fq); S.done(cur); }
        if (!has_next) break;
#pragma unroll
        for (int a = 0; a < 2; ++a)
#pragma unroll
            for (int b = 0; b < 2; ++b)
#pragma unroll
                for (int m = 0; m < 4; ++m)
#pragma unroll
                    for (int n = 0; n < 2; ++n) acc[a][b][m][n] = (f32x4){0.f, 0.f, 0.f, 0.f};
        cur = nxt; cA = nA; cB = nB; ++ui;
    }
    PG8_WAIT_V(0);
    if (wr == 0) PG8_BAR;
    PG8_BAR;
    if constexpr (Epi::AFTER_DRAIN) { E.fused(acc, cur, wr, wc, fr, fq, lds, wid, lane); S.done(cur); }
#undef PG8_SA
#undef PG8_SB
#undef PG8_STAGE
#undef PG8_LDA
#undef PG8_LDB
#undef PG8_MMA
#undef PG8_WAIT_V
#undef PG8_WAIT_L
#undef PG8_BAR
#undef PG8_SCHED
}
}
using pg8::Unit;
typedef f32x4 Acc[2][2][4][2];

template <class F> DI void store_tile_bf16(const Acc& acc, bf16_t* dst, int ld, int coloff, const Unit& u, int wr, int wc, int fr, int fq, F f) {
    const int row0 = u.pm * 256 + wr * 64 + fr, col0 = coloff + wc * 32 + 4 * fq;
#pragma unroll
    for (int ai = 0; ai < 2; ++ai)
#pragma unroll
        for (int m = 0; m < 4; ++m) { bf16_t* rp = dst + (size_t)(row0 + ai * 128 + m * 16) * ld + col0;
#pragma unroll
            for (int bj = 0; bj < 2; ++bj)
#pragma unroll
                for (int n = 0; n < 2; ++n) { const f32x4 v = acc[ai][bj][m][n]; u32x2 w; w.x = pk2(f(v[0]), f(v[1])); w.y = pk2(f(v[2]), f(v[3])); *(u32x2*)(rp + bj * 128 + n * 16) = w; } }
}

struct EpiSwiglu {
    static constexpr bool PERM = false, AFTER_DRAIN = false;
    bf16_t* act;
    DI void operator()(const Acc& acc, const Unit& u, int wr, int wc, int fr, int fq) const {
        const int row0 = u.pm * 256 + wr * 64 + fr, col0 = u.pn * 128 + wc * 32 + 4 * fq;
#pragma unroll
        for (int ai = 0; ai < 2; ++ai)
#pragma unroll
            for (int m = 0; m < 4; ++m) { bf16_t* rp = act + (size_t)(row0 + ai * 128 + m * 16) * DFF_ + col0;
#pragma unroll
                for (int n = 0; n < 2; ++n) { const f32x4 g = acc[ai][0][m][n], up = acc[ai][1][m][n]; u32x2 w;
                    w.x = pk2(silu_f(g[0]) * up[0], silu_f(g[1]) * up[1]); w.y = pk2(silu_f(g[2]) * up[2], silu_f(g[3]) * up[3]); *(u32x2*)(rp + n * 16) = w; } }
    }
};

struct EpiResid {
    static constexpr bool PERM = false, AFTER_DRAIN = false;
    const float* xin_p; const float* xin_s; float* xout; const float* gate; float scale;
    DI void operator()(const Acc& acc, const Unit& u, int wr, int wc, int fr, int fq) const {
        const int row0 = u.pm * 256 + wr * 64 + fr, col0 = u.pn * 256 + wc * 32 + 4 * fq;
        const int ci = u.pm < 32 ? 0 : 1 + ((u.pm - 32) >> 3);
        const float* gt = gate + (size_t)ci * 9216 + col0;
        f32x4 gv[2][2];
#pragma unroll
        for (int bj = 0; bj < 2; ++bj)
#pragma unroll
            for (int n = 0; n < 2; ++n) gv[bj][n] = *(const f32x4*)(gt + bj * 128 + n * 16) * scale;
#pragma unroll
        for (int ai = 0; ai < 2; ++ai)
#pragma unroll
            for (int m = 0; m < 4; ++m) { const int row = row0 + ai * 128 + m * 16;
                const float* ip = (row < MP_ ? xin_p + (size_t)row * D_ : xin_s + (size_t)(row - MP_) * D_) + col0; float* op = xout + (size_t)row * D_ + col0;
#pragma unroll
                for (int bj = 0; bj < 2; ++bj)
#pragma unroll
                    for (int n = 0; n < 2; ++n) { const f32x4 xv = *(const f32x4*)(ip + bj * 128 + n * 16); *(f32x4*)(op + bj * 128 + n * 16) = xv + gv[bj][n] * acc[ai][bj][m][n]; } }
    }
};

DI void rope_pair(f32x4& x1, f32x4& x2, const float* tab, int pos, int fq) {
    const f32x4 t0 = *(const f32x4*)(tab + (pos * 16 + 4 * fq) * 2), t1 = *(const f32x4*)(tab + (pos * 16 + 4 * fq) * 2 + 4);
    const float c[4] = {t0[0], t0[2], t1[0], t1[2]}, s[4] = {t0[1], t0[3], t1[1], t1[3]};
#pragma unroll
    for (int j = 0; j < 4; ++j) { const float a = x1[j], b = x2[j]; x1[j] = a * c[j] - b * s[j]; x2[j] = a * s[j] + b * c[j]; }
}

struct EpiInEven {
    static constexpr bool PERM = false, AFTER_DRAIN = false;
    unsigned char* wsb; const float* rope;
    DI void operator()(const Acc& acc, const Unit& u, int wr, int wc, int fr, int fq) const {
        const int pn = u.pn;
        if (pn < 2) {
            bf16_t* dst = (bf16_t*)(wsb + (pn == 0 ? A_QA : A_KA)); const float sc = pn == 0 ? 1.f : 0.125f; const bool lat = u.pm >= 32;
            const int row0 = u.pm * 256 + wr * 64 + fr, col0 = wc * 32 + 4 * fq;
#pragma unroll
            for (int ai = 0; ai < 2; ++ai)
#pragma unroll
                for (int m = 0; m < 4; ++m) { const int row = row0 + ai * 128 + m * 16; const int t = (row - MP_) & 2047; const int pos = (wc & 1) ? (t & 63) : (t >> 6);
#pragma unroll
                    for (int bj = 0; bj < 2; ++bj) { f32x4 x1 = acc[ai][bj][m][0], x2 = acc[ai][bj][m][1];
                        if (lat) rope_pair(x1, x2, rope, pos, fq);
                        bf16_t* rp = dst + (size_t)row * 256 + bj * 128 + col0; u32x2 w;
                        w.x = pk2(x1[0] * sc, x1[1] * sc); w.y = pk2(x1[2] * sc, x1[3] * sc); *(u32x2*)rp = w;
                        w.x = pk2(x2[0] * sc, x2[1] * sc); w.y = pk2(x2[2] * sc, x2[3] * sc); *(u32x2*)(rp + 16) = w; } }
        } else if (pn < 4) { store_tile_bf16(acc, (bf16_t*)(wsb + A_VA), 512, (pn - 2) * 256, u, wr, wc, fr, fq, [](float x) { return x; });
        } else if (pn < 6) { store_tile_bf16(acc, (bf16_t*)(wsb + A_GA), 512, (pn - 4) * 256, u, wr, wc, fr, fq, [](float x) { return silu_f(x); });
        } else { store_tile_bf16(acc, (bf16_t*)(wsb + A_PB), 1792, (pn - 6) * 256, u, wr, wc, fr, fq, [](float x) { return x; }); }
    }
};

struct EpiInOdd {
    static constexpr bool PERM = false, AFTER_DRAIN = false;
    unsigned char* wsb; const float* rope; const float* qk_gain; const float* ibias; const float* fbias; float* outb;
    DI void operator()(const Acc& acc, const Unit& u, int wr, int wc, int fr, int fq) const {
        const int pn = u.pn;
        if (pn < 2) { store_tile_bf16(acc, (bf16_t*)(wsb + O_QC), 512, pn * 256, u, wr, wc, fr, fq, [](float x) { return x; });
        } else if (pn < 4) { store_tile_bf16(acc, (bf16_t*)(wsb + O_KC), 512, (pn - 2) * 256, u, wr, wc, fr, fq, [](float x) { return x * 0.08838834764831845f; });
        } else if (pn < 6) { store_tile_bf16(acc, (bf16_t*)(wsb + O_VC), 512, (pn - 4) * 256, u, wr, wc, fr, fq, [](float x) { return x; });
        } else if (pn < 8) { store_tile_bf16(acc, (bf16_t*)(wsb + O_OC), 512, (pn - 6) * 256, u, wr, wc, fr, fq, [](float x) { return sigmoid_f(x); });
        } else if (pn < 11) {
            const bool lat = u.pm >= 32; const bool isv = (pn == 10) && (wc >= 2); const bool isk = (pn == 10) && (wc < 2);
            const float* gain = qk_gain + (isk ? 64 : 0);
            const int row0 = u.pm * 256 + wr * 64 + fr;
#pragma unroll
            for (int ai = 0; ai < 2; ++ai)
#pragma unroll
                for (int m = 0; m < 4; ++m) { const int row = row0 + ai * 128 + m * 16;
                    f32x4 v[2][2];
#pragma unroll
                    for (int bj = 0; bj < 2; ++bj)
#pragma unroll
                        for (int n = 0; n < 2; ++n) v[bj][n] = acc[ai][bj][m][n];
                    if (!isv) {
                        float ss = 0.f;
#pragma unroll
                        for (int bj = 0; bj < 2; ++bj)
#pragma unroll
                            for (int n = 0; n < 2; ++n)
#pragma unroll
                                for (int j = 0; j < 4; ++j) ss += v[bj][n][j] * v[bj][n][j];
                        ss = fq_sum(ss);
                        const float rs = rsqrtf(ss * (1.f / 64.f) + 1e-6f);
#pragma unroll
                        for (int bj = 0; bj < 2; ++bj)
#pragma unroll
                            for (int n = 0; n < 2; ++n) v[bj][n] = v[bj][n] * rs * *(const f32x4*)(gain + 32 * bj + 16 * n + 4 * fq);
                    }
                    if (!lat && pn == 10) {
                        const int b = row >> 8, t = row & 255, hh = wc & 1; float* op = outb + (isk ? OUT_CK : OUT_CV) + ((size_t)(b * 2 + hh) * 256 + t) * 64 + 4 * fq;
#pragma unroll
                        for (int bj = 0; bj < 2; ++bj)
#pragma unroll
                            for (int n = 0; n < 2; ++n) *(f32x4*)(op + 32 * bj + 16 * n) = v[bj][n];
                    }
                    if (lat && !isv) { const int t = (row - MP_) & 2047; rope_pair(v[0][0], v[0][1], rope, t >> 6, fq); rope_pair(v[1][0], v[1][1], rope, t & 63, fq); }
                    bf16_t* rp;
                    if (pn < 10) rp = (bf16_t*)(wsb + O_QD) + (size_t)row * 512 + (4 * (pn - 8) + wc) * 64 + 4 * fq;
                    else rp = (bf16_t*)(wsb + (isk ? O_KD : O_VD)) + (size_t)row * 128 + (wc & 1) * 64 + 4 * fq;
#pragma unroll
                    for (int bj = 0; bj < 2; ++bj)
#pragma unroll
                        for (int n = 0; n < 2; ++n) { u32x2 w; w.x = pk2(v[bj][n][0], v[bj][n][1]); w.y = pk2(v[bj][n][2], v[bj][n][3]); *(u32x2*)(rp + 32 * bj + 16 * n) = w; }
                }
        } else {
            if (wc == 0) {
                const int row0 = u.pm * 256 + wr * 64 + fr; const int c0 = 4 * fq;
                const f32x4 bias = c0 < 8 ? *(const f32x4*)(ibias + c0) : *(const f32x4*)(fbias + c0 - 8);
#pragma unroll
                for (int ai = 0; ai < 2; ++ai)
#pragma unroll
                    for (int m = 0; m < 4; ++m) { const int row = row0 + ai * 128 + m * 16; f32x4 v = acc[ai][0][m][0] + bias;
                        if (c0 >= 8) { v[0] = -softplus_f(-v[0]); v[1] = -softplus_f(-v[1]); v[2] = -softplus_f(-v[2]); v[3] = -softplus_f(-v[3]); }
                        *(f32x4*)((float*)(wsb + O_GT) + (size_t)row * 16 + c0) = v; }
            }
        }
    }
};

struct EpiLora {
    static constexpr bool PERM = false, AFTER_DRAIN = false;
    unsigned char* wsb; const float* w0; const float* a0b;
    DI void operator()(const Acc& acc, const Unit& u, int wr, int wc, int fr, int fq) const {
        const int pn = u.pn;
        if (pn >= 8) { store_tile_bf16(acc, (bf16_t*)(wsb + A_G), 512, (pn - 8) * 256, u, wr, wc, fr, fq, [](float x) { return x; }); return; }
        const int d = (pn >> 1) & 1, cb = (pn & 1) * 256; const bool isw = pn < 4;
        bf16_t* dst = (bf16_t*)(wsb + (isw ? (d ? A_U1 : A_U0) : (d ? A_A1 : A_A0))); const int boff = d * 512 + cb;
        const int row0 = u.pm * 256 + wr * 64 + fr, col0 = wc * 32 + 4 * fq;
#pragma unroll
        for (int ai = 0; ai < 2; ++ai)
#pragma unroll
            for (int m = 0; m < 4; ++m) { bf16_t* rp = dst + (size_t)(row0 + ai * 128 + m * 16) * 512 + cb + col0;
#pragma unroll
                for (int bj = 0; bj < 2; ++bj)
#pragma unroll
                    for (int n = 0; n < 2; ++n) { const float* bp = (isw ? w0 : a0b) + boff + col0 + bj * 128 + n * 16; f32x4 v = acc[ai][bj][m][n] + *(const f32x4*)bp;
#pragma unroll
                        for (int j = 0; j < 4; ++j) { const float ez = __expf(-v[j]); const float sg = __builtin_amdgcn_rcpf(1.f + ez); v[j] = isw ? sg * 0.6065306597f : sg; }
                        u32x2 w; w.x = pk2(v[0], v[1]); w.y = pk2(v[2], v[3]); *(u32x2*)(rp + bj * 128 + n * 16) = w; } }
    }
};
DI int map_col(int kind, int n) {
    if (kind == 0) return n;
    if (kind == 1) { const int pn = n >> 8, bj = (n >> 7) & 1, q = n & 127; return bj * DFF_ + pn * 128 + q; }
    const int pn = n >> 8, tc = n & 255;
    if (pn < 6) return n;
    if (pn < 8) return 1552 + (n - 1536);
    const int hh = (tc & 127) >> 5, bj = tc >> 7, d = 32 * bj + (tc & 31);
    if (pn < 10) return 2064 + (4 * (pn - 8) + hh) * 64 + d;
    if (pn == 10) return hh < 2 ? 2576 + hh * 64 + d : 2704 + (hh - 2) * 64 + d;
    return tc < 16 ? 1536 + tc : -1;
}
DI void conv_load(float (&r)[8], const float* src, int ld, int K, int kind, int tile, int tid) {
    const int tk = K >> 6, n0 = (tile / tk) << 6, k0 = (tile % tk) << 6;
#pragma unroll
    for (int q = 0; q < 8; ++q) { const int e = tid + 512 * q; const int kk = e >> 6, nn = e & 63; const int col = map_col(kind, n0 + nn); r[q] = col >= 0 ? __builtin_nontemporal_load(src + (size_t)(k0 + kk) * ld + col) : 0.f; }
}
DI void conv_finish(const float (&r)[8], bf16_t* dst, int K, int tile, LAS float* T, int tid) {
    const int tk = K >> 6, n0 = (tile / tk) << 6, k0 = (tile % tk) << 6;
    __syncthreads();
#pragma unroll
    for (int q = 0; q < 8; ++q) { const int e = tid + 512 * q; T[(e >> 6) * 65 + (e & 63)] = r[q]; }
    __syncthreads();
    for (int e = tid; e < 2048; e += 512) { const int nn = e >> 5, kp = e & 31; *(unsigned*)(dst + (size_t)(n0 + nn) * K + k0 + 2 * kp) = pk2(T[(2 * kp) * 65 + nn], T[(2 * kp + 1) * 65 + nn]); }
}
DI void conv_tile(const float* src, int ld, bf16_t* dst, int K, int kind, int tile, LAS float* T, int tid) {
    float r[8]; conv_load(r, src, ld, K, kind, tile, tid); conv_finish(r, dst, K, tile, T, tid);
}
struct ConvJob { const float* src; int ld; bf16_t* dst; int K, N, kind; };
DI void convert_layer(KParams& P, int l, LAS unsigned char* lds, int tid, int mask) {
    unsigned char* ws = P.ws;
    ConvJob jobs[6];
    jobs[0] = {P.in[14] + (size_t)(l * 2 + 0) * D_ * 2 * DFF_, 2 * DFF_, (bf16_t*)(ws + W_W1A), D_, 2 * DFF_, 1};
    jobs[1] = {P.in[14] + (size_t)(l * 2 + 1) * D_ * 2 * DFF_, 2 * DFF_, (bf16_t*)(ws + W_W1B), D_, 2 * DFF_, 1};
    jobs[2] = {P.in[15] + (size_t)(l * 2 + 0) * DFF_ * D_, D_, (bf16_t*)(ws + W_W2A), DFF_, D_, 0};
    jobs[3] = {P.in[15] + (size_t)(l * 2 + 1) * DFF_ * D_, D_, (bf16_t*)(ws + W_W2B), DFF_, D_, 0};
    if (l == 0) { jobs[4] = {P.in[16], 3328, (bf16_t*)(ws + W_WIN), D_, 3328, 0}; jobs[5] = {P.in[17], D_, (bf16_t*)(ws + W_WOUT), D_, D_, 0}; }
    else        { jobs[4] = {P.in[31], 2832, (bf16_t*)(ws + W_WIN), D_, 3072, 3}; jobs[5] = {P.in[32], D_, (bf16_t*)(ws + W_WOUT), D_, D_, 0}; }
    LAS float* T = (LAS float*)lds;
#pragma unroll
    for (int j = 0; j < 6; ++j) { if (!((mask >> j) & 1)) continue; const ConvJob J = jobs[j]; const int nt = (J.N >> 6) * (J.K >> 6);
        int t = blockIdx.x; float r0[8], r1[8];
        if (t < nt) conv_load(r0, J.src, J.ld, J.K, J.kind, t, tid);
        for (; t < nt; t += 2 * (int)gridDim.x) {
            const int t1 = t + (int)gridDim.x, t2 = t1 + (int)gridDim.x;
            if (t1 < nt) conv_load(r1, J.src, J.ld, J.K, J.kind, t1, tid);
            conv_finish(r0, J.dst, J.K, t, T, tid);
            if (t2 < nt) conv_load(r0, J.src, J.ld, J.K, J.kind, t2, tid);
            if (t1 < nt) conv_finish(r1, J.dst, J.K, t1, T, tid);
        } }
    if (l == 0) {
        bf16_t* wl = (bf16_t*)(ws + W_WL); const float* w2 = P.in[22]; const float* a2 = P.in[24]; const float* g2 = P.in[25];
        for (int e = blockIdx.x * 512 + tid; e < 2560 * 128; e += gridDim.x * 512) { const int n = e >> 7, k = (e & 127) * 2; const int sel = n >> 9, c = n & 511; float v0 = 0.f, v1 = 0.f;
            if (sel < 2) { if (k < 64) { v0 = w2[(size_t)(sel * 64 + k) * 512 + c]; v1 = w2[(size_t)(sel * 64 + k + 1) * 512 + c]; } }
            else if (sel < 4) { if (k >= 64 && k < 128) { v0 = a2[(size_t)((sel - 2) * 64 + k - 64) * 512 + c]; v1 = a2[(size_t)((sel - 2) * 64 + k - 63) * 512 + c]; } }
            else { if (k >= 128) { v0 = g2[(size_t)(k - 128) * 512 + c]; v1 = g2[(size_t)(k - 127) * 512 + c]; } }
            *(unsigned*)(wl + (size_t)n * 256 + k) = pk2(v0, v1); }
    }
}


DI void conv_l1_early_item(KParams& P, int idx, LAS unsigned char* lds, int tid) {
    LAS float* T = (LAS float*)lds;
    const float* src; int ld, K, kind, t0; bf16_t* dst;
    if (idx < 352) { src = P.in[14] + (size_t)(1 * 2 + 0) * D_ * 2 * DFF_; ld = 2 * DFF_; dst = (bf16_t*)(P.ws + W_W1A); K = D_; kind = 1; t0 = 4 * idx; }
    else if (idx < 528) { src = P.in[15] + (size_t)(1 * 2 + 0) * DFF_ * D_; ld = D_; dst = (bf16_t*)(P.ws + W_W2A); K = DFF_; kind = 0; t0 = 4 * (idx - 352); }
    else { src = P.in[31]; ld = 2832; dst = (bf16_t*)(P.ws + W_WIN); K = D_; kind = 3; t0 = 4 * (idx - 528); }
    float r0[8], r1[8];
    conv_load(r0, src, ld, K, kind, t0, tid); conv_load(r1, src, ld, K, kind, t0 + 1, tid);
    conv_finish(r0, dst, K, t0, T, tid); conv_load(r0, src, ld, K, kind, t0 + 2, tid);
    conv_finish(r1, dst, K, t0 + 1, T, tid); conv_load(r1, src, ld, K, kind, t0 + 3, tid);
    conv_finish(r0, dst, K, t0 + 2, T, tid);
    conv_finish(r1, dst, K, t0 + 3, T, tid);
}

DI void mod_phase(KParams& P, LAS unsigned char* lds, int tid) {
    LAS float* sc = (LAS float*)lds;
    LAS float* red = sc + 9 * 1024;
    const float* c = P.in[9]; const float* cctx = P.in[10];
    for (int e = tid; e < 9 * 1024; e += 512) { const int ci = e >> 10, k = e & 1023; const float v = ci == 0 ? cctx[k] : c[(ci - 1) * 1024 + k]; sc[e] = silu_f(v); }
    __syncthreads();
    float* mod = (float*)(P.ws + WS_MOD);
    const int wid = tid >> 6, lane = tid & 63;
    for (int it = blockIdx.x; it < 512; it += gridDim.x) { const int l = it >> 8, n0 = (it & 255) * 36;
        const float* w = P.in[11] + (size_t)l * D_ * 9216 + n0 + (lane < 36 ? lane : 35);
        float acc[9];
#pragma unroll
        for (int i = 0; i < 9; ++i) acc[i] = 0.f;
        for (int k = wid * 128; k < wid * 128 + 128; k += 16) {
            float wv[16];
#pragma unroll
            for (int q = 0; q < 16; ++q) wv[q] = __builtin_nontemporal_load(w + (size_t)(k + q) * 9216);
#pragma unroll
            for (int q = 0; q < 16; ++q)
#pragma unroll
                for (int i = 0; i < 9; ++i) acc[i] += sc[i * 1024 + k + q] * wv[q];
        }
#pragma unroll
        for (int i = 0; i < 9; ++i) red[(wid * 9 + i) * 64 + lane] = acc[i];
        __syncthreads();
        for (int o = tid; o < 576; o += 512) { const int i = o >> 6, ln = o & 63; float s = 0.f;
#pragma unroll
            for (int w8 = 0; w8 < 8; ++w8) s += red[(w8 * 9 + i) * 64 + ln];
            if (ln < 36) mod[(size_t)(l * 9 + i) * 9216 + n0 + ln] = s + P.in[12][(size_t)l * 9216 + n0 + ln]; }
        __syncthreads();
    }
}

DI void norm_phase(const float* xp, const float* xs, bf16_t* h, const float* g, const float* modl, int qsh, int tid) {
    const int wid = tid >> 6, lane = tid & 63; const int stride = gridDim.x * 8;
    int row = blockIdx.x * 8 + wid;
    f32x4 v[4], nv[4];
    if (row < M_) { const float* xr = row < MP_ ? xp + (size_t)row * D_ : xs + (size_t)(row - MP_) * D_;
#pragma unroll
        for (int i = 0; i < 4; ++i) v[i] = *(const f32x4*)(xr + 4 * lane + 256 * i); }
    for (; row < M_; row += stride) {
        const int nrow = row + stride;
        if (nrow < M_) { const float* xr = nrow < MP_ ? xp + (size_t)nrow * D_ : xs + (size_t)(nrow - MP_) * D_;
#pragma unroll
            for (int i = 0; i < 4; ++i) nv[i] = *(const f32x4*)(xr + 4 * lane + 256 * i); }
        const float* sh = modl + (size_t)cond_of_row(row) * 9216 + qsh * 1024; const float* sc = sh + 1024;
        float ss = 0.f;
#pragma unroll
        for (int i = 0; i < 4; ++i) ss += v[i][0] * v[i][0] + v[i][1] * v[i][1] + v[i][2] * v[i][2] + v[i][3] * v[i][3];
        ss = wave_sum(ss); const float rs = rsqrtf(ss * (1.f / 1024.f) + 1e-6f);
#pragma unroll
        for (int i = 0; i < 4; ++i) { const int c = 4 * lane + 256 * i; const f32x4 gg = *(const f32x4*)(g + c), s1 = *(const f32x4*)(sc + c), s0 = *(const f32x4*)(sh + c);
            const f32x4 y = v[i] * rs * gg * (s1 + 1.f) + s0; u32x2 w; w.x = pk2(y[0], y[1]); w.y = pk2(y[2], y[3]); *(u32x2*)(h + (size_t)row * D_ + c) = w; }
#pragma unroll
        for (int i = 0; i < 4; ++i) v[i] = nv[i];
    }
}
DI void final_norm_phase(float* x, const float* g, int tid) {
    const int wid = tid >> 6, lane = tid & 63; const int stride = gridDim.x * 8;
    int row = blockIdx.x * 8 + wid;
    f32x4 v[4], nv[4];
    if (row < M_) {
#pragma unroll
        for (int i = 0; i < 4; ++i) v[i] = *(const f32x4*)(x + (size_t)row * D_ + 4 * lane + 256 * i); }
    for (; row < M_; row += stride) {
        const int nrow = row + stride;
        if (nrow < M_) {
#pragma unroll
            for (int i = 0; i < 4; ++i) nv[i] = *(const f32x4*)(x + (size_t)nrow * D_ + 4 * lane + 256 * i); }
        float* xr = x + (size_t)row * D_; float ss = 0.f;
#pragma unroll
        for (int i = 0; i < 4; ++i) ss += v[i][0] * v[i][0] + v[i][1] * v[i][1] + v[i][2] * v[i][2] + v[i][3] * v[i][3];
        ss = wave_sum(ss); const float rs = rsqrtf(ss * (1.f / 1024.f) + 1e-6f);
#pragma unroll
        for (int i = 0; i < 4; ++i) { const int c = 4 * lane + 256 * i; *(f32x4*)(xr + c) = v[i] * rs * *(const f32x4*)(g + c); }
#pragma unroll
        for (int i = 0; i < 4; ++i) v[i] = nv[i];
    }
}
#define MFMA16(a, b, c) __builtin_amdgcn_mfma_f32_16x16x32_bf16((a), (b), (c), 0, 0, 0)
template <int COLS> DI void stage_bf16(LAS bf16_t* dst, const bf16_t* src, size_t ldg, int rows, int pitch, int tid) {
    constexpr int PR = COLS / 8;
    for (int p = tid; p < rows * PR; p += 512) { const int r = p / PR, c8 = p % PR; const u32x4 v = *(const u32x4*)(src + (size_t)r * ldg + c8 * 8); *(LAS u32x4*)(dst + r * pitch + c8 * 8) = v; }
}
template <int COLS> DI void stage_f32(LAS bf16_t* dst, const float* src, size_t ldg, int rows, int pitch, int tid) {
    constexpr int PR = COLS / 4;
    for (int p = tid; p < rows * PR; p += 512) { const int r = p / PR, c4 = p % PR; const f32x4 v = *(const f32x4*)(src + (size_t)r * ldg + c4 * 4); u32x2 w; w.x = pk2(v[0], v[1]); w.y = pk2(v[2], v[3]); *(LAS u32x2*)(dst + r * pitch + c4 * 4) = w; }
}

template <int COLS> DI void tile_load(u32x4 (&r)[COLS / 32], const bf16_t* src, size_t ldg, int tid) {
    constexpr int PR = COLS / 8;
#pragma unroll
    for (int i = 0; i < COLS / 32; ++i) { const int p = tid + 512 * i; r[i] = *(const u32x4*)(src + (size_t)(p / PR) * ldg + (p % PR) * 8); }
}
template <int COLS> DI void tile_store(LAS bf16_t* dst, const u32x4 (&r)[COLS / 32], int pitch, int tid) {
    constexpr int PR = COLS / 8;
#pragma unroll
    for (int i = 0; i < COLS / 32; ++i) { const int p = tid + 512 * i; *(LAS u32x4*)(dst + (p / PR) * pitch + (p % PR) * 8) = r[i]; }
}
DI void tile_load_f32x64(f32x4 (&r)[4], const float* src, int tid) {
#pragma unroll
    for (int i = 0; i < 4; ++i) r[i] = *(const f32x4*)(src + (size_t)(tid + 512 * i) * 4);
}
DI void tile_store_f32x64(LAS bf16_t* dst, const f32x4 (&r)[4], int pitch, int tid) {
#pragma unroll
    for (int i = 0; i < 4; ++i) { const int p = tid + 512 * i; u32x2 w; w.x = pk2(r[i][0], r[i][1]); w.y = pk2(r[i][2], r[i][3]); *(LAS u32x2*)(dst + (p >> 4) * pitch + (p & 15) * 4) = w; }
}
template <int DK> DI void qk_tile(const LAS bf16_t* sK, const bf16x8 (&qf)[DK / 32], f32x4 (&sacc)[8], int fr, int fq) {
#pragma unroll
    for (int jt = 0; jt < 8; ++jt) { f32x4 a = {0.f, 0.f, 0.f, 0.f};
#pragma unroll
        for (int s = 0; s < DK / 32; ++s) { const bf16x8 kf = *(const LAS bf16x8*)(sK + (16 * jt + fr) * (DK + 8) + 32 * s + 8 * fq); a = MFMA16(kf, qf[s], a); }
        sacc[jt] = a; }
}
template <int DV, int PITCH = DV + 8> DI void pv_tile(const LAS bf16_t* sV, const bf16x8 (&pf)[4], f32x4 (&oacc)[DV / 16], int fr, int fq) {
#pragma unroll
    for (int et = 0; et < DV / 16; ++et)
#pragma unroll
        for (int s = 0; s < 4; ++s) {
            const LAS bf16_t* p0 = sV + (32 * s + 4 * fq + (fr >> 2)) * PITCH + 16 * et + 4 * (fr & 3);
            const s16x4 lo = __builtin_amdgcn_ds_read_tr16_b64_v4i16((LAS s16x4*)p0), hi = __builtin_amdgcn_ds_read_tr16_b64_v4i16((LAS s16x4*)(p0 + 16 * PITCH));
            const bf16x8 vf = __builtin_shufflevector(lo, hi, 0, 1, 2, 3, 4, 5, 6, 7);
            oacc[et] = MFMA16(vf, pf[s], oacc[et]); }
}
DI void pack_p(const f32x4 (&p)[8], bf16x8 (&pf)[4]) {
#pragma unroll
    for (int s = 0; s < 4; ++s) { u32x4 w; w.x = pk2(p[2 * s][0], p[2 * s][1]); w.y = pk2(p[2 * s][2], p[2 * s][3]); w.z = pk2(p[2 * s + 1][0], p[2 * s + 1][1]); w.w = pk2(p[2 * s + 1][2], p[2 * s + 1][3]); pf[s] = __builtin_bit_cast(bf16x8, w); }
}
template <int DKQ> DI void pack_q_state(const bf16_t* qrow, float f0, float f1, bf16x8 (&pf)[4], f32x4 (&pv)[8], int fq) {
#pragma unroll
    for (int s = 0; s < 4; ++s)
#pragma unroll
        for (int hh = 0; hh < 2; ++hh) { const int key = 32 * s + 16 * hh + 4 * fq; const int d = DKQ == 64 ? (key & 63) : key; const float fac = (DKQ == 64 && key >= 64) ? f1 : f0;
            const u32x2 w = *(const u32x2*)(qrow + d); f32x4 v; v[0] = bf_lo(w.x) * fac; v[1] = bf_hi(w.x) * fac; v[2] = bf_lo(w.y) * fac; v[3] = bf_hi(w.y) * fac; pv[2 * s + hh] = v; }
    pack_p(pv, pf);
}
DI void ln_gate_store(f32x4 (&o)[8], float eps, const float* wgt, const bf16_t* gate, bf16_t* dst, int fq) {
    float s = 0.f;
#pragma unroll
    for (int et = 0; et < 8; ++et) s += o[et][0] + o[et][1] + o[et][2] + o[et][3];
    s = fq_sum(s); const float mu = s * (1.f / 128.f); float vs = 0.f;
#pragma unroll
    for (int et = 0; et < 8; ++et)
#pragma unroll
        for (int j = 0; j < 4; ++j) { const float d = o[et][j] - mu; vs += d * d; }
    vs = fq_sum(vs); const float rs = rsqrtf(vs * (1.f / 128.f) + eps);
#pragma unroll
    for (int et = 0; et < 8; ++et) { const int e = 16 * et + 4 * fq; const f32x4 wv = *(const f32x4*)(wgt + e); const u32x2 gw = *(const u32x2*)(gate + e);
        u32x2 w; w.x = pk2((o[et][0] - mu) * rs * wv[0] * bf_lo(gw.x), (o[et][1] - mu) * rs * wv[1] * bf_hi(gw.x));
        w.y = pk2((o[et][2] - mu) * rs * wv[2] * bf_lo(gw.y), (o[et][3] - mu) * rs * wv[3] * bf_hi(gw.y)); *(u32x2*)(dst + e) = w; }
}


template <int DK> DI void state_mfma(const bf16_t* kg, size_t ldk, const bf16_t* vg, size_t ldv, const LAS float* wj, LAS unsigned char* lds, float* out, float* nout, int tid) {
    constexpr int PK = DK == 128 ? 144 : 72, NE = DK == 128 ? 8 : 4, PR = DK / 8;
    const int wid = tid >> 6, lane = tid & 63, fr = lane & 15, fq = lane >> 4;
    const int dt = DK == 128 ? wid : (wid & 3), e0 = DK == 128 ? 0 : (wid >> 2) * 4;
    LAS bf16_t* sKw = (LAS bf16_t*)lds; LAS bf16_t* sV = (LAS bf16_t*)(lds + 36864);
    f32x4 acc[NE];
#pragma unroll
    for (int i = 0; i < NE; ++i) acc[i] = (f32x4){0.f, 0.f, 0.f, 0.f};
    float nacc = 0.f;
#pragma unroll 1
    for (int hf = 0; hf < 2; ++hf) {
        __syncthreads();
        for (int p = tid; p < 128 * PR; p += 512) { const int r = p / PR, c8 = p % PR; const u32x4 v = *(const u32x4*)(kg + (size_t)(128 * hf + r) * ldk + c8 * 8); const float w = wj[128 * hf + r];
            u32x4 o; o.x = pk2(bf_lo(v.x) * w, bf_hi(v.x) * w); o.y = pk2(bf_lo(v.y) * w, bf_hi(v.y) * w); o.z = pk2(bf_lo(v.z) * w, bf_hi(v.z) * w); o.w = pk2(bf_lo(v.w) * w, bf_hi(v.w) * w);
            *(LAS u32x4*)(sKw + r * PK + c8 * 8) = o; }
        stage_bf16<128>(sV, vg + (size_t)(128 * hf) * ldv, ldv, 128, 144, tid);
        __syncthreads();
#pragma unroll
        for (int s = 0; s < 4; ++s) {
            const LAS bf16_t* pa = sKw + (32 * s + 4 * fq + (fr >> 2)) * PK + 16 * dt + 4 * (fr & 3);
            const s16x4 alo = __builtin_amdgcn_ds_read_tr16_b64_v4i16((LAS s16x4*)pa), ahi = __builtin_amdgcn_ds_read_tr16_b64_v4i16((LAS s16x4*)(pa + 16 * PK));
            const bf16x8 af = __builtin_shufflevector(alo, ahi, 0, 1, 2, 3, 4, 5, 6, 7);
#pragma unroll
            for (int i = 0; i < NE; ++i) {
                const LAS bf16_t* pb = sV + (32 * s + 4 * fq + (fr >> 2)) * 144 + 16 * (e0 + i) + 4 * (fr & 3);
                const s16x4 blo = __builtin_amdgcn_ds_read_tr16_b64_v4i16((LAS s16x4*)pb), bhi = __builtin_amdgcn_ds_read_tr16_b64_v4i16((LAS s16x4*)(pb + 16 * 144));
                const bf16x8 bfv = __builtin_shufflevector(blo, bhi, 0, 1, 2, 3, 4, 5, 6, 7);
                acc[i] = MFMA16(af, bfv, acc[i]); }
        }
        if (nout && tid < DK) { for (int j = 0; j < 128; ++j) nacc += bf2f(sKw[j * PK + tid]); }
    }
#pragma unroll
    for (int i = 0; i < NE; ++i)
#pragma unroll
        for (int r = 0; r < 4; ++r) out[(size_t)(16 * dt + 4 * fq + r) * 128 + 16 * (e0 + i) + fr] = acc[i][r];
    if (nout && tid < DK) nout[tid] = nacc;
}
DI void ret_item(KParams& P, int item, LAS unsigned char* lds, int tid) {
    const int wid = tid >> 6, lane = tid & 63, fr = lane & 15, fq = lane >> 4;
    int b, h, c, L, rowbase, nc; bool lat;
    if (item < 128) { b = item >> 2; h = item & 3; c = 0; L = 256; rowbase = b * 256; nc = 2; lat = false; }
    else { const int it = item - 128; b = it >> 5; h = (it >> 3) & 3; c = it & 7; L = 2048; rowbase = MP_ + b * 2048; nc = 16; lat = true; }
    const bf16_t* qA = (const bf16_t*)(P.ws + A_QA); const bf16_t* kA = (const bf16_t*)(P.ws + A_KA); const bf16_t* vA = (const bf16_t*)(P.ws + A_VA); const bf16_t* gA = (const bf16_t*)(P.ws + A_GA);
    LAS bf16_t* sK = (LAS bf16_t*)lds; LAS bf16_t* sV = (LAS bf16_t*)(lds + 128 * 72 * 2);
    const float lgf = P.in[18][h], lgb = P.in[18][4 + h];
    const float lgf2 = lgf * 1.4426950408889634f, lgb2 = lgb * 1.4426950408889634f;
    const int ti0 = 256 * c + 32 * wid + fr;
    bf16x8 qf[2][2];
#pragma unroll
    for (int it = 0; it < 2; ++it)
#pragma unroll
        for (int s = 0; s < 2; ++s) qf[it][s] = *(const bf16x8*)(qA + (size_t)(rowbase + ti0 + 16 * it) * 256 + h * 64 + 32 * s + 8 * fq);
    f32x4 oacc[2][8];
#pragma unroll
    for (int it = 0; it < 2; ++it)
#pragma unroll
        for (int et = 0; et < 8; ++et) oacc[it][et] = (f32x4){0.f, 0.f, 0.f, 0.f};
    f32x4 sacc[8]; bf16x8 pf[2][4];
    auto pv2 = [&](const LAS bf16_t* cV) {
#pragma unroll
        for (int et = 0; et < 8; ++et)
#pragma unroll
            for (int s = 0; s < 4; ++s) {
                const LAS bf16_t* p0 = cV + (32 * s + 4 * fq + (fr >> 2)) * 144 + 16 * et + 4 * (fr & 3);
                const s16x4 lo = __builtin_amdgcn_ds_read_tr16_b64_v4i16((LAS s16x4*)p0), hi = __builtin_amdgcn_ds_read_tr16_b64_v4i16((LAS s16x4*)(p0 + 16 * 144));
                const bf16x8 vf = __builtin_shufflevector(lo, hi, 0, 1, 2, 3, 4, 5, 6, 7);
                oacc[0][et] = MFMA16(vf, pf[0][s], oacc[0][et]); oacc[1][et] = MFMA16(vf, pf[1][s], oacc[1][et]); if (s == 3 && (et & 1)) __builtin_amdgcn_sched_barrier(0); } };
    {
        u32x4 rk[2], rv[4];
        const bf16_t* kg = kA + (size_t)rowbase * 256 + h * 64; const bf16_t* vg = vA + (size_t)rowbase * 512 + h * 128;
        tile_load<64>(rk, kg, 256, tid); tile_load<128>(rv, vg, 512, tid);
        __syncthreads();
        tile_store<64>(sK, rk, 72, tid); tile_store<128>(sV, rv, 144, tid);
        if (nc > 1) { tile_load<64>(rk, kg + (size_t)128 * 256, 256, tid); tile_load<128>(rv, vg + (size_t)128 * 512, 512, tid); }
        __syncthreads();
        for (int kc = 0; kc < nc; ++kc) {
            const LAS bf16_t* cK = sK + (kc & 1) * 27648; const LAS bf16_t* cV = sV + (kc & 1) * 27648;
#pragma unroll
            for (int it = 0; it < 2; ++it) {
                qk_tile<64>(cK, qf[it], sacc, fr, fq);
#pragma unroll
                for (int jt = 0; jt < 8; ++jt)
#pragma unroll
                    for (int r = 0; r < 4; ++r) { const int tj = 128 * kc + 16 * jt + 4 * fq + r; const int dl = ti0 + 16 * it - tj;
                        const float e = __builtin_amdgcn_exp2f((dl > 0 ? lgf2 : lgb2) * (float)(dl > 0 ? dl : -dl)); sacc[jt][r] *= (dl == 0 ? 2.f : e); }
                pack_p(sacc, pf[it]); }
            pv2(cV);
            { const int tl = launder_v(tid);
            if (kc + 1 < nc) { tile_store<64>(sK + ((kc + 1) & 1) * 27648, rk, 72, tl); tile_store<128>(sV + ((kc + 1) & 1) * 27648, rv, 144, tl); }
            if (kc + 2 < nc) { tile_load<64>(rk, kg + (size_t)128 * (kc + 2) * 256, 256, tl); tile_load<128>(rv, vg + (size_t)128 * (kc + 2) * 512, 512, tl); } }
            __syncthreads();
        }
    }
    if (lat) {
        __syncthreads();
        const float* s0 = P.in[2] + (size_t)b * 2 * 4 * 64 * 128;
        stage_f32<128>(sV, s0 + (size_t)(0 * 4 + h) * 64 * 128, 128, 64, 144, tid);
        stage_f32<128>(sV + 64 * 144, s0 + (size_t)(1 * 4 + h) * 64 * 128, 128, 64, 144, tid);
        __syncthreads();
#pragma unroll
        for (int it = 0; it < 2; ++it) { const int ti = ti0 + 16 * it;
            pack_q_state<64>(qA + (size_t)(rowbase + ti) * 256 + h * 64, __expf(lgf * (float)(ti + 1)), __expf(lgb * (float)(L - ti)), pf[it], sacc, fq); }
        pv2(sV);
    }
#pragma unroll
    for (int it = 0; it < 2; ++it) { const int qrow = launder_v(rowbase + ti0) + 16 * it;
        ln_gate_store(oacc[it], 1e-5f, P.in[19] + h * 128, gA + (size_t)qrow * 512 + h * 128, (bf16_t*)(P.ws + WS_H) + (size_t)qrow * D_ + h * 128, fq); }
}
DI void ret_state_item(KParams& P, int item, LAS unsigned char* lds, int tid) {
    const int b = item >> 3, h = (item >> 1) & 3, dir = item & 1; const int rowbase = b * 256;
    const bf16_t* kA = (const bf16_t*)(P.ws + A_KA); const bf16_t* vA = (const bf16_t*)(P.ws + A_VA);
    LAS float* wj = (LAS float*)(lds + MISC_OFF);
    const float lg = P.in[18][dir * 4 + h];
    __syncthreads();
    if (tid < 256) wj[tid] = __expf(lg * (float)(dir ? tid : 255 - tid));
    state_mfma<64>(kA + (size_t)rowbase * 256 + h * 64, 256, vA + (size_t)rowbase * 512 + h * 128, 512, wj, lds, P.out + OUT_RET + (size_t)((b * 2 + dir) * 4 + h) * 64 * 128, nullptr, tid);
}
DI float wave_incl_sum(float v, int lane) {
#pragma unroll
    for (int o = 1; o < 64; o <<= 1) { const float t = __shfl_up(v, o); if (lane >= o) v += t; }
    return v;
}
DI float wave_incl_max(float v, int lane) {
#pragma unroll
    for (int o = 1; o < 64; o <<= 1) { const float t = __shfl_up(v, o); if (lane >= o) v = fmaxf(v, t); }
    return v;
}
DI void gate_scan(const LAS float* ig, const LAS float* lf, LAS float* cf, LAS float* rowf, LAS float* Fq, int L, int t0, bool rev, float m0, int lane, float& Ftot, float& Mtot) {
    float csum = 0.f, cmax = m0;
    for (int blk = 0; blk < L; blk += 64) { const int pos = blk + lane; const int t = rev ? L - 1 - pos : pos;
        const float F = csum + wave_incl_sum(lf[t], lane); const float c = ig[t] - F; const float pm = fmaxf(cmax, wave_incl_max(c, lane));
        cf[t] = c; if (t >= t0 && t < t0 + 128) { rowf[t - t0] = -pm; Fq[t - t0] = F; }
        csum = __shfl(F, 63); cmax = __shfl(pm, 63); }
    Ftot = csum; Mtot = cmax;
}
DI void mlstm_item(KParams& P, int item, LAS unsigned char* lds, int tid) {
    const int wid = tid >> 6, lane = tid & 63, fr = lane & 15, fq = lane >> 4;
    int b, h, c, L, rowbase, nc; bool lat;
    if (item < 256) { b = item >> 3; h = (item >> 1) & 3; c = item & 1; L = 256; rowbase = b * 256; nc = 2; lat = false; }
    else { const int it = item - 256; b = it >> 6; h = (it >> 4) & 3; c = it & 15; L = 2048; rowbase = MP_ + b * 2048; nc = 16; lat = true; }
    const bf16_t* qC = (const bf16_t*)(P.ws + O_QC); const bf16_t* kC = (const bf16_t*)(P.ws + O_KC); const bf16_t* vC = (const bf16_t*)(P.ws + O_VC); const bf16_t* oC = (const bf16_t*)(P.ws + O_OC);
    const float* gates = (const float*)(P.ws + O_GT); bf16_t* mix = (bf16_t*)(P.ws + WS_H);
    LAS bf16_t* sK = (LAS bf16_t*)lds; LAS bf16_t* sV = (LAS bf16_t*)(lds + 34816);
    LAS float* cfa = (LAS float*)(lds + 73728);
    LAS float* rowfa = (LAS float*)(lds + 90112);
    LAS float* Fqa = rowfa + 256;
    LAS float* tmp = (LAS float*)(lds + 94208);
    __syncthreads();
    for (int t = tid; t < L; t += 512) { const float* g = gates + (size_t)(rowbase + t) * 16; tmp[t] = g[h]; tmp[2048 + t] = g[8 + h]; tmp[4096 + t] = g[4 + h]; tmp[6144 + t] = g[12 + h]; }
    __syncthreads();
    float m0f = 0.f, m0b = 0.f;
    if (lat) { m0f = P.in[6][(b * 2 + 0) * 4 + h]; m0b = P.in[6][(b * 2 + 1) * 4 + h]; }
    {
        LAS float* bs = (LAS float*)(lds + MISC_OFF);
        const int nblk = L >> 6;
        for (int j = wid; j < 2 * nblk; j += 8) { const int dr = j >= nblk, blk = dr ? j - nblk : j; const int pos = 64 * blk + lane; const int t = dr ? L - 1 - pos : pos;
            LAS float* ig = tmp + dr * 4096; LAS float* lf = ig + 2048;
            const float Fl = wave_incl_sum(lf[t], lane); const float cl = ig[t] - Fl; const float pm = wave_incl_max(cl, lane);
            cfa[dr * 2048 + t] = cl; ig[t] = pm; lf[t] = Fl;
            if (lane == 63) { bs[dr * 32 + blk] = Fl; bs[64 + dr * 32 + blk] = pm; } }
        __syncthreads();
        if (wid == 0) { const int dr = lane >> 5, blk = lane & 31;
            if (blk < nblk) { float C = 0.f, cm = dr ? m0b : m0f;
                for (int q = 0; q < blk; ++q) { cm = fmaxf(cm, bs[64 + dr * 32 + q] - C); C += bs[dr * 32 + q]; }
                bs[128 + dr * 32 + blk] = C; bs[192 + dr * 32 + blk] = cm; } }
        __syncthreads();
        for (int e = tid; e < 2 * L; e += 512) { const int dr = e >= L, t = dr ? e - L : e; const int pos = dr ? L - 1 - t : t; const int blk = pos >> 6;
            const float C = bs[128 + dr * 32 + blk], cm = bs[192 + dr * 32 + blk];
            cfa[dr * 2048 + t] -= C;
            if (t >= 128 * c && t < 128 * c + 128) { rowfa[dr * 128 + t - 128 * c] = -fmaxf(cm, tmp[dr * 4096 + t] - C); Fqa[dr * 128 + t - 128 * c] = tmp[dr * 4096 + 2048 + t] + C; } }
    }
    __syncthreads();
    const int ti = 128 * c + 16 * wid + fr; const int qrow = rowbase + ti;
    bf16x8 qf[4];
#pragma unroll
    for (int s = 0; s < 4; ++s) qf[s] = *(const bf16x8*)(qC + (size_t)qrow * 512 + h * 128 + 32 * s + 8 * fq);
    f32x4 hsum[8];
#pragma unroll
    for (int et = 0; et < 8; ++et) hsum[et] = (f32x4){0.f, 0.f, 0.f, 0.f};
    f32x4 sacc[8]; bf16x8 pf[4];
#pragma unroll 1
    for (int dir = 0; dir < 2; ++dir) {
        f32x4 num[8];
#pragma unroll
        for (int et = 0; et < 8; ++et) num[et] = (f32x4){0.f, 0.f, 0.f, 0.f};
        float den = 0.f;
        const float rf = rowfa[dir * 128 + 16 * wid + fr]; const LAS float* cf = cfa + dir * 2048;
        const int k0 = dir ? c : 0, k1 = dir ? nc : c + 1;
        {
            u32x4 rk[4], rv[4];
            const bf16_t* kg = kC + (size_t)rowbase * 512 + h * 128; const bf16_t* vg = vC + (size_t)rowbase * 512 + h * 128;
            tile_load<128>(rk, kg + (size_t)128 * k0 * 512, 512, tid); tile_load<128>(rv, vg + (size_t)128 * k0 * 512, 512, tid);
            for (int kc = k0; kc < k1; ++kc) {
                __syncthreads();
                tile_store<128>(sK, rk, 136, tid); tile_store<128>(sV, rv, 144, tid);
                __syncthreads();
                if (kc + 1 < k1) { tile_load<128>(rk, kg + (size_t)128 * (kc + 1) * 512, 512, tid); tile_load<128>(rv, vg + (size_t)128 * (kc + 1) * 512, 512, tid); }
                qk_tile<128>(sK, qf, sacc, fr, fq);
#pragma unroll
                for (int jt = 0; jt < 8; ++jt) { const f32x4 cv = *(const LAS f32x4*)(cf + 128 * kc + 16 * jt + 4 * fq);
#pragma unroll
                    for (int r = 0; r < 4; ++r) { const int tj = 128 * kc + 16 * jt + 4 * fq + r; const bool ok = dir ? (tj >= ti) : (tj <= ti);
                        const float w = ok ? __expf(rf + cv[r]) : 0.f; const float p = sacc[jt][r] * w; sacc[jt][r] = p; den += p; } }
                pack_p(sacc, pf);
                pv_tile<128, 144>(sV, pf, num, fr, fq);
            }
        }
        if (lat) {
            __syncthreads();
            stage_f32<128>(sV, P.in[4] + (size_t)((b * 2 + dir) * 4 + h) * 128 * 128, 128, 128, 144, tid);
            __syncthreads();
            const float fac = __expf((dir ? m0b : m0f) + rf);
            pack_q_state<128>(qC + (size_t)qrow * 512 + h * 128, fac, fac, pf, sacc, fq);
            const float* n0 = P.in[5] + (size_t)((b * 2 + dir) * 4 + h) * 128;
#pragma unroll
            for (int jt = 0; jt < 8; ++jt) { const f32x4 nv = *(const f32x4*)(n0 + 16 * jt + 4 * fq); den += sacc[jt][0] * nv[0] + sacc[jt][1] * nv[1] + sacc[jt][2] * nv[2] + sacc[jt][3] * nv[3]; }
            pv_tile<128, 144>(sV, pf, num, fr, fq);
        }
        den = fq_sum(den);
        const float thr = __expf(rf - Fqa[dir * 128 + 16 * wid + fr]);
        const float dn = 1.f / fmaxf(fabsf(den), thr);
#pragma unroll
        for (int et = 0; et < 8; ++et) hsum[et] += num[et] * dn;
    }
    ln_gate_store(hsum, 1e-5f, P.in[35] + h * 128, oC + (size_t)qrow * 512 + h * 128, mix + (size_t)qrow * D_ + h * 128, fq);
}
DI void mlstm_state_item(KParams& P, int item, LAS unsigned char* lds, int tid) {
    const int wid = tid >> 6, lane = tid & 63;
    const int b = item >> 3, h = (item >> 1) & 3, dir = item & 1; const int rowbase = b * 256;
    const bf16_t* kC = (const bf16_t*)(P.ws + O_KC); const bf16_t* vC = (const bf16_t*)(P.ws + O_VC); const float* gates = (const float*)(P.ws + O_GT);
    LAS float* mi = (LAS float*)(lds + MISC_OFF);
    __syncthreads();
    if (tid < 256) { const float* g = gates + (size_t)(rowbase + tid) * 16; mi[tid] = g[dir * 4 + h]; mi[256 + tid] = g[8 + dir * 4 + h]; }
    __syncthreads();
    if (wid == 0) { float Ft, Mt; gate_scan(mi, mi + 256, mi + 512, mi + 768, mi + 896, 256, 0, dir == 1, 0.f, lane, Ft, Mt); if (lane == 0) { mi[1024] = Ft; mi[1025] = Mt; } }
    __syncthreads();
    const float Ft = mi[1024], Mt = mi[1025];
    if (tid < 256) mi[512 + tid] = __expf(mi[512 + tid] - Mt);
    const size_t sidx = (size_t)(b * 2 + dir) * 4 + h;
    state_mfma<128>(kC + (size_t)rowbase * 512 + h * 128, 512, vC + (size_t)rowbase * 512 + h * 128, 512, mi + 512, lds, P.out + OUT_MC + sidx * 128 * 128, P.out + OUT_MN + sidx * 128, tid);
    if (tid == 0) P.out[OUT_MM + sidx] = Ft + Mt;
}
DI void attn_item(KParams& P, int item, LAS unsigned char* lds, int tid) {
    const int wid = tid >> 6, lane = tid & 63, fr = lane & 15, fq = lane >> 4;
    int b, qh, qb, rowbase, nkt; bool lat;
    if (item >= 512) { const int it = item - 512; b = it >> 3; qh = it & 7; qb = 0; rowbase = b * 256; nkt = 2; lat = false; }
    else { b = item >> 6; qh = (item >> 3) & 7; qb = item & 7; rowbase = MP_ + b * 2048; nkt = 20; lat = true; }
    const int kvh = qh >> 2;
    const bf16_t* qD = (const bf16_t*)(P.ws + O_QD); const bf16_t* kD = (const bf16_t*)(P.ws + O_KD); const bf16_t* vD = (const bf16_t*)(P.ws + O_VD); bf16_t* mix = (bf16_t*)(P.ws + WS_H);
    LAS bf16_t* sK = (LAS bf16_t*)lds; LAS bf16_t* sV = (LAS bf16_t*)(lds + 128 * 72 * 2);
    const int qrow = rowbase + 256 * qb + 32 * wid + fr;
    bf16x8 qf[2][2];
#pragma unroll
    for (int it = 0; it < 2; ++it)
#pragma unroll
        for (int s = 0; s < 2; ++s) qf[it][s] = *(const bf16x8*)(qD + (size_t)(qrow + 16 * it) * 512 + qh * 64 + 32 * s + 8 * fq);
    f32x4 oacc[2][4];
#pragma unroll
    for (int it = 0; it < 2; ++it)
#pragma unroll
        for (int et = 0; et < 4; ++et) oacc[it][et] = (f32x4){0.f, 0.f, 0.f, 0.f};
    float mrun[2] = {-1e30f, -1e30f}, lpart[2] = {0.f, 0.f};
    f32x4 sacc[2][8]; bf16x8 pf[2][4];
    {
        u32x4 ra[2], rc[2];
        const bf16_t* cKb = (const bf16_t*)(P.ws + WS_CK); const bf16_t* cVb = (const bf16_t*)(P.ws + WS_CV);
        auto t_load = [&](int kt) {
            if (lat && kt < 4) { const size_t off = ((size_t)(b * 2 + kvh) * 512 + 128 * kt) * 64; tile_load<64>(ra, cKb + off, 64, tid); tile_load<64>(rc, cVb + off, 64, tid); }
            else { const size_t r0 = (size_t)rowbase + 128 * (lat ? kt - 4 : kt); tile_load<64>(ra, kD + r0 * 128 + kvh * 64, 128, tid); tile_load<64>(rc, vD + r0 * 128 + kvh * 64, 128, tid); } };
        auto t_store = [&](int kt) { tile_store<64>(sK + (kt & 1) * 18432, ra, 72, tid); tile_store<64>(sV + (kt & 1) * 18432, rc, 72, tid); };
        t_load(0);
        __syncthreads();
        t_store(0);
        if (nkt > 1) t_load(1);
        __syncthreads();
        for (int kt = 0; kt < nkt; ++kt) {
            const LAS bf16_t* cK = sK + (kt & 1) * 18432; const LAS bf16_t* cV = sV + (kt & 1) * 18432;
#pragma unroll
            for (int jt = 0; jt < 8; ++jt) { f32x4 a0 = {0.f, 0.f, 0.f, 0.f}, a1 = {0.f, 0.f, 0.f, 0.f};
#pragma unroll
                for (int s = 0; s < 2; ++s) { const bf16x8 kf = *(const LAS bf16x8*)(cK + (16 * jt + fr) * 72 + 32 * s + 8 * fq); a0 = MFMA16(kf, qf[0][s], a0); a1 = MFMA16(kf, qf[1][s], a1); }
                sacc[0][jt] = a0; sacc[1][jt] = a1; }
#pragma unroll
            for (int it = 0; it < 2; ++it) {
                float tmax = -1e30f;
#pragma unroll
                for (int jt = 0; jt < 8; ++jt)
#pragma unroll
                    for (int r = 0; r < 4; ++r) tmax = fmaxf(tmax, sacc[it][jt][r]);
                tmax = fq_max(tmax) * 0.18033688011112042f;
                const float mnew = fmaxf(mrun[it], tmax), alpha = __builtin_amdgcn_exp2f(mrun[it] - mnew); float ps = 0.f;
#pragma unroll
                for (int jt = 0; jt < 8; ++jt)
#pragma unroll
                    for (int r = 0; r < 4; ++r) { const float p = __builtin_amdgcn_exp2f(sacc[it][jt][r] * 0.18033688011112042f - mnew); sacc[it][jt][r] = p; ps += p; }
                lpart[it] = lpart[it] * alpha + ps; mrun[it] = mnew;
                if (__builtin_amdgcn_ballot_w64(alpha != 1.f)) {
#pragma unroll
                    for (int et = 0; et < 4; ++et) oacc[it][et] *= alpha; }
                pack_p(sacc[it], pf[it]);
            }
#pragma unroll
            for (int et = 0; et < 4; ++et)
#pragma unroll
                for (int s = 0; s < 4; ++s) {
                    const LAS bf16_t* p0 = cV + (32 * s + 4 * fq + (fr >> 2)) * 72 + 16 * et + 4 * (fr & 3);
                    const s16x4 lo = __builtin_amdgcn_ds_read_tr16_b64_v4i16((LAS s16x4*)p0), hi = __builtin_amdgcn_ds_read_tr16_b64_v4i16((LAS s16x4*)(p0 + 16 * 72));
                    const bf16x8 vf = __builtin_shufflevector(lo, hi, 0, 1, 2, 3, 4, 5, 6, 7);
                    oacc[0][et] = MFMA16(vf, pf[0][s], oacc[0][et]); oacc[1][et] = MFMA16(vf, pf[1][s], oacc[1][et]); }
            if (kt + 1 < nkt) t_store(kt + 1);
            if (kt + 2 < nkt) t_load(kt + 2);
            __syncthreads();
        }
    }
#pragma unroll
    for (int it = 0; it < 2; ++it) {
        const float inv = 1.f / fq_sum(lpart[it]);
        bf16_t* dst = (bf16_t*)(P.ws + WS_H) + (size_t)(launder_v(qrow) + 16 * it) * D_ + 512 + qh * 64 + 4 * fq;
#pragma unroll
        for (int et = 0; et < 4; ++et) { u32x2 w; w.x = pk2(oacc[it][et][0] * inv, oacc[it][et][1] * inv); w.y = pk2(oacc[it][et][2] * inv, oacc[it][et][3] * inv); *(u32x2*)(dst + 16 * et) = w; }
    }
}

DI void rwkv_shift_row(const bf16_t* pB, const float* mu, bf16_t* rB, bf16_t* kB, bf16_t* vB, bf16_t* X, int row, int lane) {
    const int t = seqpos_of_row(row), L = row < MP_ ? 256 : 2048; const bool hp = t > 0, hn = t < L - 1;
    const bf16_t* pr = pB + (size_t)row * 1792;
    u32x2 cu[7], pu[7], nu[7];
#pragma unroll
    for (int g = 0; g < 7; ++g) { const int c = 256 * g + 4 * lane; cu[g] = *(const u32x2*)(pr + c); pu[g] = (u32x2){0u, 0u}; nu[g] = (u32x2){0u, 0u};
        if (hp) pu[g] = *(const u32x2*)(pr - 1792 + c); if (hn) nu[g] = *(const u32x2*)(pr + 1792 + c); }
#pragma unroll
    for (int g = 0; g < 7; ++g) { const int c = 256 * g + 4 * lane;
        const f32x4 m4 = *(const f32x4*)(mu + c);
        float x[4] = {bf_lo(cu[g].x), bf_hi(cu[g].x), bf_lo(cu[g].y), bf_hi(cu[g].y)}; const float pv[4] = {bf_lo(pu[g].x), bf_hi(pu[g].x), bf_lo(pu[g].y), bf_hi(pu[g].y)}, nv[4] = {bf_lo(nu[g].x), bf_hi(nu[g].x), bf_lo(nu[g].y), bf_hi(nu[g].y)};
#pragma unroll
        for (int j = 0; j < 4; ++j) x[j] = x[j] + m4[j] * (0.5f * (pv[j] + nv[j]) - x[j]);
        u32x2 w;
        if (g < 6) { w.x = pk2(x[0], x[1]); w.y = pk2(x[2], x[3]); bf16_t* dst = g < 2 ? rB : (g < 4 ? kB : vB); *(u32x2*)(dst + (size_t)row * 512 + (g & 1) * 256 + 4 * lane) = w; }
        else { const int cc = 4 * lane;
#pragma unroll
            for (int j = 0; j < 4; ++j) x[j] = cc < 64 ? tanhf(x[j]) : (cc < 128 ? x[j] : sigmoid_f(x[j]));
            w.x = pk2(x[0], x[1]); w.y = pk2(x[2], x[3]); *(u32x2*)(X + (size_t)row * 256 + cc) = w; }
    }
}
DI void rwkv_shift_phase(KParams& P, int tid) {
    const int wid = tid >> 6, lane = tid & 63;
    const bf16_t* pB = (const bf16_t*)(P.ws + A_PB); const float* mu = P.in[20];
    bf16_t* rB = (bf16_t*)(P.ws + A_R); bf16_t* kB = (bf16_t*)(P.ws + A_K); bf16_t* vB = (bf16_t*)(P.ws + A_V); bf16_t* X = (bf16_t*)(P.ws + A_X);
    for (int row = blockIdx.x * 8 + wid; row < M_; row += gridDim.x * 8) rwkv_shift_row(pB, mu, rB, kB, vB, X, row, lane);
}
DI float dpp_xor1(float v) { return __int_as_float(__builtin_amdgcn_mov_dpp(__float_as_int(v), 0xB1, 0xf, 0xf, true)); }
DI float dpp_xor2(float v) { return __int_as_float(__builtin_amdgcn_mov_dpp(__float_as_int(v), 0x4E, 0xf, 0xf, true)); }
DI float dpp_hmir(float v) { return __int_as_float(__builtin_amdgcn_mov_dpp(__float_as_int(v), 0x141, 0xf, 0xf, true)); }
DI float sum8(float v) { v += dpp_xor1(v); v += dpp_xor2(v); v += dpp_hmir(v); return v; }
DI float dpp_rmir(float v) { return __int_as_float(__builtin_amdgcn_mov_dpp(__float_as_int(v), 0x140, 0xf, 0xf, true)); }
DI float sum16(float v) { v += dpp_xor1(v); v += dpp_xor2(v); v += dpp_hmir(v); v += dpp_rmir(v); return v; }
DI void rwkv_scan_item(KParams& P, int item, LAS unsigned char* lds, int tid) {
    int b, h, dir, L, rowbase; bool lat;
    if (item < 128) { b = item >> 4; h = (item >> 1) & 7; dir = item & 1; L = 2048; rowbase = MP_ + b * 2048; lat = true; }
    else { const int it = item - 128; b = it >> 4; h = (it >> 1) & 7; dir = it & 1; L = 256; rowbase = b * 256; lat = false; }
    const bf16_t* rB = (const bf16_t*)(P.ws + A_R); const bf16_t* kB = (const bf16_t*)(P.ws + A_K); const bf16_t* vB = (const bf16_t*)(P.ws + A_V);
    const bf16_t* uB = (const bf16_t*)(P.ws + (dir ? A_U1 : A_U0)); const bf16_t* aB = (const bf16_t*)(P.ws + (dir ? A_A1 : A_A0)); bf16_t* y = (bf16_t*)(P.ws + A_Y) + (dir ? (size_t)M_ * 512 : 0);
    LAS float* buf = (LAS float*)lds;
    LAS float* ybuf = (LAS float*)(lds + 98304);
    const int i = tid >> 3, cg = tid & 7, tt_s = tid >> 4, jc = (tid & 15) * 4;
    LAS float* ydst = (cg == 0) ? (ybuf + i) : ((LAS float*)(lds + 114688) + tid);
    f32x2 S[4];
    if (lat) { const float* s0 = P.in[3] + ((size_t)((b * 2 + dir) * 8 + h) * 64 + i) * 64 + 8 * cg; const f32x4 a = *(const f32x4*)s0, c = *(const f32x4*)(s0 + 4);
        S[0] = (f32x2){a[0], a[1]}; S[1] = (f32x2){a[2], a[3]}; S[2] = (f32x2){c[0], c[1]}; S[3] = (f32x2){c[2], c[3]}; }
    else {
#pragma unroll
        for (int q = 0; q < 4; ++q) S[q] = (f32x2){0.f, 0.f}; }
    const f32x4 kk4 = *(const f32x4*)(P.in[26] + h * 64 + jc), ka4 = *(const f32x4*)(P.in[27] + h * 64 + jc);
    u32x2 gr, gk, gv, gu, ga;
    auto gload = [&](int ci) { const int pos = 32 * ci + tt_s; const int t = dir ? L - 1 - pos : pos; const size_t o = (size_t)(rowbase + t) * 512 + h * 64 + jc;
        gr = *(const u32x2*)(rB + o); gk = *(const u32x2*)(kB + o); gv = *(const u32x2*)(vB + o); gu = *(const u32x2*)(uB + o); ga = *(const u32x2*)(aB + o); };
    auto pstore = [&](int bi) { LAS float* bb = buf + bi * 12288 + tt_s * 64 + jc;
        const float k[4] = {bf_lo(gk.x), bf_hi(gk.x), bf_lo(gk.y), bf_hi(gk.y)}, a[4] = {bf_lo(ga.x), bf_hi(ga.x), bf_lo(ga.y), bf_hi(ga.y)}, u[4] = {bf_lo(gu.x), bf_hi(gu.x), bf_lo(gu.y), bf_hi(gu.y)};
        float kv[4]; float ss = 0.f;
#pragma unroll
        for (int j = 0; j < 4; ++j) { kv[j] = k[j] * kk4[j]; ss += kv[j] * kv[j]; }
        ss = sum16(ss);
        const float rn = 1.f / fmaxf(sqrtf(ss), 1e-12f);
        f32x4 w4, a4, b4, d4;
#pragma unroll
        for (int j = 0; j < 4; ++j) { const float kkn = kv[j] * rn; w4[j] = __expf(-u[j]); a4[j] = -kkn; b4[j] = kkn * a[j]; d4[j] = k[j] * (1.f + (a[j] - 1.f) * ka4[j]); }
        *(LAS f32x4*)(bb) = w4; *(LAS f32x4*)(bb + 2048) = a4; *(LAS f32x4*)(bb + 4096) = b4; *(LAS f32x4*)(bb + 6144) = d4;
        *(LAS f32x4*)(bb + 8192) = (f32x4){bf_lo(gr.x), bf_hi(gr.x), bf_lo(gr.y), bf_hi(gr.y)}; *(LAS f32x4*)(bb + 10240) = (f32x4){bf_lo(gv.x), bf_hi(gv.x), bf_lo(gv.y), bf_hi(gv.y)}; };
    const int nch = L >> 5;
    __syncthreads();
    gload(0); pstore(0);
    __syncthreads();
    for (int ci = 0; ci < nch; ++ci) {
        if (ci + 1 < nch) gload(ci + 1);
        const LAS float* bb = buf + (ci & 1) * 12288 + 8 * cg; const LAS float* bvv = buf + (ci & 1) * 12288 + 10240 + i;
        struct SV { f32x4 w0, w1, a0, a1, b0, b1, d0, d1, r0, r1; float vi; };
        auto ld = [&](int tt) { SV v; const LAS float* p = bb + tt * 64;
            v.w0 = *(const LAS f32x4*)(p); v.w1 = *(const LAS f32x4*)(p + 4); v.a0 = *(const LAS f32x4*)(p + 2048); v.a1 = *(const LAS f32x4*)(p + 2052);
            v.b0 = *(const LAS f32x4*)(p + 4096); v.b1 = *(const LAS f32x4*)(p + 4100); v.d0 = *(const LAS f32x4*)(p + 6144); v.d1 = *(const LAS f32x4*)(p + 6148);
            v.r0 = *(const LAS f32x4*)(p + 8192); v.r1 = *(const LAS f32x4*)(p + 8196); v.vi = bvv[tt * 64]; return v; };
        LAS float* ydc = ydst + ((cg == 0) ? (ci & 1) * 2048 : 0);
        SV cur = ld(0);
#pragma unroll 4
        for (int tt = 0; tt < 32; ++tt) {
            const SV nx = ld(tt < 31 ? tt + 1 : 31);
            const f32x2 A[4] = {{cur.a0[0], cur.a0[1]}, {cur.a0[2], cur.a0[3]}, {cur.a1[0], cur.a1[1]}, {cur.a1[2], cur.a1[3]}}, W[4] = {{cur.w0[0], cur.w0[1]}, {cur.w0[2], cur.w0[3]}, {cur.w1[0], cur.w1[1]}, {cur.w1[2], cur.w1[3]}};
            const f32x2 B[4] = {{cur.b0[0], cur.b0[1]}, {cur.b0[2], cur.b0[3]}, {cur.b1[0], cur.b1[1]}, {cur.b1[2], cur.b1[3]}}, D[4] = {{cur.d0[0], cur.d0[1]}, {cur.d0[2], cur.d0[3]}, {cur.d1[0], cur.d1[1]}, {cur.d1[2], cur.d1[3]}};
            const f32x2 R[4] = {{cur.r0[0], cur.r0[1]}, {cur.r0[2], cur.r0[3]}, {cur.r1[0], cur.r1[1]}, {cur.r1[2], cur.r1[3]}};
            const f32x2 t2 = (S[1] * A[1] + S[0] * A[0]) + (S[3] * A[3] + S[2] * A[2]);
            const float sa = sum8(t2[0] + t2[1]);
            const f32x2 sv = {sa, sa}, vv = {cur.vi, cur.vi};
#pragma unroll
            for (int q = 0; q < 4; ++q) { const f32x2 T = S[q] * W[q] + vv * D[q]; S[q] = sv * B[q] + T; }
            const f32x2 u2 = (S[1] * R[1] + S[0] * R[0]) + (S[3] * R[3] + S[2] * R[2]);
            const float yv = sum8(u2[0] + u2[1]);
            ydc[tt * 64] = yv;
            cur = nx; }
        if (ci + 1 < nch) pstore((ci + 1) & 1);
        __syncthreads();
        { const int pos = 32 * ci + tt_s; const int t = dir ? L - 1 - pos : pos; const f32x4 yv = *(const LAS f32x4*)(ybuf + (ci & 1) * 2048 + tt_s * 64 + jc);
            u32x2 w; w.x = pk2(yv[0], yv[1]); w.y = pk2(yv[2], yv[3]); *(u32x2*)(y + (size_t)(rowbase + t) * 512 + h * 64 + jc) = w; }
    }
    if (!lat) { float* op = P.out + OUT_RWKV + ((size_t)((b * 2 + dir) * 8 + h) * 64 + i) * 64 + 8 * cg; *(f32x4*)op = (f32x4){S[0][0], S[0][1], S[1][0], S[1][1]}; *(f32x4*)(op + 4) = (f32x4){S[2][0], S[2][1], S[3][0], S[3][1]}; }
}
DI void rwkv_scan_half_item(KParams& P, int item, LAS unsigned char* lds, int tid) {
    const int b = item >> 5, h = (item >> 2) & 7, dir = (item >> 1) & 1, half = item & 1; const int L = 2048, rowbase = MP_ + b * 2048, nch = 64;
    LAS float* buf = (LAS float*)lds;
    LAS float* ybuf = (LAS float*)(lds + 98304);
    __syncthreads();
    if (tid >= 256) {
        const int lt = tid - 256, jc = (lt & 15) * 4;
        const bf16_t* rB = (const bf16_t*)(P.ws + A_R); const bf16_t* kB = (const bf16_t*)(P.ws + A_K); const bf16_t* vB = (const bf16_t*)(P.ws + A_V);
        const bf16_t* uB = (const bf16_t*)(P.ws + (dir ? A_U1 : A_U0)); const bf16_t* aB = (const bf16_t*)(P.ws + (dir ? A_A1 : A_A0)); bf16_t* y = (bf16_t*)(P.ws + A_Y) + (dir ? (size_t)M_ * 512 : 0);
        const f32x4 kk4 = *(const f32x4*)(P.in[26] + h * 64 + jc), ka4 = *(const f32x4*)(P.in[27] + h * 64 + jc);
        auto stage = [&](int ci) {
            u32x2 gr[2], gk[2], gv[2], gu[2], ga[2];
#pragma unroll
            for (int g = 0; g < 2; ++g) { const int pos = 32 * ci + (lt >> 4) + 16 * g; const int t = dir ? L - 1 - pos : pos; const size_t o = (size_t)(rowbase + t) * 512 + h * 64 + jc;
                gr[g] = *(const u32x2*)(rB + o); gk[g] = *(const u32x2*)(kB + o); gv[g] = *(const u32x2*)(vB + o); gu[g] = *(const u32x2*)(uB + o); ga[g] = *(const u32x2*)(aB + o); }
#pragma unroll
            for (int g = 0; g < 2; ++g) { LAS float* bb = buf + (ci & 1) * 12288 + ((lt >> 4) + 16 * g) * 64 + jc;
                const float k[4] = {bf_lo(gk[g].x), bf_hi(gk[g].x), bf_lo(gk[g].y), bf_hi(gk[g].y)}, a[4] = {bf_lo(ga[g].x), bf_hi(ga[g].x), bf_lo(ga[g].y), bf_hi(ga[g].y)}, u[4] = {bf_lo(gu[g].x), bf_hi(gu[g].x), bf_lo(gu[g].y), bf_hi(gu[g].y)};
                float kv[4]; float ss = 0.f;
#pragma unroll
                for (int j = 0; j < 4; ++j) { kv[j] = k[j] * kk4[j]; ss += kv[j] * kv[j]; }
                ss = sum16(ss);
                const float rn = 1.f / fmaxf(sqrtf(ss), 1e-12f);
                f32x4 w4, a4, b4, d4;
#pragma unroll
                for (int j = 0; j < 4; ++j) { const float kkn = kv[j] * rn; w4[j] = __expf(-u[j]); a4[j] = -kkn; b4[j] = kkn * a[j]; d4[j] = k[j] * (1.f + (a[j] - 1.f) * ka4[j]); }
                *(LAS f32x4*)(bb) = w4; *(LAS f32x4*)(bb + 2048) = a4; *(LAS f32x4*)(bb + 4096) = b4; *(LAS f32x4*)(bb + 6144) = d4;
                *(LAS f32x4*)(bb + 8192) = (f32x4){bf_lo(gr[g].x), bf_hi(gr[g].x), bf_lo(gr[g].y), bf_hi(gr[g].y)}; *(LAS f32x4*)(bb + 10240) = (f32x4){bf_lo(gv[g].x), bf_hi(gv[g].x), bf_lo(gv[g].y), bf_hi(gv[g].y)}; } };
        auto flush = [&](int ci) { const int tok = lt >> 3, r4 = (lt & 7) * 4; const int pos = 32 * ci + tok; const int t = dir ? L - 1 - pos : pos;
            const f32x4 yv = *(const LAS f32x4*)(ybuf + (ci & 1) * 1024 + tok * 32 + r4); u32x2 w; w.x = pk2(yv[0], yv[1]); w.y = pk2(yv[2], yv[3]);
            *(u32x2*)(y + (size_t)(rowbase + t) * 512 + h * 64 + 32 * half + r4) = w; };
        stage(0);
        __syncthreads();
        for (int ci = 0; ci < nch; ++ci) {
            if (ci + 1 < nch) stage(ci + 1);
            if (ci >= 1) flush(ci - 1);
            __syncthreads();
        }
        flush(nch - 1);
    } else {
        const int il = tid >> 3, cg = tid & 7, i = 32 * half + il;
        f32x2 S[4];
        { const float* s0 = P.in[3] + ((size_t)((b * 2 + dir) * 8 + h) * 64 + i) * 64 + 8 * cg; const f32x4 a = *(const f32x4*)s0, c = *(const f32x4*)(s0 + 4);
          S[0] = (f32x2){a[0], a[1]}; S[1] = (f32x2){a[2], a[3]}; S[2] = (f32x2){c[0], c[1]}; S[3] = (f32x2){c[2], c[3]}; }
        LAS float* ydst = (cg == 0) ? (ybuf + il) : ((LAS float*)(lds + 106496) + tid);
        __syncthreads();
        for (int ci = 0; ci < nch; ++ci) {
            const LAS float* bb = buf + (ci & 1) * 12288 + 8 * cg; const LAS float* bvv = buf + (ci & 1) * 12288 + 10240 + i;
            LAS float* ydc = ydst + ((cg == 0) ? (ci & 1) * 1024 : 0);
            struct SV { f32x4 w0, w1, a0, a1, b0, b1, d0, d1, r0, r1; float vi; };
            auto ld = [&](int tt) { SV v; const LAS float* p = bb + tt * 64;
                v.w0 = *(const LAS f32x4*)(p); v.w1 = *(const LAS f32x4*)(p + 4); v.a0 = *(const LAS f32x4*)(p + 2048); v.a1 = *(const LAS f32x4*)(p + 2052);
                v.b0 = *(const LAS f32x4*)(p + 4096); v.b1 = *(const LAS f32x4*)(p + 4100); v.d0 = *(const LAS f32x4*)(p + 6144); v.d1 = *(const LAS f32x4*)(p + 6148);
                v.r0 = *(const LAS f32x4*)(p + 8192); v.r1 = *(const LAS f32x4*)(p + 8196); v.vi = bvv[tt * 64]; return v; };
            SV cur = ld(0);
#pragma unroll 4
            for (int tt = 0; tt < 32; ++tt) {
                const SV nx = ld(tt < 31 ? tt + 1 : 31);
                const f32x2 A[4] = {{cur.a0[0], cur.a0[1]}, {cur.a0[2], cur.a0[3]}, {cur.a1[0], cur.a1[1]}, {cur.a1[2], cur.a1[3]}}, W[4] = {{cur.w0[0], cur.w0[1]}, {cur.w0[2], cur.w0[3]}, {cur.w1[0], cur.w1[1]}, {cur.w1[2], cur.w1[3]}};
                const f32x2 B[4] = {{cur.b0[0], cur.b0[1]}, {cur.b0[2], cur.b0[3]}, {cur.b1[0], cur.b1[1]}, {cur.b1[2], cur.b1[3]}}, D[4] = {{cur.d0[0], cur.d0[1]}, {cur.d0[2], cur.d0[3]}, {cur.d1[0], cur.d1[1]}, {cur.d1[2], cur.d1[3]}};
                const f32x2 R[4] = {{cur.r0[0], cur.r0[1]}, {cur.r0[2], cur.r0[3]}, {cur.r1[0], cur.r1[1]}, {cur.r1[2], cur.r1[3]}};
                const f32x2 t2 = (S[1] * A[1] + S[0] * A[0]) + (S[3] * A[3] + S[2] * A[2]);
                const float sa = sum8(t2[0] + t2[1]);
                const f32x2 sv = {sa, sa}, vv = {cur.vi, cur.vi};
#pragma unroll
                for (int q = 0; q < 4; ++q) { const f32x2 T = S[q] * W[q] + vv * D[q]; S[q] = sv * B[q] + T; }
                const f32x2 u2 = (S[1] * R[1] + S[0] * R[0]) + (S[3] * R[3] + S[2] * R[2]);
                const float yv = sum8(u2[0] + u2[1]);
                ydc[tt * 32] = yv;
                cur = nx; }
            __syncthreads();
        }
    }
}
DI void rwkv_post_phase(KParams& P, int tid) {
    const int wid = tid >> 6, lane = tid & 63;
    const bf16_t* rB = (const bf16_t*)(P.ws + A_R); const bf16_t* kB = (const bf16_t*)(P.ws + A_K); const bf16_t* vB = (const bf16_t*)(P.ws + A_V); const bf16_t* gB = (const bf16_t*)(P.ws + A_G);
    const bf16_t* yA = (const bf16_t*)(P.ws + A_Y); const bf16_t* yBk = yA + (size_t)M_ * 512; bf16_t* mix = (bf16_t*)(P.ws + WS_H);
    const int c = 8 * lane;
    f32x4 lw[2], lb[2], rk[2];
#pragma unroll
    for (int q = 0; q < 2; ++q) { lw[q] = *(const f32x4*)(P.in[29] + c + 4 * q); lb[q] = *(const f32x4*)(P.in[30] + c + 4 * q); rk[q] = *(const f32x4*)(P.in[28] + c + 4 * q); }
    for (int row = blockIdx.x * 8 + wid; row < M_; row += gridDim.x * 8) { const size_t o = (size_t)row * 512 + c;
        const u32x4 ya = *(const u32x4*)(yA + o), yb = *(const u32x4*)(yBk + o);
        const u32x4 ru = *(const u32x4*)(rB + o), ku = *(const u32x4*)(kB + o), vu = *(const u32x4*)(vB + o), gu = *(const u32x4*)(gB + o);
        float yy[8]; float r[8], k[8], v[8], g[8];
#pragma unroll
        for (int q = 0; q < 4; ++q) { yy[2 * q] = bf_lo(ya[q]) + bf_lo(yb[q]); yy[2 * q + 1] = bf_hi(ya[q]) + bf_hi(yb[q]); }
#pragma unroll
        for (int q = 0; q < 4; ++q) { r[2 * q] = bf_lo(ru[q]); r[2 * q + 1] = bf_hi(ru[q]); k[2 * q] = bf_lo(ku[q]); k[2 * q + 1] = bf_hi(ku[q]); v[2 * q] = bf_lo(vu[q]); v[2 * q + 1] = bf_hi(vu[q]); g[2 * q] = bf_lo(gu[q]); g[2 * q + 1] = bf_hi(gu[q]); }
        float s = 0.f, bs = 0.f;
#pragma unroll
        for (int q = 0; q < 8; ++q) { s += yy[q]; bs += r[q] * k[q] * rk[q >> 2][q & 3]; }
        s = sum8(s); bs = sum8(bs); const float mu = s * (1.f / 64.f); float vs = 0.f;
#pragma unroll
        for (int q = 0; q < 8; ++q) { const float d = yy[q] - mu; vs += d * d; }
        vs = sum8(vs); const float rs = rsqrtf(vs * (1.f / 64.f) + 64e-5f);
        float o8[8];
#pragma unroll
        for (int q = 0; q < 8; ++q) o8[q] = ((yy[q] - mu) * rs * lw[q >> 2][q & 3] + lb[q >> 2][q & 3] + bs * v[q]) * g[q];
        u32x4 w; w.x = pk2(o8[0], o8[1]); w.y = pk2(o8[2], o8[3]); w.z = pk2(o8[4], o8[5]); w.w = pk2(o8[6], o8[7]);
        *(u32x4*)(mix + (size_t)row * D_ + 512 + c) = w; }
}
#define XB_TMO      128
#define XB_XCNT(j)  (256  + 64 * (j))
#define XB_XSUB(j)  (1280 + 64 * (j))
#define XB_XGEN(j)  (2304 + 64 * (j))
#define XB_TOP      3328
#define XB_TOPGEN   3392
#define XCD_BAR_WORDS 3456
#define XB_SPIN_CAP (1u << 18)

__device__ __forceinline__ unsigned xb_ld(unsigned* p)              { return __hip_atomic_load(p, __ATOMIC_RELAXED, __HIP_MEMORY_SCOPE_AGENT); }
__device__ __forceinline__ unsigned xb_add(unsigned* p, unsigned v) { return __hip_atomic_fetch_add(p, v, __ATOMIC_RELAXED, __HIP_MEMORY_SCOPE_AGENT); }
__device__ __forceinline__ unsigned xb_xcc_id() { return (unsigned)__builtin_amdgcn_s_getreg((3 << 11) | 20) & 0xFu; }
#define XB_SPIN(cond, bar) do { unsigned _sp = 0; while (cond) { __builtin_amdgcn_s_sleep(1); \
    if ((++_sp & 255u) == 0u) { if (xb_ld(&(bar)[XB_TMO])) break; if (_sp > XB_SPIN_CAP) { atomicAdd(&(bar)[XB_TMO], 1u); break; } } } } while (0)

struct XcdBarrier {
    unsigned* bar; unsigned x;
    volatile LAS unsigned* st;
};

__device__ __forceinline__ XcdBarrier xcd_barrier_post(unsigned* bar, volatile LAS unsigned* st) {
    XcdBarrier b; b.bar = bar; b.x = xb_xcc_id(); b.st = st;
    if (threadIdx.x == 0) (void)xb_add(&bar[XB_XCNT(b.x)], 1u);
    return b;
}
__device__ __forceinline__ void xcd_barrier_complete(unsigned* bar, unsigned x, unsigned& nloc, unsigned& nx) {
    const unsigned G = gridDim.x * gridDim.y * gridDim.z;
    unsigned sum, cnt, mine, sp = 0u;
    for (;;) {
        sum = 0u; cnt = 0u; mine = 0u;
#pragma unroll
        for (unsigned j = 0; j < 16; ++j) { const unsigned c = xb_ld(&bar[XB_XCNT(j)]); sum += c; cnt += (c > 0u) ? 1u : 0u; mine = (j == x) ? c : mine; }
        if (sum == G) break;
        __builtin_amdgcn_s_sleep(1);
        if ((++sp & 255u) == 0u) { if (xb_ld(&bar[XB_TMO])) break; if (sp > XB_SPIN_CAP) { atomicAdd(&bar[XB_TMO], 1u); break; } }
    }
    nloc = mine > 0u ? mine : 1u; nx = cnt > 0u ? cnt : 1u;
}

__device__ __forceinline__ void xcd_barrier(const XcdBarrier& b) {
    asm volatile("s_waitcnt vmcnt(0)" ::: "memory");
    __syncthreads();
    if (threadIdx.x == 0) {
        unsigned* bar = b.bar;
        __builtin_amdgcn_s_waitcnt(0);
        unsigned nloc = b.st[0], nx = b.st[1];
        if (nloc == 0u) { xcd_barrier_complete(bar, b.x, nloc, nx); b.st[0] = nloc; b.st[1] = nx; }
        const unsigned old = xb_add(&bar[XB_XSUB(b.x)], 1u);
        const unsigned gen = old / nloc;
        if (old + 1u == (gen + 1u) * nloc) {
            __builtin_amdgcn_fence(__ATOMIC_RELEASE, "agent");
            asm volatile("s_waitcnt vmcnt(0)" ::: "memory");
            const unsigned og = xb_add(&bar[XB_TOP], 1u);
            const unsigned tg = og / nx;
            if (og + 1u == (tg + 1u) * nx) xb_add(&bar[XB_TOPGEN], 1u);
            else XB_SPIN(xb_ld(&bar[XB_TOPGEN]) == tg, bar);
            __builtin_amdgcn_fence(__ATOMIC_ACQUIRE, "agent");
            xb_add(&bar[XB_XGEN(b.x)], 1u);
            asm volatile("s_waitcnt vmcnt(0)" ::: "memory");
        } else {
            XB_SPIN(xb_ld(&bar[XB_XGEN(b.x)]) == gen, bar);
            __builtin_amdgcn_fence(__ATOMIC_ACQUIRE, "agent");
            asm volatile("s_waitcnt vmcnt(0)" ::: "memory");
        }
    }
    __syncthreads();
}


DI int next_item(unsigned* c, LAS int* slot, int tid) { __syncthreads(); if (tid == 0) *slot = (int)atomicAdd(c, 1u); __syncthreads(); return *slot; }

template <int NN, class Epi> DI void run_gemm(LAS unsigned char* lds, const bf16_t* A, const bf16_t* Bt, int N, int K, const Epi& E) {
    N = launder_s(N); K = launder_s(K);
    pg8::FastOrder<NN> S; S.init(M_, N, (int)gridDim.x, (int)blockIdx.x);
    pg8::gemm_phase<Epi, pg8::FastOrder<NN>>(lds, pg8::Gemm{A, Bt, M_, N, K}, S, E);
    __syncthreads();
}

__global__ void __launch_bounds__(512) fwd_kernel(Params Pk) {
#define P (kparams())
    extern __shared__ __attribute__((aligned(16))) unsigned char smem[];
    LAS unsigned char* lds = (LAS unsigned char*)smem;
    LAS int* slot = (LAS int*)(lds + MISC_OFF + 8064);
#define ws (P.ws)
#define tid (launder_v((int)threadIdx.x))
#define ctr ((unsigned*)(ws + WS_CTR))
#define rope ((float*)(ws + WS_ROPE))
#define mod ((float*)(ws + WS_MOD))
#define XRES (P.out)
#define hb ((bf16_t*)(ws + WS_H))
#define act ((bf16_t*)(ws + A_ACT))
    if (blockIdx.x == 0) { if (threadIdx.x < 16) ctr[threadIdx.x] = 0u; unsigned* bz = (unsigned*)(ws + WS_BAR); for (int i = threadIdx.x; i < XCD_BAR_WORDS; i += 512) bz[i] = 0u; }
    if (blockIdx.x == gridDim.x - 1) for (int e = tid; e < 1024; e += 512) { const int pos = e >> 4, i = e & 15; const float inv = powf(10000.f, -(float)i / 16.f); const float ang = (float)pos * inv; rope[2 * e] = cosf(ang); rope[2 * e + 1] = sinf(ang); }
    { bf16_t* ck = (bf16_t*)(ws + WS_CK); bf16_t* cv = (bf16_t*)(ws + WS_CV); const float* sk = P.in[7]; const float* sv = P.in[8];
      for (int i = blockIdx.x * 512 + threadIdx.x; i < 131072; i += gridDim.x * 512) { const f32x4 a = *(const f32x4*)(sk + 4 * (size_t)i), c = *(const f32x4*)(sv + 4 * (size_t)i); u32x2 w; w.x = pk2(a[0], a[1]); w.y = pk2(a[2], a[3]); *(u32x2*)(ck + 4 * (size_t)i) = w; w.x = pk2(c[0], c[1]); w.y = pk2(c[2], c[3]); *(u32x2*)(cv + 4 * (size_t)i) = w; } }
    mod_phase(P, lds, tid);
    convert_layer(P, 0, lds, tid, 63);
    cg::this_grid().sync();
    { volatile LAS unsigned* st_ = (volatile LAS unsigned*)(lds + MISC_OFF + 8072); if (threadIdx.x < 2) st_[threadIdx.x] = 0u; __syncthreads(); (void)xcd_barrier_post((unsigned*)(ws + WS_BAR), st_); }
#define GBAR() do { XcdBarrier b_; b_.bar = (unsigned*)(ws + WS_BAR); b_.x = xb_xcc_id(); b_.st = (volatile LAS unsigned*)(lds + MISC_OFF + 8072); xcd_barrier(b_); } while (0)
    { constexpr int l = 0;
#define modl (mod + (size_t)launder_s(l) * 9 * 9216)
#define ng (P.in[13] + (size_t)launder_s(l) * 3 * 1024)
        if (l == 1) convert_layer(P, 1, lds, tid, 42);
        norm_phase(l == 0 ? P.in[0] : XRES, l == 0 ? P.in[1] : XRES + (size_t)MP_ * D_, hb, ng, modl, 0, tid);
        GBAR();
        run_gemm<22>(lds, hb, (const bf16_t*)(ws + W_W1A), 2 * DFF_, D_, EpiSwiglu{act});
        GBAR();
        run_gemm<4>(lds, act, (const bf16_t*)(ws + W_W2A), D_, DFF_, EpiResid{l == 0 ? P.in[0] : XRES, l == 0 ? P.in[1] : XRES + (size_t)MP_ * D_, XRES, modl + 2 * 1024, 0.5f});
        GBAR();
        norm_phase(XRES, XRES + (size_t)MP_ * D_, hb, ng + 1024, modl, 3, tid);
        GBAR();
        if (l == 0) {
            run_gemm<13>(lds, hb, (const bf16_t*)(ws + W_WIN), 3328, D_, EpiInEven{ws, rope});
            GBAR();
            for (;;) { const int it = next_item(ctr + 0, slot, tid); if (it >= 640) break;
                if (it < 256) ret_item(P, it + 128, lds, tid); else if (it < 512) ret_state_item(P, it - 256, lds, tid); else ret_item(P, it - 512, lds, tid); }
            rwkv_shift_phase(P, tid);
            GBAR();
            run_gemm<10>(lds, (const bf16_t*)(ws + A_X), (const bf16_t*)(ws + W_WL), 2560, 256,
                     EpiLora{ws, P.in[21], P.in[23]});
            GBAR();
            for (;;) { const int it = next_item(ctr + 1, slot, tid); if (it >= 768 + 720) break; if (it < 256) rwkv_scan_half_item(P, it, lds, tid); else if (it < 768) rwkv_scan_item(P, it - 128, lds, tid); else conv_l1_early_item(P, it - 768, lds, tid); }
            GBAR();
            rwkv_post_phase(P, tid);
            GBAR();
        } else {
            run_gemm<12>(lds, hb, (const bf16_t*)(ws + W_WIN), 3072, D_, EpiInOdd{ws, rope, P.in[36], P.in[33], P.in[34], P.out});
            GBAR();
            for (;;) { const int it = next_item(ctr + 2, slot, tid); if (it >= 1792) break;
                if (it < 512) attn_item(P, it, lds, tid); else if (it < 1024) mlstm_item(P, it - 256, lds, tid); else if (it < 1280) mlstm_state_item(P, it - 1024, lds, tid);
                else if (it < 1536) mlstm_item(P, it - 1280, lds, tid); else attn_item(P, 512 + it - 1536, lds, tid); }
            GBAR();
        }
        run_gemm<4>(lds, hb, (const bf16_t*)(ws + W_WOUT), D_, D_, EpiResid{XRES, XRES + (size_t)MP_ * D_, XRES, modl + 5 * 1024, 1.0f});
        GBAR();
        norm_phase(XRES, XRES + (size_t)MP_ * D_, hb, ng + 2048, modl, 6, tid);
        GBAR();
        run_gemm<22>(lds, hb, (const bf16_t*)(ws + W_W1B), 2 * DFF_, D_, EpiSwiglu{act});
        GBAR();
        run_gemm<4>(lds, act, (const bf16_t*)(ws + W_W2B), D_, DFF_, EpiResid{XRES, XRES + (size_t)MP_ * D_, XRES, modl + 8 * 1024, 0.5f});
        GBAR();
    }
    { constexpr int l = 1;
#define modl (mod + (size_t)launder_s(l) * 9 * 9216)
#define ng (P.in[13] + (size_t)launder_s(l) * 3 * 1024)
        if (l == 1) convert_layer(P, 1, lds, tid, 42);
        norm_phase(l == 0 ? P.in[0] : XRES, l == 0 ? P.in[1] : XRES + (size_t)MP_ * D_, hb, ng, modl, 0, tid);
        GBAR();
        run_gemm<22>(lds, hb, (const bf16_t*)(ws + W_W1A), 2 * DFF_, D_, EpiSwiglu{act});
        GBAR();
        run_gemm<4>(lds, act, (const bf16_t*)(ws + W_W2A), D_, DFF_, EpiResid{l == 0 ? P.in[0] : XRES, l == 0 ? P.in[1] : XRES + (size_t)MP_ * D_, XRES, modl + 2 * 1024, 0.5f});
        GBAR();
        norm_phase(XRES, XRES + (size_t)MP_ * D_, hb, ng + 1024, modl, 3, tid);
        GBAR();
        if (l == 0) {
            run_gemm<13>(lds, hb, (const bf16_t*)(ws + W_WIN), 3328, D_, EpiInEven{ws, rope});
            GBAR();
            for (;;) { const int it = next_item(ctr + 0, slot, tid); if (it >= 640) break;
                if (it < 256) ret_item(P, it + 128, lds, tid); else if (it < 512) ret_state_item(P, it - 256, lds, tid); else ret_item(P, it - 512, lds, tid); }
            rwkv_shift_phase(P, tid);
            GBAR();
            run_gemm<10>(lds, (const bf16_t*)(ws + A_X), (const bf16_t*)(ws + W_WL), 2560, 256,
                     EpiLora{ws, P.in[21], P.in[23]});
            GBAR();
            for (;;) { const int it = next_item(ctr + 1, slot, tid); if (it >= 768 + 720) break; if (it < 256) rwkv_scan_half_item(P, it, lds, tid); else if (it < 768) rwkv_scan_item(P, it - 128, lds, tid); else conv_l1_early_item(P, it - 768, lds, tid); }
            GBAR();
            rwkv_post_phase(P, tid);
            GBAR();
        } else {
            run_gemm<12>(lds, hb, (const bf16_t*)(ws + W_WIN), 3072, D_, EpiInOdd{ws, rope, P.in[36], P.in[33], P.in[34], P.out});
            GBAR();
            for (;;) { const int it = next_item(ctr + 2, slot, tid); if (it >= 1792) break;
                if (it < 512) attn_item(P, it, lds, tid); else if (it < 1024) mlstm_item(P, it - 256, lds, tid); else if (it < 1280) mlstm_state_item(P, it - 1024, lds, tid);
                else if (it < 1536) mlstm_item(P, it - 1280, lds, tid); else attn_item(P, 512 + it - 1536, lds, tid); }
            GBAR();
        }
        run_gemm<4>(lds, hb, (const bf16_t*)(ws + W_WOUT), D_, D_, EpiResid{XRES, XRES + (size_t)MP_ * D_, XRES, modl + 5 * 1024, 1.0f});
        GBAR();
        norm_phase(XRES, XRES + (size_t)MP_ * D_, hb, ng + 2048, modl, 6, tid);
        GBAR();
        run_gemm<22>(lds, hb, (const bf16_t*)(ws + W_W1B), 2 * DFF_, D_, EpiSwiglu{act});
        GBAR();
        run_gemm<4>(lds, act, (const bf16_t*)(ws + W_W2B), D_, DFF_, EpiResid{XRES, XRES + (size_t)MP_ * D_, XRES, modl + 8 * 1024, 0.5f});
        GBAR();
    }
    final_norm_phase(XRES, P.in[37], tid);
#undef tid
#undef GBAR
#undef modl
#undef ng
#undef ctr
#undef rope
#undef mod
#undef XRES
#undef hb
#undef act
#undef ws
#undef P
}

extern "C" void kernel_launch(void* const* d_in, const int* in_sizes, int n_in, void* d_out, int out_size, void* d_ws, size_t ws_size, hipStream_t stream) {
    static int grid_blocks = 0;
    if (grid_blocks == 0) {
        if (n_in != 38 || ws_size < WS_NEED) { fprintf(stderr, "kernel_launch: need 38 inputs and %zu bytes of workspace, got %d / %zu\n", (size_t)WS_NEED, n_in, ws_size); grid_blocks = -1; return; }
        int dev = 0, cus = 0, per_cu = 0;
        hipGetDevice(&dev); hipDeviceGetAttribute(&cus, hipDeviceAttributeMultiprocessorCount, dev);
        if (hipFuncSetAttribute((const void*)fwd_kernel, hipFuncAttributeMaxDynamicSharedMemorySize, LDS_BYTES) != hipSuccess) { fprintf(stderr, "kernel_launch: hipFuncSetAttribute failed\n"); grid_blocks = -1; return; }
        if (hipOccupancyMaxActiveBlocksPerMultiprocessor(&per_cu, (const void*)fwd_kernel, 512, LDS_BYTES) != hipSuccess || per_cu < 1) { fprintf(stderr, "kernel_launch: occupancy query failed (%d)\n", per_cu); grid_blocks = -1; return; }
        grid_blocks = cus * per_cu;
    }
    if (grid_blocks < 0) return;
    Params p{};
    for (int i = 0; i < 38; ++i) p.in[i] = (const float*)d_in[i];
    p.out = (float*)d_out; p.ws = (unsigned char*)d_ws;
    void* args[] = {&p};
    hipError_t e = hipLaunchCooperativeKernel((const void*)fwd_kernel, dim3(grid_blocks), dim3(512), args, LDS_BYTES, stream);
    if (e != hipSuccess) fprintf(stderr, "cooperative launch failed: %s (grid %d)\n", hipGetErrorString(e), grid_blocks);
}
```
